# Optimizing an MI355X kernel written in HIP

```python
import math
import jax
import jax.numpy as jnp
from jax import lax
import numpy as np

D_MODEL = 2048
BATCH = 2
SEQ = 4096
DEPTH = 4

MIX_WIDTH = D_MODEL
SWA_WIDTH = MIX_WIDTH // 2
DN_WIDTH = MIX_WIDTH - SWA_WIDTH
HEAD_DIM = 64
N_Q_HEADS = SWA_WIDTH // HEAD_DIM
KV_GROUP = 8
N_KV_HEADS = N_Q_HEADS // KV_GROUP
WINDOW = 128
BLOCK = 128
ROPE_THETA = 10000.0
DN_HEAD_DIM = 128
DN_HEADS = DN_WIDTH // DN_HEAD_DIM
CONV_WIDTH = 4
CHUNK = 64
N_EXPERTS = 16
N_GROUPS = 4
EXPERTS_PER_GROUP = N_EXPERTS // N_GROUPS
TOP_K = 2
D_EXPERT = D_MODEL // 4
ALPHA = (2 * DEPTH) ** 0.25
BETA_INIT = (8 * DEPTH) ** -0.25
LN_EPS = 1e-5
RMS_EPS = 1e-6
SWA_KV_DIM = N_KV_HEADS * HEAD_DIM
DN_QKV_DIM = 3 * DN_WIDTH
PROJ_SIZES = (SWA_WIDTH, SWA_KV_DIM, SWA_KV_DIM, DN_QKV_DIM, DN_WIDTH, DN_HEADS, DN_HEADS)
PROJ_DIM = sum(PROJ_SIZES)

kernel_name = "hymba_swa_sink_gdn_grouped_moe_deepnorm"


def layer_norm(x, g, b):
    xf = x.astype(jnp.float32)
    mu = jnp.mean(xf, axis=-1, keepdims=True)
    xc = xf - mu
    var = jnp.mean(xc * xc, axis=-1, keepdims=True)
    return (xc * lax.rsqrt(var + LN_EPS) * g.astype(jnp.float32) + b.astype(jnp.float32)).astype(x.dtype)


def rope_tables(positions):
    inv_freq = 1.0 / (ROPE_THETA ** (jnp.arange(0, HEAD_DIM, 2, dtype=jnp.float32) / HEAD_DIM))
    ang = positions.astype(jnp.float32)[..., None] * inv_freq
    return jnp.cos(ang), jnp.sin(ang)


def apply_rope(x, cos, sin):
    xf = x.astype(jnp.float32)
    x1, x2 = jnp.split(xf, 2, axis=-1)
    c = cos[:, :, None, :]
    s = sin[:, :, None, :]
    return jnp.concatenate([x1 * c - x2 * s, x2 * c + x1 * s], axis=-1).astype(x.dtype)


def sliding_window_attention(q, k, v, sinks):
    B, S = q.shape[0], q.shape[1]
    nb = S // BLOCK
    qb = q.reshape(B, nb, BLOCK, N_KV_HEADS, KV_GROUP, HEAD_DIM)
    pad = ((0, 0), (BLOCK, 0), (0, 0), (0, 0))
    kp = jnp.pad(k, pad).reshape(B, nb + 1, BLOCK, N_KV_HEADS, HEAD_DIM)
    vp = jnp.pad(v, pad).reshape(B, nb + 1, BLOCK, N_KV_HEADS, HEAD_DIM)
    kb = jnp.concatenate([kp[:, :-1], kp[:, 1:]], axis=2)
    vb = jnp.concatenate([vp[:, :-1], vp[:, 1:]], axis=2)
    s = jnp.einsum('bnqhgd,bnkhd->bnhgqk', qb, kb).astype(jnp.float32) * (HEAD_DIM ** -0.5)
    qpos = jnp.arange(BLOCK)[:, None] + BLOCK
    kpos = jnp.arange(2 * BLOCK)[None, :]
    rel = qpos - kpos
    band = (rel >= 0) & (rel < WINDOW)
    not_pad = (jnp.arange(nb)[:, None, None] > 0) | (kpos >= BLOCK)[None]
    valid = band[None] & not_pad
    s = jnp.where(valid[None, :, None, None], s, -jnp.inf)
    sink = jnp.broadcast_to(
        sinks.astype(jnp.float32).reshape(N_KV_HEADS, KV_GROUP)[None, None, :, :, None, None],
        s.shape[:-1] + (1,))
    p = jax.nn.softmax(jnp.concatenate([s, sink], axis=-1), axis=-1)[..., :-1]
    o = jnp.einsum('bnhgqk,bnkhd->bnqhgd', p.astype(v.dtype), vb)
    return o.reshape(B, S, N_Q_HEADS * HEAD_DIM)


def causal_depthwise_conv(x, w):
    C = x.shape[-1]
    return lax.conv_general_dilated(
        x, w[:, None, :].astype(x.dtype), window_strides=(1,),
        padding=[(CONV_WIDTH - 1, 0)], dimension_numbers=('NWC', 'WIO', 'NWC'),
        feature_group_count=C)


def l2norm(x):
    return x * lax.rsqrt(jnp.sum(x * x, axis=-1, keepdims=True) + RMS_EPS)


def gated_delta_rule(q, k, v, g, beta):
    B, S, H, DK = q.shape
    DV = v.shape[-1]
    n = S // CHUNK

    def chunk(t):
        return t.reshape(B, n, CHUNK, H, -1).transpose(0, 3, 1, 2, 4)

    q, k, v = chunk(q), chunk(k), chunk(v)
    g = g.reshape(B, n, CHUNK, H).transpose(0, 3, 1, 2)
    beta = beta.reshape(B, n, CHUNK, H).transpose(0, 3, 1, 2)
    gc = jnp.cumsum(g, axis=-1)
    idx = jnp.arange(CHUNK)
    causal = idx[:, None] >= idx[None, :]
    strict = idx[:, None] > idx[None, :]
    decay = jnp.exp(jnp.where(causal, gc[..., :, None] - gc[..., None, :], -jnp.inf))
    kb = k * beta[..., None]
    vb = v * beta[..., None]
    L = jnp.where(strict, jnp.einsum('bhncd,bhnsd->bhncs', kb, k) * decay, 0.0)
    eye = jnp.eye(CHUNK, dtype=L.dtype)
    T = lax.linalg.triangular_solve(eye + L, jnp.broadcast_to(eye, L.shape),
                                    left_side=True, lower=True, unit_diagonal=True)
    u = jnp.einsum('bhncs,bhnsv->bhncv', T, vb)
    w = jnp.einsum('bhncs,bhnsk->bhnck', T, kb * jnp.exp(gc)[..., None])
    a_qk = jnp.where(causal, jnp.einsum('bhncd,bhnsd->bhncs', q, k) * decay, 0.0)
    qg = q * jnp.exp(gc)[..., None]
    kd = k * jnp.exp(gc[..., -1:] - gc)[..., None]
    glast = jnp.exp(gc[..., -1])
    xs = tuple(jnp.moveaxis(t, 2, 0) for t in (u, w, a_qk, qg, kd, glast))

    def step(state, inp):
        u_i, w_i, a_i, qg_i, kd_i, gl_i = inp
        v_new = u_i - jnp.einsum('bhck,bhkv->bhcv', w_i, state)
        o_i = jnp.einsum('bhck,bhkv->bhcv', qg_i, state) + jnp.einsum('bhcs,bhsv->bhcv', a_i, v_new)
        state = state * gl_i[..., None, None] + jnp.einsum('bhck,bhcv->bhkv', kd_i, v_new)
        return state, o_i

    s0 = jnp.zeros((B, H, DK, DV), jnp.float32)
    _, o = lax.scan(step, s0, xs)
    return o.transpose(1, 0, 3, 2, 4).reshape(B, S, H, DV)


def hybrid_mixer(h, w_in, sinks, conv_w, a_log, dt_bias, dn_norm_w, w_out, cos, sin):
    B, S, _ = h.shape
    proj = h @ w_in
    cuts = []
    off = 0
    for size in PROJ_SIZES[:-1]:
        off += size
        cuts.append(off)
    sq, sk, sv, dn_qkv, dn_z, dn_a, dn_b = jnp.split(proj, cuts, axis=-1)

    sq = apply_rope(sq.reshape(B, S, N_Q_HEADS, HEAD_DIM), cos, sin)
    sk = apply_rope(sk.reshape(B, S, N_KV_HEADS, HEAD_DIM), cos, sin)
    sv = sv.reshape(B, S, N_KV_HEADS, HEAD_DIM)
    attn_out = sliding_window_attention(sq, sk, sv, sinks)

    dn_qkv = jax.nn.silu(causal_depthwise_conv(dn_qkv, conv_w)).astype(jnp.float32)
    dq, dk, dv = jnp.split(dn_qkv, 3, axis=-1)
    dq = l2norm(dq.reshape(B, S, DN_HEADS, DN_HEAD_DIM)) * (DN_HEAD_DIM ** -0.5)
    dk = l2norm(dk.reshape(B, S, DN_HEADS, DN_HEAD_DIM))
    dv = dv.reshape(B, S, DN_HEADS, DN_HEAD_DIM)
    beta = jax.nn.sigmoid(dn_b.astype(jnp.float32))
    g = -jnp.exp(a_log.astype(jnp.float32)) * jax.nn.softplus(
        dn_a.astype(jnp.float32) + dt_bias.astype(jnp.float32))
    o = gated_delta_rule(dq, dk, dv, g, beta)
    z = dn_z.reshape(B, S, DN_HEADS, DN_HEAD_DIM).astype(jnp.float32)
    o = (o * lax.rsqrt(jnp.mean(o * o, axis=-1, keepdims=True) + RMS_EPS)
         * dn_norm_w.astype(jnp.float32) * jax.nn.silu(z))
    dn_out = o.reshape(B, S, DN_WIDTH).astype(h.dtype)

    return jnp.concatenate([attn_out, dn_out], axis=-1) @ w_out


def grouped_moe(h, router_w, router_bias, w_gate, w_up, w_down):
    B, S, D = h.shape
    t = h.reshape(-1, D)
    scores = jax.nn.sigmoid((t @ router_w).astype(jnp.float32))
    sel = scores + router_bias.astype(jnp.float32)
    grp_top = lax.top_k(sel.reshape(-1, N_GROUPS, EXPERTS_PER_GROUP), 2)[0]
    gidx = jnp.argmax(jnp.sum(grp_top, axis=-1), axis=-1)
    in_group = (jnp.arange(N_EXPERTS) // EXPERTS_PER_GROUP)[None, :] == gidx[:, None]
    _, eidx = lax.top_k(jnp.where(in_group, sel, -jnp.inf), TOP_K)
    wsel = jnp.take_along_axis(scores, eidx, axis=-1)
    wsel = wsel / jnp.sum(wsel, axis=-1, keepdims=True)
    gates = jnp.sum(jax.nn.one_hot(eidx, N_EXPERTS, dtype=jnp.float32) * wsel[..., None], axis=1)
    a = jnp.einsum('td,edf->etf', t, w_gate)
    u = jnp.einsum('td,edf->etf', t, w_up)
    hidden = jax.nn.silu(a) * u * gates.T.astype(t.dtype)[..., None]
    out = jnp.einsum('etf,efd->td', hidden, w_down)
    return out.reshape(B, S, D)


def setup_inputs(seed: int = 0) -> dict:
    key = jax.random.key(seed)
    ks = jax.random.split(key, 20)
    f32 = jnp.float32

    def nrm(k, shape, scale):
        return jax.random.normal(k, shape, f32) * scale

    x = nrm(ks[0], (BATCH, SEQ, D_MODEL), 1.0)
    positions = jnp.broadcast_to(jnp.arange(SEQ, dtype=jnp.int32), (BATCH, SEQ))
    w_in = nrm(ks[1], (DEPTH, D_MODEL, PROJ_DIM), D_MODEL ** -0.5)
    attn_sinks = nrm(ks[2], (DEPTH, N_Q_HEADS), 0.5)
    conv_w = nrm(ks[3], (DEPTH, CONV_WIDTH, DN_QKV_DIM), CONV_WIDTH ** -0.5)
    a_log = jnp.log(jax.random.uniform(ks[4], (DEPTH, DN_HEADS), f32, 1.0, 16.0))
    dt = jnp.exp(jax.random.uniform(ks[5], (DEPTH, DN_HEADS), f32, math.log(1e-3), math.log(1e-1)))
    dt_bias = dt + jnp.log(-jnp.expm1(-dt))
    dn_norm_w = 1.0 + nrm(ks[6], (DEPTH, DN_HEAD_DIM), 0.02)
    w_out = nrm(ks[7], (DEPTH, MIX_WIDTH, D_MODEL), MIX_WIDTH ** -0.5 * BETA_INIT)
    ln1_g = 1.0 + nrm(ks[8], (DEPTH, D_MODEL), 0.02)
    ln1_b = nrm(ks[9], (DEPTH, D_MODEL), 0.02)
    router_w = nrm(ks[10], (D_MODEL, N_EXPERTS), D_MODEL ** -0.5)
    router_bias = nrm(ks[11], (N_EXPERTS,), 0.01)
    w_gate = nrm(ks[12], (DEPTH, N_EXPERTS, D_MODEL, D_EXPERT), D_MODEL ** -0.5)
    w_up = nrm(ks[13], (DEPTH, N_EXPERTS, D_MODEL, D_EXPERT), D_MODEL ** -0.5)
    w_down = nrm(ks[14], (DEPTH, N_EXPERTS, D_EXPERT, D_MODEL), D_EXPERT ** -0.5 * BETA_INIT)
    ln2_g = 1.0 + nrm(ks[15], (DEPTH, D_MODEL), 0.02)
    ln2_b = nrm(ks[16], (DEPTH, D_MODEL), 0.02)
    return {"x": x, "positions": positions, "w_in": w_in, "attn_sinks": attn_sinks,
            "conv_w": conv_w, "a_log": a_log, "dt_bias": dt_bias, "dn_norm_w": dn_norm_w,
            "w_out": w_out, "ln1_g": ln1_g, "ln1_b": ln1_b, "router_w": router_w,
            "router_bias": router_bias, "w_gate": w_gate, "w_up": w_up, "w_down": w_down,
            "ln2_g": ln2_g, "ln2_b": ln2_b}


def reference(x, positions, w_in, attn_sinks, conv_w, a_log, dt_bias, dn_norm_w, w_out,
              ln1_g, ln1_b, router_w, router_bias, w_gate, w_up, w_down, ln2_g, ln2_b):
    cos, sin = rope_tables(positions)
    for l in range(DEPTH):
        mix = hybrid_mixer(x, w_in[l], attn_sinks[l], conv_w[l], a_log[l], dt_bias[l],
                           dn_norm_w[l], w_out[l], cos, sin)
        x = layer_norm(ALPHA * x + mix, ln1_g[l], ln1_b[l])
        ffn = grouped_moe(x, router_w, router_bias, w_gate[l], w_up[l], w_down[l])
        x = layer_norm(ALPHA * x + ffn, ln2_g[l], ln2_b[l])
    return x
```

```cpp
#include <hip/hip_runtime.h>
#include <cstdio>
#include <cstdint>

#ifndef MK_ONE_LAUNCH
#define MK_ONE_LAUNCH 0
#endif
#ifndef DN_NAIVE
#define DN_NAIVE 1
#endif

#define DI __device__ __forceinline__
#define LAS __attribute__((address_space(3)))
#define GAS __attribute__((address_space(1)))
typedef unsigned short bf16;
typedef short bf16x8 __attribute__((ext_vector_type(8)));
typedef short s16x4 __attribute__((ext_vector_type(4)));
typedef float f32x4 __attribute__((ext_vector_type(4)));
typedef float f32x2 __attribute__((ext_vector_type(2)));
typedef unsigned u32x4 __attribute__((ext_vector_type(4)));
typedef unsigned u32x2 __attribute__((ext_vector_type(2)));

constexpr int NTOK = 8192, SEQ = 4096, DM = 2048, PROJ = 5392, PN = 5376, DEPTH = 4;
constexpr int C_SQ = 0, C_SK = 1024, C_SV = 1152, C_DQ = 1280, C_DK = 2304, C_DV = 3328, C_DZ = 4352, C_AB = 5376;
constexpr int NEXP = 16, DEXP = 512;
constexpr float ALPHA = 1.681792830507429f;
constexpr float LN_EPS = 1e-5f, RMS_EPS = 1e-6f;

constexpr size_t MiB = 1u << 20;
constexpr size_t WS_CTL = 0, CTL_BYTES = 1 * MiB;
constexpr size_t WS_COS = 1 * MiB, WS_SIN = 2 * MiB;
constexpr size_t WS_AB = 4 * MiB;
constexpr size_t WS_G = 4 * MiB + 512 * 1024, WS_BETA = WS_G + 256 * 1024;
constexpr size_t WS_WSEL = 5 * MiB, WS_LIST = 5 * MiB + 64 * 1024;
constexpr size_t WS_WIN = 8 * MiB, WS_WOUT = 50 * MiB, WS_WGU = 66 * MiB, WS_WD = 194 * MiB;
constexpr size_t WS_X = 258 * MiB, WS_XB = 322 * MiB, WS_PROJ = 354 * MiB, WS_Y = 438 * MiB, WS_X1 = 502 * MiB, WS_X1B = 566 * MiB;
constexpr size_t WS_CAT = 598 * MiB, WS_OBUF = 630 * MiB, WS_QKV = 662 * MiB, WS_SCAN = 710 * MiB, WS_HID = 798 * MiB, WS_O2 = 814 * MiB, WS_END = 878 * MiB;
constexpr int CW_BAR = 4096;
constexpr int CW_CNT = 64;

DI unsigned f2bf(float f) { unsigned u = __builtin_bit_cast(unsigned, f); return (u + 0x7fffu + ((u >> 16) & 1u)) >> 16; }
DI unsigned pk2(float lo, float hi) { return f2bf(lo) | (f2bf(hi) << 16); }
DI float bflo(unsigned w) { return __builtin_bit_cast(float, w << 16); }
DI float bfhi(unsigned w) { return __builtin_bit_cast(float, w & 0xffff0000u); }
#define swz_xor(v, pat) __builtin_bit_cast(float, __builtin_amdgcn_ds_swizzle(__builtin_bit_cast(int, (float)(v)), (pat)))
#define SWZ_X1 0x041F
#define SWZ_X2 0x081F
#define SWZ_X4 0x101F
#define SWZ_X8 0x201F
#define SWZ_X16 0x401F
DI float xor32_sum(float v) { const unsigned u = __builtin_bit_cast(unsigned, v); const auto r = __builtin_amdgcn_permlane32_swap(u, u, false, false); return __builtin_bit_cast(float, (unsigned)r[0]) + __builtin_bit_cast(float, (unsigned)r[1]); }
DI float xor32_max(float v) { const unsigned u = __builtin_bit_cast(unsigned, v); const auto r = __builtin_amdgcn_permlane32_swap(u, u, false, false); return fmaxf(__builtin_bit_cast(float, (unsigned)r[0]), __builtin_bit_cast(float, (unsigned)r[1])); }
DI float wave_sum(float v) {
    v += swz_xor(v, SWZ_X1); v += swz_xor(v, SWZ_X2); v += swz_xor(v, SWZ_X4); v += swz_xor(v, SWZ_X8); v += swz_xor(v, SWZ_X16);
    return xor32_sum(v);
}
DI float sigmoidf_(float x) { return 1.0f / (1.0f + __expf(-x)); }
DI float siluf_(float x) { return x / (1.0f + __expf(-x)); }
#define LDS_WAIT() asm volatile("s_waitcnt lgkmcnt(0)" ::: "memory")

#define XB_TMO      128
#define XB_XCNT(j)  (256  + 64 * (j))
#define XB_XSUB(j)  (1280 + 64 * (j))
#define XB_XGEN(j)  (2304 + 64 * (j))
#define XB_TOP      3328
#define XB_TOPGEN   3392
#define XCD_BAR_WORDS 3456
#define XB_SPIN_CAP (1u << 18)
__device__ __forceinline__ unsigned xb_ld(unsigned* p)              { return __hip_atomic_load(p, __ATOMIC_RELAXED, __HIP_MEMORY_SCOPE_AGENT); }
__device__ __forceinline__ unsigned xb_add(unsigned* p, unsigned v) { return __hip_atomic_fetch_add(p, v, __ATOMIC_RELAXED, __HIP_MEMORY_SCOPE_AGENT); }
__device__ __forceinline__ unsigned xb_xcc_id() { return (unsigned)__builtin_amdgcn_s_getreg((3 << 11) | 20) & 0xFu; }
#define XB_SPIN(cond, bar) do { unsigned _sp = 0; while (cond) { __builtin_amdgcn_s_sleep(1); \
    if ((++_sp & 255u) == 0u) { if (xb_ld(&(bar)[XB_TMO])) break; if (_sp > XB_SPIN_CAP) { atomicAdd(&(bar)[XB_TMO], 1u); break; } } } } while (0)
struct XcdBarrier { unsigned* bar; unsigned x; volatile LAS unsigned* st; };
__device__ __forceinline__ XcdBarrier xcd_barrier_post(unsigned* bar, volatile LAS unsigned* st) {
    XcdBarrier b; b.bar = bar; b.x = xb_xcc_id(); b.st = st;
    if (threadIdx.x == 0) (void)xb_add(&bar[XB_XCNT(b.x)], 1u);
    return b;
}
__device__ __forceinline__ void xcd_barrier_complete(unsigned* bar, unsigned x, unsigned& nloc, unsigned& nx) {
    const unsigned G = gridDim.x * gridDim.y * gridDim.z;
    unsigned sum, cnt, mine, sp = 0u;
    for (;;) {
        sum = 0u; cnt = 0u; mine = 0u;
#pragma unroll
        for (unsigned j = 0; j < 16; ++j) { const unsigned c = xb_ld(&bar[XB_XCNT(j)]); sum += c; cnt += (c > 0u) ? 1u : 0u; mine = (j == x) ? c : mine; }
        if (sum == G) break;
        __builtin_amdgcn_s_sleep(1);
        if ((++sp & 255u) == 0u) { if (xb_ld(&bar[XB_TMO])) break; if (sp > XB_SPIN_CAP) { atomicAdd(&bar[XB_TMO], 1u); break; } }
    }
    nloc = mine > 0u ? mine : 1u; nx = cnt > 0u ? cnt : 1u;
}
__device__ __forceinline__ void xcd_barrier(const XcdBarrier& b) {
    asm volatile("s_waitcnt vmcnt(0)" ::: "memory");
    __syncthreads();
    if (threadIdx.x == 0) {
        unsigned* bar = b.bar;
        __builtin_amdgcn_s_waitcnt(0);
        unsigned nloc = b.st[0], nx = b.st[1];
        if (nloc == 0u) { xcd_barrier_complete(bar, b.x, nloc, nx); b.st[0] = nloc; b.st[1] = nx; }
        const unsigned old = xb_add(&bar[XB_XSUB(b.x)], 1u);
        const unsigned gen = old / nloc;
        if (old + 1u == (gen + 1u) * nloc) {
            __builtin_amdgcn_fence(__ATOMIC_RELEASE, "agent");
            asm volatile("s_waitcnt vmcnt(0)" ::: "memory");
            const unsigned og = xb_add(&bar[XB_TOP], 1u);
            const unsigned tg = og / nx;
            if (og + 1u == (tg + 1u) * nx) xb_add(&bar[XB_TOPGEN], 1u);
            else XB_SPIN(xb_ld(&bar[XB_TOPGEN]) == tg, bar);
            __builtin_amdgcn_fence(__ATOMIC_ACQUIRE, "agent");
            xb_add(&bar[XB_XGEN(b.x)], 1u);
            asm volatile("s_waitcnt vmcnt(0)" ::: "memory");
        } else {
            XB_SPIN(xb_ld(&bar[XB_XGEN(b.x)]) == gen, bar);
            __builtin_amdgcn_fence(__ATOMIC_ACQUIRE, "agent");
            asm volatile("s_waitcnt vmcnt(0)" ::: "memory");
        }
    }
    __syncthreads();
}

namespace g8 {
constexpr int BM = 256, BK = 64, HALF = 128, HTB = HALF * BK * 2, STAGE_BYTES = 8 * HTB, NXCD = 8, WGM = 8;
DI int lds_byte(int r, int c) { const int st = (r >> 4) * 2 + (c >> 5), rr = r & 15, cc = c & 31, ob = rr * 64 + cc * 2; return st * 1024 + (ob ^ (((ob >> 9) & 1) << 5)); }
DI void stage_rc(int b, int& R, int& C) { const int st = b / 1024, sb = b % 1024, swz = sb ^ (((sb >> 9) & 1) << 5); R = (st >> 1) * 16 + swz / 64; C = (st & 1) * 32 + (swz % 64) / 2; }
DI int perm32(int rho) { const int n = rho >> 4, i = rho & 15; return 8 * (i >> 2) + 4 * n + (i & 3); }

struct Unit { const char* B; int m0, n0, rows, e; };

template <int M_, int N_, int K_> struct DenseSched {
    static constexpr bool GATHER = false;
    static constexpr int nM = M_ / BM, nN = N_ / BM, nwg = nM * nN, K = K_;
    int G, c; const char* Bt;
    DI void init(const void* Bt_, int G_, int c_) { G = G_; c = c_; Bt = (const char*)Bt_; }
    DI bool next(int i, Unit& u) const {
        const int L = i * G + c; if (L >= nwg) return false;
        int wgid = L; { constexpr int q = nwg / NXCD, r = nwg % NXCD; const int xcd = wgid % NXCD, off = wgid / NXCD; wgid = (xcd < r ? xcd * (q + 1) : r * (q + 1) + (xcd - r) * q) + off; }
        constexpr int nig = WGM * nN; const int gid = wgid / nig, fm = gid * WGM, gsz = (nM - fm) < WGM ? (nM - fm) : WGM;
        const int pm = fm + ((wgid % nig) % gsz), pn = (wgid % nig) / gsz;
        u.m0 = pm * BM; u.n0 = pn * BM; u.rows = BM; u.e = 0; u.B = Bt + (size_t)pn * BM * K * 2; return true;
    }
    DI unsigned arow(const Unit& u, int r) const { return (unsigned)(u.m0 + r); }
};
template <bool TOKEN_ROWS> struct MoeSched {
    static constexpr bool GATHER = true;
    const LAS int* tab; const int* list; const char* W; size_t wstride; int NB, K, G, c, total;
    DI bool next(int i, Unit& u) const {
        const int L = i * G + c; if (L >= total) return false;
        const int mt = L / NB, nb = L - mt * NB;
        int e = 0;
#pragma unroll
        for (int j = 1; j < 16; ++j) e += (tab[j] <= mt) ? 1 : 0;
        const int ti = mt - tab[e], cnt = tab[17 + e];
        u.e = e; u.m0 = e * NTOK + ti * BM; u.rows = (cnt - ti * BM) < BM ? (cnt - ti * BM) : BM; u.n0 = nb * BM;
        u.B = W + (size_t)e * wstride + (size_t)nb * BM * K * 2; return true;
    }
    DI unsigned arow(const Unit& u, int r) const { const int rr = r < u.rows ? r : 0; const unsigned en = (unsigned)list[u.m0 + rr]; return TOKEN_ROWS ? (en & (NTOK - 1)) : en; }
};

DI unsigned cvt_pk_bf16(float lo, float hi) { unsigned r; asm volatile("v_cvt_pk_bf16_f32 %0, %1, %2" : "=v"(r) : "v"(lo), "v"(hi)); return r; }

struct EpiBf16 {
    static constexpr bool PERM = true;
    bf16* O; int ldc;
    DI void operator()(const f32x4 (&acc)[2][2][4][2], const Unit& u, int wr, int wc, int fr, int fq) const {
        const int row0 = u.m0 + wr * 64 + fr, col0 = u.n0 + wc * 32 + 8 * fq;
#pragma unroll
        for (int ai = 0; ai < 2; ++ai)
#pragma unroll
            for (int m = 0; m < 4; ++m) { bf16* rowp = O + (size_t)(row0 + ai * HALF + m * 16) * ldc + col0;
#pragma unroll
                for (int bj = 0; bj < 2; ++bj) { const f32x4 v0 = acc[ai][bj][m][0], v1 = acc[ai][bj][m][1];
                    u32x4 w; w.x = cvt_pk_bf16(v0[0], v0[1]); w.y = cvt_pk_bf16(v0[2], v0[3]); w.z = cvt_pk_bf16(v1[0], v1[1]); w.w = cvt_pk_bf16(v1[2], v1[3]);
                    *(u32x4*)(rowp + bj * HALF) = w; } }
    }
};
struct EpiResid {
    static constexpr bool PERM = false;
    const float* X; float* Y;
    DI void operator()(const f32x4 (&acc)[2][2][4][2], const Unit& u, int wr, int wc, int fr, int fq) const {
        const int row0 = u.m0 + wr * 64 + fr, col0 = u.n0 + wc * 32 + 4 * fq;
#pragma unroll
        for (int ai = 0; ai < 2; ++ai)
#pragma unroll
            for (int m = 0; m < 4; ++m) { const size_t off = (size_t)(row0 + ai * HALF + m * 16) * DM + col0;
#pragma unroll
                for (int bj = 0; bj < 2; ++bj)
#pragma unroll
                    for (int n = 0; n < 2; ++n) { const f32x4 xr = *(const f32x4*)(X + off + bj * HALF + n * 16); *(f32x4*)(Y + off + bj * HALF + n * 16) = xr * ALPHA + acc[ai][bj][m][n]; } }
    }
};
struct EpiSwiglu {
    static constexpr bool PERM = true;
    bf16* H; const int* list; const float* wsel;
    DI void operator()(const f32x4 (&acc)[2][2][4][2], const Unit& u, int wr, int wc, int fr, int fq) const {
        const int col0 = (u.n0 >> 1) + wc * 32 + 8 * fq;
#pragma unroll
        for (int ai = 0; ai < 2; ++ai)
#pragma unroll
            for (int m = 0; m < 4; ++m) { const int r = ai * HALF + wr * 64 + m * 16 + fr;
                if (r < u.rows) { const int en = list[u.m0 + r]; const float ws = wsel[en];
                    const f32x4 g0 = acc[ai][0][m][0], g1 = acc[ai][0][m][1], u0 = acc[ai][1][m][0], u1 = acc[ai][1][m][1];
                    float h[8];
#pragma unroll
                    for (int j = 0; j < 4; ++j) { h[j] = siluf_(g0[j]) * u0[j] * ws; h[4 + j] = siluf_(g1[j]) * u1[j] * ws; }
                    u32x4 w; w.x = cvt_pk_bf16(h[0], h[1]); w.y = cvt_pk_bf16(h[2], h[3]); w.z = cvt_pk_bf16(h[4], h[5]); w.w = cvt_pk_bf16(h[6], h[7]);
                    *(u32x4*)(H + (size_t)en * DEXP + col0) = w; } }
    }
};
struct EpiDown {
    static constexpr bool PERM = true;
    bf16* O; const int* list;
    DI void operator()(const f32x4 (&acc)[2][2][4][2], const Unit& u, int wr, int wc, int fr, int fq) const {
        const int col0 = u.n0 + wc * 32 + 8 * fq;
#pragma unroll
        for (int ai = 0; ai < 2; ++ai)
#pragma unroll
            for (int m = 0; m < 4; ++m) { const int r = ai * HALF + wr * 64 + m * 16 + fr;
                if (r < u.rows) { const int en = list[u.m0 + r]; bf16* rowp = O + (size_t)en * DM + col0;
#pragma unroll
                    for (int bj = 0; bj < 2; ++bj) { const f32x4 v0 = acc[ai][bj][m][0], v1 = acc[ai][bj][m][1];
                        u32x4 w; w.x = cvt_pk_bf16(v0[0], v0[1]); w.y = cvt_pk_bf16(v0[2], v0[3]); w.z = cvt_pk_bf16(v1[0], v1[1]); w.w = cvt_pk_bf16(v1[2], v1[3]);
                        *(u32x4*)(rowp + bj * HALF) = w; } } }
    }
};

template <class Epi, class Sched>
DI void gemm_phase(LAS unsigned char* lds, const int wave_id, const char* Abase, const int K, const Sched& S, const Epi& E) {
    int z_ = 0; asm volatile("" : "+v"(z_));
    const int lane = __builtin_amdgcn_mbcnt_hi(-1, __builtin_amdgcn_mbcnt_lo(-1, z_)), wid = wave_id, tid = wid * 64 + lane, wr = wid >> 2, wc = wid & 3, fr = lane & 15, fq = lane >> 4;
    const int nt = K / BK;
    constexpr bool GATHER = Sched::GATHER;
    int Rr[2]; unsigned C2[2], voffB[2], voffA[2];
#pragma unroll
    for (int i = 0; i < 2; ++i) { int R, C; stage_rc(tid * 16 + i * 8192, R, C); const int Rb = Epi::PERM ? ((R & ~31) + perm32(R & 31)) : R;
        Rr[i] = R; C2[i] = (unsigned)C * 2u; voffB[i] = (unsigned)(Rb * K + C) * 2u; voffA[i] = (unsigned)(R * K + C) * 2u; }
    const size_t kstep = (size_t)(BK * 2);
    const size_t hstepB = (size_t)HALF * K * 2;
    const size_t tstepA = (size_t)K * 2;
    const unsigned ldsw = (unsigned)wid * 1024u;
    const int aoff = lds_byte(wr * 64 + fr, fq * 8), boff = lds_byte(wc * 32 + fr, fq * 8);
#define G8_SA(b, h) (((b) * 2 + (h)) * HTB)
#define G8_SB(b, h) ((4 + (b) * 2 + (h)) * HTB)
#define G8_STAGE(bufoff, gbase, voff) do { _Pragma("unroll") for (int _i = 0; _i < 2; ++_i) \
        __builtin_amdgcn_global_load_lds((const unsigned*)((const char*)(gbase) + (voff)[_i]), (LAS unsigned*)(lds + (bufoff) + ldsw + _i * 8192), 16, 0, 0); } while (0)
#define G8_LDA(dst, b, h) do { _Pragma("unroll") for (int m = 0; m < 4; ++m) _Pragma("unroll") for (int k = 0; k < 2; ++k) dst[m][k] = *(const LAS bf16x8*)(lds + G8_SA(b, h) + aoff + m * 2048 + k * 1024); } while (0)
#define G8_LDB(dst, b, h) do { _Pragma("unroll") for (int n = 0; n < 2; ++n) _Pragma("unroll") for (int k = 0; k < 2; ++k) dst[n][k] = *(const LAS bf16x8*)(lds + G8_SB(b, h) + boff + n * 2048 + k * 1024); } while (0)
#define G8_MMA(ai, bj, At, Bt) do { __builtin_amdgcn_s_setprio(1); _Pragma("unroll") for (int m = 0; m < 4; ++m) _Pragma("unroll") for (int n = 0; n < 2; ++n) _Pragma("unroll") for (int k = 0; k < 2; ++k) \
        acc[ai][bj][m][n] = __builtin_amdgcn_mfma_f32_16x16x32_bf16(Bt[n][k], At[m][k], acc[ai][bj][m][n], 0, 0, 0); __builtin_amdgcn_s_setprio(0); } while (0)
#define G8_WAIT_V(n) asm volatile("s_waitcnt vmcnt(" #n ")" ::: "memory")
#define G8_WAIT_L(n) asm volatile("s_waitcnt lgkmcnt(" #n ")" ::: "memory")
#define G8_BAR __builtin_amdgcn_s_barrier()
#define G8_SCHED __builtin_amdgcn_sched_barrier(0)
    Unit cur, nxt; int ui = 0;
    if (!S.next(0, cur)) return;
    f32x4 acc[2][2][4][2];
#pragma unroll
    for (int a = 0; a < 2; ++a)
#pragma unroll
        for (int b = 0; b < 2; ++b)
#pragma unroll
            for (int m = 0; m < 4; ++m)
#pragma unroll
                for (int n = 0; n < 2; ++n) acc[a][b][m][n] = (f32x4){0.f, 0.f, 0.f, 0.f};
    bf16x8 At[4][2], B0[2][2], B1[2][2];
    unsigned vAc[2][2], vAn[2][2];
    const char* cA0 = Abase; const char* cA1 = Abase;
    if constexpr (GATHER) {
#pragma unroll
        for (int h = 0; h < 2; ++h)
#pragma unroll
            for (int i = 0; i < 2; ++i) vAc[h][i] = S.arow(cur, h * HALF + Rr[i]) * (unsigned)(K * 2) + C2[i];
    } else {
        cA0 = Abase + (size_t)cur.m0 * tstepA; cA1 = cA0 + (size_t)HALF * tstepA;
#pragma unroll
        for (int h = 0; h < 2; ++h)
#pragma unroll
            for (int i = 0; i < 2; ++i) vAc[h][i] = voffA[i];
    }
    const char* cB = cur.B;
    G8_STAGE(G8_SB(0, 0), cB, voffB); G8_STAGE(G8_SA(0, 0), cA0, vAc[0]); G8_STAGE(G8_SB(0, 1), cB + hstepB, voffB); G8_STAGE(G8_SA(0, 1), cA1, vAc[1]);
    if (wr == 1) G8_BAR;
    G8_WAIT_V(4); G8_BAR;
    G8_STAGE(G8_SB(1, 0), cB + kstep, voffB); G8_STAGE(G8_SA(1, 0), cA0 + kstep, vAc[0]); G8_STAGE(G8_SB(1, 1), cB + hstepB + kstep, voffB);
    G8_WAIT_V(6); G8_BAR;
    for (;;) {
        const bool has_next = S.next(ui + 1, nxt);
        const char* nB = has_next ? nxt.B : cB;
        const char* nA0 = cA0; const char* nA1 = cA1;
        if constexpr (GATHER) {
#pragma unroll
            for (int h = 0; h < 2; ++h)
#pragma unroll
                for (int i = 0; i < 2; ++i) vAn[h][i] = has_next ? (S.arow(nxt, h * HALF + Rr[i]) * (unsigned)(K * 2) + C2[i]) : vAc[h][i];
        } else {
            if (has_next) { nA0 = Abase + (size_t)nxt.m0 * tstepA; nA1 = nA0 + (size_t)HALF * tstepA; }
        }
        for (int t = 0; t < nt; t += 2) {
            const bool last = (t == nt - 2);
            const char* a1h1 = cA1 + (size_t)(t + 1) * kstep;
            const char* a2h0 = last ? nA0 : cA0 + (size_t)(t + 2) * kstep; const char* a2h1 = last ? nA1 : cA1 + (size_t)(t + 2) * kstep;
            const char* b2 = last ? nB : cB + (size_t)(t + 2) * kstep;
            const char* a3h0 = a2h0 + kstep; const char* b3 = b2 + kstep;
            unsigned va2[2][2];
#pragma unroll
            for (int h = 0; h < 2; ++h)
#pragma unroll
                for (int i = 0; i < 2; ++i) va2[h][i] = (GATHER && last) ? vAn[h][i] : vAc[h][i];
            G8_LDB(B0, 0, 0); G8_SCHED; G8_LDA(At, 0, 0); G8_STAGE(G8_SA(1, 1), a1h1, vAc[1]);
            G8_WAIT_L(8); G8_BAR; G8_WAIT_L(0); G8_MMA(0, 0, At, B0); G8_BAR; G8_SCHED;
            G8_LDB(B1, 0, 1); G8_STAGE(G8_SB(0, 0), b2, voffB);
            G8_BAR; G8_WAIT_L(0); G8_MMA(0, 1, At, B1); G8_BAR;
            G8_LDA(At, 0, 1); G8_STAGE(G8_SA(0, 0), a2h0, va2[0]);
            G8_BAR; G8_WAIT_L(0); G8_MMA(1, 0, At, B0); G8_BAR; G8_SCHED;
            G8_STAGE(G8_SB(0, 1), b2 + hstepB, voffB);
            G8_WAIT_V(6); G8_BAR; G8_MMA(1, 1, At, B1); G8_BAR;
            G8_LDB(B0, 1, 0); G8_SCHED; G8_LDA(At, 1, 0); G8_STAGE(G8_SA(0, 1), a2h1, va2[1]);
            G8_WAIT_L(8); G8_BAR; G8_WAIT_L(0); G8_MMA(0, 0, At, B0); G8_BAR; G8_SCHED;
            G8_LDB(B1, 1, 1); G8_STAGE(G8_SB(1, 0), b3, voffB);
            G8_BAR; G8_WAIT_L(0); G8_MMA(0, 1, At, B1); G8_BAR;
            G8_LDA(At, 1, 1); G8_STAGE(G8_SA(1, 0), a3h0, va2[0]);
            G8_BAR; G8_WAIT_L(0); G8_MMA(1, 0, At, B0); G8_BAR; G8_SCHED;
            G8_STAGE(G8_SB(1, 1), b3 + hstepB, voffB);
            G8_WAIT_V(6); G8_BAR; G8_MMA(1, 1, At, B1); G8_BAR;
        }
        E(acc, cur, wr, wc, fr, fq);
        if (!has_next) break;
#pragma unroll
        for (int a = 0; a < 2; ++a)
#pragma unroll
            for (int b = 0; b < 2; ++b)
#pragma unroll
                for (int m = 0; m < 4; ++m)
#pragma unroll
                    for (int n = 0; n < 2; ++n) acc[a][b][m][n] = (f32x4){0.f, 0.f, 0.f, 0.f};
        cur = nxt; cB = nB; cA0 = nA0; cA1 = nA1; ++ui;
        if constexpr (GATHER) {
#pragma unroll
            for (int h = 0; h < 2; ++h)
#pragma unroll
                for (int i = 0; i < 2; ++i) vAc[h][i] = vAn[h][i];
        }
    }
    G8_WAIT_V(0);
    if (wr == 0) G8_BAR;
    G8_BAR;
#undef G8_SA
#undef G8_SB
#undef G8_STAGE
#undef G8_LDA
#undef G8_LDB
#undef G8_MMA
#undef G8_WAIT_V
#undef G8_WAIT_L
#undef G8_BAR
#undef G8_SCHED
}
}

constexpr int NWAVES = 8, NTHREADS = 512;
constexpr int RING_BYTES = 131072;
constexpr int LN_STRIDE = 2052;
constexpr int LN_TILE_BYTES = 16 * LN_STRIDE * 4;
constexpr int LN_PART_OFF = LN_TILE_BYTES, LN_LOGIT_OFF = LN_PART_OFF + 8192;
constexpr int MOETAB_OFF = 141312;
constexpr int MISC_OFF = 141824;
constexpr int LDS_BYTES = 147456;
static_assert(LN_LOGIT_OFF + 1024 <= MOETAB_OFF && MISC_OFF + 16 <= LDS_BYTES, "LDS map");

struct Frame {
    LAS unsigned char* lds;
    int tid, lane, wave, G, bid;
    unsigned char* ws;
    const float* const* in;
    float* out;
};
enum { I_X = 0, I_POS, I_WIN, I_SINK, I_CONVW, I_ALOG, I_DTB, I_DNW, I_WOUT, I_LN1G, I_LN1B, I_RW, I_RB, I_WG, I_WU, I_WDN, I_LN2G, I_LN2B };

DI void transpose_item(const float* W, int ldw, bf16* WT, int ldt, int k0, int n0, int drow0, LAS float* scr, int lane) {
#pragma unroll 8
    for (int i = 0; i < 32; ++i) { const int kk = 2 * i + (lane >> 5); scr[kk * 33 + (lane & 31)] = W[(size_t)(k0 + kk) * ldw + n0 + (lane & 31)]; }
    LDS_WAIT(); asm volatile("" ::: "memory");
    const int c = lane & 7;
#pragma unroll
    for (int j = 0; j < 4; ++j) { const int n = (lane >> 3) + 8 * j; const LAS float* s = scr + (8 * c) * 33 + n;
        u32x4 o; o.x = pk2(s[0 * 33], s[1 * 33]); o.y = pk2(s[2 * 33], s[3 * 33]); o.z = pk2(s[4 * 33], s[5 * 33]); o.w = pk2(s[6 * 33], s[7 * 33]);
        *(GAS u32x4*)(WT + (size_t)(drow0 + n) * ldt + k0 + 8 * c) = o; }
    LDS_WAIT(); asm volatile("" ::: "memory");
}
DI void convw_phase(Frame& F, int l, int slot) {
    LAS float* scr = (LAS float*)(F.lds + F.wave * 16384);
    const int gw = F.bid * NWAVES + F.wave, NGW = F.G * NWAVES;
    bf16* win_t = (bf16*)(F.ws + WS_WIN) + (size_t)slot * PN * DM;
    bf16* wout_t = (bf16*)(F.ws + WS_WOUT) + (size_t)slot * DM * DM;
    bf16* wgu_t = (bf16*)(F.ws + WS_WGU) + (size_t)slot * NEXP * 1024 * DM;
    bf16* wd_t = (bf16*)(F.ws + WS_WD) + (size_t)slot * NEXP * DM * DEXP;
    const float* w_in = F.in[I_WIN] + (size_t)l * DM * PROJ;
    const float* w_out = F.in[I_WOUT] + (size_t)l * DM * DM;
    const float* w_g = F.in[I_WG] + (size_t)l * NEXP * DM * DEXP;
    const float* w_u = F.in[I_WU] + (size_t)l * NEXP * DM * DEXP;
    const float* w_d = F.in[I_WDN] + (size_t)l * NEXP * DEXP * DM;
    constexpr int I_IN = 32 * 168, I_OUT = 32 * 64, I_GU = 32 * 16, I_D = 8 * 64, I_E = 2 * I_GU + I_D;
    constexpr int NITEMS = I_IN + I_OUT + NEXP * I_E;
    for (int it = gw; it < NITEMS; it += NGW) {
        int r = it;
        if (r < I_IN) { const int kb = r / 168, nb = r % 168; transpose_item(w_in, PROJ, win_t, DM, kb * 64, nb * 32, nb * 32, scr, F.lane); continue; } r -= I_IN;
        if (r < I_OUT) { const int kb = r / 64, nb = r % 64; transpose_item(w_out, DM, wout_t, DM, kb * 64, nb * 32, nb * 32, scr, F.lane); continue; } r -= I_OUT;
        const int e = r / I_E; r -= e * I_E;
        if (r < 2 * I_GU) { const int up = r / I_GU; r -= up * I_GU; const int kb = r / 16, nb = r % 16, n0 = nb * 32;
            const int drow0 = (n0 >> 7) * 256 + up * 128 + (n0 & 127);
            transpose_item((up ? w_u : w_g) + (size_t)e * DM * DEXP, DEXP, wgu_t + (size_t)e * 1024 * DM, DM, kb * 64, n0, drow0, scr, F.lane); continue; }
        r -= 2 * I_GU;
        { const int kb = r / 64, nb = r % 64; transpose_item(w_d + (size_t)e * DEXP * DM, DM, wd_t + (size_t)e * DM * DEXP, DEXP, kb * 64, nb * 32, nb * 32, scr, F.lane); }
    }
}

DI void rope_phase(Frame& F) {
    float* cs = (float*)(F.ws + WS_COS); float* sn = (float*)(F.ws + WS_SIN);
    const int* pos = (const int*)F.in[I_POS];
    for (int i = F.bid * NTHREADS + F.tid; i < NTOK * 32; i += F.G * NTHREADS) {
        const int t = i >> 5, d = i & 31;
        const float inv = exp2f(-(float)d * (13.287712379549449f / 32.0f));
        const float ang = (float)pos[t] * inv;
        cs[i] = cosf(ang); sn[i] = sinf(ang);
    }
}

template <int MODE>
DI void ln_phase(Frame& F, const float* src, const bf16* o2, const float* gam, const float* bet, float* of32, bf16* obf, const float* W16, int ldw, bool do_logits,
                 float* ab, const float* rbias, unsigned* cnt, int* list, float* wsel) {
    LAS float* tile = (LAS float*)F.lds;
    LAS float* part = (LAS float*)(F.lds + LN_PART_OFF);
    LAS float* logit = (LAS float*)(F.lds + LN_LOGIT_OFF);
    const int lane = F.lane, w = F.wave;
    for (int unit = F.bid; unit < NTOK / 16; unit += F.G) {
        const int row0 = unit * 16;
#pragma unroll 1
        for (int rr = 0; rr < 2; ++rr) {
            const int rl = 2 * w + rr, row = row0 + rl;
            f32x4 v[8];
            const GAS f32x4* sp = (const GAS f32x4*)(src + (size_t)row * DM) + lane;
#pragma unroll
            for (int j = 0; j < 8; ++j) v[j] = sp[64 * j];
            if (MODE == 2) {
                const GAS u32x2* pa = (const GAS u32x2*)(o2 + (size_t)row * DM) + lane;
                const GAS u32x2* pb = (const GAS u32x2*)(o2 + (size_t)(NTOK + row) * DM) + lane;
#pragma unroll
                for (int j = 0; j < 8; ++j) { const u32x2 a = pa[64 * j], b = pb[64 * j];
                    v[j].x = v[j].x * ALPHA + (bflo(a.x) + bflo(b.x)); v[j].y = v[j].y * ALPHA + (bfhi(a.x) + bfhi(b.x));
                    v[j].z = v[j].z * ALPHA + (bflo(a.y) + bflo(b.y)); v[j].w = v[j].w * ALPHA + (bfhi(a.y) + bfhi(b.y)); }
            }
            if (MODE != 0) {
                float s = 0.f;
#pragma unroll
                for (int j = 0; j < 8; ++j) s += (v[j].x + v[j].y) + (v[j].z + v[j].w);
                const float mean = wave_sum(s) * (1.0f / DM); float s2 = 0.f;
#pragma unroll
                for (int j = 0; j < 8; ++j) { v[j] = v[j] - mean; s2 += (v[j].x * v[j].x + v[j].y * v[j].y) + (v[j].z * v[j].z + v[j].w * v[j].w); }
                const float rstd = 1.0f / sqrtf(wave_sum(s2) * (1.0f / DM) + LN_EPS);
#pragma unroll
                for (int j = 0; j < 8; ++j) { const f32x4 g4 = *((const GAS f32x4*)gam + lane + 64 * j), b4 = *((const GAS f32x4*)bet + lane + 64 * j); v[j] = v[j] * rstd * g4 + b4; }
            }
            if (of32) { GAS f32x4* op = (GAS f32x4*)(of32 + (size_t)row * DM) + lane;
#pragma unroll
                for (int j = 0; j < 8; ++j) op[64 * j] = v[j]; }
            { GAS u32x2* op = (GAS u32x2*)(obf + (size_t)row * DM) + lane;
#pragma unroll
                for (int j = 0; j < 8; ++j) { u32x2 o; o.x = pk2(v[j].x, v[j].y); o.y = pk2(v[j].z, v[j].w); op[64 * j] = o; } }
            if (do_logits) {
#pragma unroll
                for (int j = 0; j < 8; ++j) *(LAS f32x4*)(tile + rl * LN_STRIDE + 4 * lane + 256 * j) = v[j];
            }
        }
        if (do_logits) {
            __syncthreads();
            const int m = lane & 15, kq = lane >> 4;
            f32x4 acc = (f32x4){0.f, 0.f, 0.f, 0.f};
            const int kb = 256 * w;
#pragma unroll 4
            for (int s = 0; s < 16; ++s) {
                const int k = kb + 16 * s + 4 * kq;
                const f32x4 a4 = *(const LAS f32x4*)(tile + m * LN_STRIDE + k);
                const float* wp = W16 + (size_t)k * ldw + m;
                const float b0 = wp[0], b1 = wp[ldw], b2 = wp[2 * (size_t)ldw], b3 = wp[3 * (size_t)ldw];
                acc = __builtin_amdgcn_mfma_f32_16x16x4f32(a4.x, b0, acc, 0, 0, 0);
                acc = __builtin_amdgcn_mfma_f32_16x16x4f32(a4.y, b1, acc, 0, 0, 0);
                acc = __builtin_amdgcn_mfma_f32_16x16x4f32(a4.z, b2, acc, 0, 0, 0);
                acc = __builtin_amdgcn_mfma_f32_16x16x4f32(a4.w, b3, acc, 0, 0, 0);
            }
#pragma unroll
            for (int r = 0; r < 4; ++r) part[(w * 16 + 4 * kq + r) * 16 + m] = acc[r];
            __syncthreads();
            if (F.tid < 256) {
                const int r = F.tid >> 4, n = F.tid & 15; float s = 0.f;
#pragma unroll
                for (int ww = 0; ww < 8; ++ww) s += part[(ww * 16 + r) * 16 + n];
                if (MODE == 1) logit[r * 16 + n] = s; else ab[(size_t)(row0 + r) * 16 + n] = s;
            }
            if (MODE == 1) {
                __syncthreads();
                if (F.tid < 16) {
                    const int tok = row0 + F.tid;
                    float sc[16], sel[16];
#pragma unroll
                    for (int e = 0; e < 16; ++e) { sc[e] = sigmoidf_(logit[F.tid * 16 + e]); sel[e] = sc[e] + rbias[e]; }
                    int bg = 0; float bgv = -1e30f; int be0[4], be1[4];
#pragma unroll
                    for (int g = 0; g < 4; ++g) {
                        int i0 = 0; float v0 = sel[4 * g];
#pragma unroll
                        for (int j = 1; j < 4; ++j) if (sel[4 * g + j] > v0) { v0 = sel[4 * g + j]; i0 = j; }
                        int i1 = -1; float v1 = -1e30f;
#pragma unroll
                        for (int j = 0; j < 4; ++j) if (j != i0 && sel[4 * g + j] > v1) { v1 = sel[4 * g + j]; i1 = j; }
                        be0[g] = 4 * g + i0; be1[g] = 4 * g + i1;
                        const float sum = v0 + v1; if (sum > bgv) { bgv = sum; bg = g; }
                    }
                    int e0 = be0[0], e1 = be1[0];
#pragma unroll
                    for (int g = 1; g < 4; ++g) if (bg == g) { e0 = be0[g]; e1 = be1[g]; }
                    float w0 = 0.f, w1 = 0.f;
#pragma unroll
                    for (int e = 0; e < 16; ++e) { if (e == e0) w0 = sc[e]; if (e == e1) w1 = sc[e]; }
                    const float inv = 1.0f / (w0 + w1);
                    const unsigned p0 = atomicAdd(cnt + e0, 1u); list[e0 * NTOK + p0] = tok; wsel[tok] = w0 * inv;
                    const unsigned p1 = atomicAdd(cnt + e1, 1u); list[e1 * NTOK + p1] = NTOK + tok; wsel[NTOK + tok] = w1 * inv;
                }
            }
            __syncthreads();
        }
    }
}

constexpr int KT_PITCH = 72, VT_PITCH = 264;
constexpr int ATT_KT_OFF = 0, ATT_VT_OFF = 256 * KT_PITCH * 2;
DI void attn_unit(Frame& F, int unit, int l) {
    const int b = unit >> 6, kvh = (unit >> 5) & 1, qb = unit & 31;
    const bf16* proj = (const bf16*)(F.ws + WS_PROJ);
    const float* cs = (const float*)(F.ws + WS_COS); const float* sn = (const float*)(F.ws + WS_SIN);
    bf16* cat = (bf16*)(F.ws + WS_CAT);
    LAS unsigned char* kt = F.lds + ATT_KT_OFF; LAS unsigned char* vt = F.lds + ATT_VT_OFF;
    const int tq0 = b * SEQ + qb * 128, tk0 = tq0 - 128;
#pragma unroll
    for (int it = 0; it < 2; ++it) {
        const int idx = F.tid + it * NTHREADS, kj = idx >> 2, c = idx & 3;
        int tk = tk0 + kj; if (tk < b * SEQ) tk = b * SEQ;
        const bf16* kp = proj + (size_t)tk * PN + C_SK + kvh * 64;
        const u32x4 lo = *(const GAS u32x4*)(kp + 8 * c), hi = *(const GAS u32x4*)(kp + 32 + 8 * c);
        const f32x4 c0 = *(const GAS f32x4*)(cs + tk * 32 + 8 * c), c1 = *(const GAS f32x4*)(cs + tk * 32 + 8 * c + 4);
        const f32x4 s0 = *(const GAS f32x4*)(sn + tk * 32 + 8 * c), s1 = *(const GAS f32x4*)(sn + tk * 32 + 8 * c + 4);
        float x1[8], x2[8], cc[8], ss[8];
#pragma unroll
        for (int j = 0; j < 4; ++j) { x1[2 * j] = bflo(lo[j]); x1[2 * j + 1] = bfhi(lo[j]); x2[2 * j] = bflo(hi[j]); x2[2 * j + 1] = bfhi(hi[j]); cc[j] = c0[j]; cc[4 + j] = c1[j]; ss[j] = s0[j]; ss[4 + j] = s1[j]; }
        u32x4 o1, o2;
#pragma unroll
        for (int j = 0; j < 4; ++j) {
            o1[j] = pk2(x1[2 * j] * cc[2 * j] - x2[2 * j] * ss[2 * j], x1[2 * j + 1] * cc[2 * j + 1] - x2[2 * j + 1] * ss[2 * j + 1]);
            o2[j] = pk2(x2[2 * j] * cc[2 * j] + x1[2 * j] * ss[2 * j], x2[2 * j + 1] * cc[2 * j + 1] + x1[2 * j + 1] * ss[2 * j + 1]);
        }
        *(LAS u32x4*)(kt + kj * (KT_PITCH * 2) + 16 * c) = o1;
        *(LAS u32x4*)(kt + kj * (KT_PITCH * 2) + 64 + 16 * c) = o2;
    }
    {
        const int kj = F.tid & 255, dh = F.tid >> 8;
        int tk = tk0 + kj; if (tk < b * SEQ) tk = b * SEQ;
        const bf16* vp = proj + (size_t)tk * PN + C_SV + kvh * 64 + dh * 32;
#pragma unroll
        for (int q = 0; q < 4; ++q) { const u32x4 x = *(const GAS u32x4*)(vp + 8 * q);
#pragma unroll
            for (int j = 0; j < 4; ++j) { const int d = dh * 32 + 8 * q + 2 * j;
                *(LAS unsigned short*)(vt + (d * VT_PITCH + kj) * 2) = (unsigned short)(x[j] & 0xffffu);
                *(LAS unsigned short*)(vt + ((d + 1) * VT_PITCH + kj) * 2) = (unsigned short)(x[j] >> 16); } }
    }
    __syncthreads();
    const int lane = F.lane, n = lane & 15, q4 = lane >> 4, head = kvh * 8 + F.wave;
    const float sink = F.in[I_SINK][l * 16 + head];
#pragma unroll 1
    for (int qt = 0; qt < 8; ++qt) {
        const int qi = 16 * qt + n, tq = tq0 + qi;
        bf16x8 qf[2];
        {
            const bf16* qp = proj + (size_t)tq * PN + C_SQ + head * 64;
            const u32x4 lo = *(const GAS u32x4*)(qp + 8 * q4), hi = *(const GAS u32x4*)(qp + 32 + 8 * q4);
            const f32x4 c0 = *(const GAS f32x4*)(cs + tq * 32 + 8 * q4), c1 = *(const GAS f32x4*)(cs + tq * 32 + 8 * q4 + 4);
            const f32x4 s0 = *(const GAS f32x4*)(sn + tq * 32 + 8 * q4), s1 = *(const GAS f32x4*)(sn + tq * 32 + 8 * q4 + 4);
            float x1[8], x2[8], cc[8], ss[8];
#pragma unroll
            for (int j = 0; j < 4; ++j) { x1[2 * j] = bflo(lo[j]); x1[2 * j + 1] = bfhi(lo[j]); x2[2 * j] = bflo(hi[j]); x2[2 * j + 1] = bfhi(hi[j]); cc[j] = c0[j]; cc[4 + j] = c1[j]; ss[j] = s0[j]; ss[4 + j] = s1[j]; }
            u32x4 o1, o2;
#pragma unroll
            for (int j = 0; j < 4; ++j) {
                o1[j] = pk2(0.125f * (x1[2 * j] * cc[2 * j] - x2[2 * j] * ss[2 * j]), 0.125f * (x1[2 * j + 1] * cc[2 * j + 1] - x2[2 * j + 1] * ss[2 * j + 1]));
                o2[j] = pk2(0.125f * (x2[2 * j] * cc[2 * j] + x1[2 * j] * ss[2 * j]), 0.125f * (x2[2 * j + 1] * cc[2 * j + 1] + x1[2 * j + 1] * ss[2 * j + 1]));
            }
            qf[0] = __builtin_bit_cast(bf16x8, o1); qf[1] = __builtin_bit_cast(bf16x8, o2);
        }
        const int t0 = 2 * (qt >> 1);
        f32x4 s[10];
#pragma unroll
        for (int tt = 0; tt < 10; ++tt) {
            f32x4 a = (f32x4){0.f, 0.f, 0.f, 0.f};
#pragma unroll
            for (int kk = 0; kk < 2; ++kk) {
                const bf16x8 kf = *(const LAS bf16x8*)(kt + (16 * (t0 + tt) + n) * (KT_PITCH * 2) + 64 * kk + 16 * q4);
                a = __builtin_amdgcn_mfma_f32_16x16x32_bf16(kf, qf[kk], a, 0, 0, 0);
            }
            s[tt] = a;
        }
        float mx = sink;
#pragma unroll
        for (int tt = 0; tt < 10; ++tt)
#pragma unroll
            for (int r = 0; r < 4; ++r) { const int kj = 16 * (t0 + tt) + 4 * q4 + r;
                const bool valid = (kj >= qi + 1) && (kj <= qi + 128) && (qb > 0 || kj >= 128);
                s[tt][r] = valid ? s[tt][r] : -INFINITY; mx = fmaxf(mx, s[tt][r]); }
        mx = fmaxf(mx, swz_xor(mx, SWZ_X16)); mx = xor32_max(mx);
        float sum = 0.f;
#pragma unroll
        for (int tt = 0; tt < 10; ++tt)
#pragma unroll
            for (int r = 0; r < 4; ++r) { const float p = __expf(s[tt][r] - mx); s[tt][r] = p; sum += p; }
        sum += swz_xor(sum, SWZ_X16); sum = xor32_sum(sum);
        const float inv = 1.0f / (sum + __expf(sink - mx));
        f32x4 o[4];
#pragma unroll
        for (int dt = 0; dt < 4; ++dt) o[dt] = (f32x4){0.f, 0.f, 0.f, 0.f};
#pragma unroll
        for (int kk = 0; kk < 5; ++kk) {
            u32x4 pw; pw.x = pk2(s[2 * kk][0], s[2 * kk][1]); pw.y = pk2(s[2 * kk][2], s[2 * kk][3]); pw.z = pk2(s[2 * kk + 1][0], s[2 * kk + 1][1]); pw.w = pk2(s[2 * kk + 1][2], s[2 * kk + 1][3]);
            const bf16x8 pf = __builtin_bit_cast(bf16x8, pw);
            const int key0 = 16 * t0 + 32 * kk + 4 * q4;
#pragma unroll
            for (int dt = 0; dt < 4; ++dt) {
                const LAS unsigned char* vp = vt + ((16 * dt + n) * VT_PITCH + key0) * 2;
                const u32x2 va = *(const LAS u32x2*)vp, vb = *(const LAS u32x2*)(vp + 32);
                u32x4 vw; vw.x = va.x; vw.y = va.y; vw.z = vb.x; vw.w = vb.y;
                o[dt] = __builtin_amdgcn_mfma_f32_16x16x32_bf16(__builtin_bit_cast(bf16x8, vw), pf, o[dt], 0, 0, 0);
            }
        }
#pragma unroll
        for (int dt = 0; dt < 4; ++dt) { u32x2 w; w.x = pk2(o[dt][0] * inv, o[dt][1] * inv); w.y = pk2(o[dt][2] * inv, o[dt][3] * inv);
            *(GAS u32x2*)(cat + (size_t)tq * DM + head * 64 + 16 * dt + 4 * q4) = w; }
    }
    __syncthreads();
}

DI void dn_pre_item(Frame& F, int item, int l) {
    const int h = item & 7, ck = (item >> 3) & 63, b = item >> 9;
    const bf16* proj = (const bf16*)(F.ws + WS_PROJ);
    bf16* qn = (bf16*)(F.ws + WS_QKV); bf16* kn = qn + (size_t)NTOK * 1024; bf16* vv = kn + (size_t)NTOK * 1024;
    const int lane = F.lane, tb = b * SEQ + ck * 64;
    {
        const float* ab = (const float*)(F.ws + WS_AB) + (size_t)(tb + lane) * 16;
        const float a = ab[h], bb = ab[8 + h];
        const float x = a + F.in[I_DTB][l * 8 + h];
        const float ex = __expf(x);
        const float sp = (x > 20.f) ? x : ((ex < 0.03f) ? ex * (1.0f - ex * (0.5f - ex * (0.33333333f - 0.25f * ex))) : __logf(1.0f + ex));
        ((float*)(F.ws + WS_G))[(size_t)(tb + lane) * 8 + h] = -__expf(F.in[I_ALOG][l * 8 + h]) * sp;
        ((float*)(F.ws + WS_BETA))[(size_t)(tb + lane) * 8 + h] = sigmoidf_(bb);
    }
    const float* cw = F.in[I_CONVW] + (size_t)l * 4 * 3072;
    float w[3][4][2];
#pragma unroll
    for (int s = 0; s < 3; ++s)
#pragma unroll
        for (int j = 0; j < 4; ++j) { const f32x2 t = *(const GAS f32x2*)(cw + j * 3072 + s * 1024 + h * 128 + 2 * lane); w[s][j][0] = t.x; w[s][j][1] = t.y; }
    const int colq = C_DQ + h * 128 + 2 * lane;
    float hist[3][3][2];
#pragma unroll
    for (int a = 0; a < 3; ++a) {
        const int t = ck * 64 - 3 + a;
#pragma unroll
        for (int s = 0; s < 3; ++s) {
            unsigned x = 0u;
            if (t >= 0) x = *(const GAS unsigned*)(proj + (size_t)(b * SEQ + t) * PN + colq + s * 1024);
            hist[s][a][0] = bflo(x); hist[s][a][1] = bfhi(x);
        }
    }
#pragma unroll 1
    for (int t8 = 0; t8 < 64; t8 += 8) {
        unsigned xs[8][3];
#pragma unroll
        for (int i = 0; i < 8; ++i)
#pragma unroll
            for (int s = 0; s < 3; ++s) xs[i][s] = *(const GAS unsigned*)(proj + (size_t)(tb + t8 + i) * PN + colq + s * 1024);
#pragma unroll
        for (int i = 0; i < 8; ++i) {
            float y[3][2];
#pragma unroll
            for (int s = 0; s < 3; ++s) {
                const float c0 = bflo(xs[i][s]), c1 = bfhi(xs[i][s]);
                const float a0 = w[s][0][0] * hist[s][0][0] + w[s][1][0] * hist[s][1][0] + w[s][2][0] * hist[s][2][0] + w[s][3][0] * c0;
                const float a1 = w[s][0][1] * hist[s][0][1] + w[s][1][1] * hist[s][1][1] + w[s][2][1] * hist[s][2][1] + w[s][3][1] * c1;
                hist[s][0][0] = hist[s][1][0]; hist[s][0][1] = hist[s][1][1]; hist[s][1][0] = hist[s][2][0]; hist[s][1][1] = hist[s][2][1]; hist[s][2][0] = c0; hist[s][2][1] = c1;
                y[s][0] = siluf_(a0); y[s][1] = siluf_(a1);
            }
            const float sq = wave_sum(y[0][0] * y[0][0] + y[0][1] * y[0][1]);
            const float sk = wave_sum(y[1][0] * y[1][0] + y[1][1] * y[1][1]);
            const float rq = 1.0f / sqrtf(sq + RMS_EPS) * 0.08838834764831845f, rk = 1.0f / sqrtf(sk + RMS_EPS);
            const size_t o = (size_t)(tb + t8 + i) * 1024 + h * 128 + 2 * lane;
            *(GAS unsigned*)(qn + o) = pk2(y[0][0] * rq, y[0][1] * rq);
            *(GAS unsigned*)(kn + o) = pk2(y[1][0] * rk, y[1][1] * rk);
            *(GAS unsigned*)(vv + o) = pk2(y[2][0], y[2][1]);
        }
    }
}

DI void dn_naive_phase(Frame& F) {
    if (F.bid >= 16) return;
    const int b = F.bid >> 3, h = F.bid & 7;
    const bf16* qn = (const bf16*)(F.ws + WS_QKV); const bf16* kn = qn + (size_t)NTOK * 1024; const bf16* vv = kn + (size_t)NTOK * 1024;
    const float* gb = (const float*)(F.ws + WS_G); const float* bb = (const float*)(F.ws + WS_BETA);
    float* ob = (float*)(F.ws + WS_OBUF);
    LAS float* kq = (LAS float*)F.lds;
    LAS float* gl = (LAS float*)(F.lds + 65536);
    float S[64];
#pragma unroll
    for (int i = 0; i < 64; ++i) S[i] = 0.f;
    const int vcol = (F.wave & 3) * 32 + (F.lane & 31), kh = F.lane >> 5;
    for (int ck = 0; ck < 64; ++ck) {
        const int tb = b * SEQ + ck * 64;
        __syncthreads();
        for (int i = F.tid; i < 64 * 64; i += NTHREADS) { const int t = i >> 6, d2 = i & 63;
            const unsigned kw = *(const GAS unsigned*)(kn + (size_t)(tb + t) * 1024 + h * 128 + 2 * d2), qw = *(const GAS unsigned*)(qn + (size_t)(tb + t) * 1024 + h * 128 + 2 * d2);
            kq[t * 128 + 2 * d2] = bflo(kw); kq[t * 128 + 2 * d2 + 1] = bfhi(kw); kq[8192 + t * 128 + 2 * d2] = bflo(qw); kq[8192 + t * 128 + 2 * d2 + 1] = bfhi(qw); }
        if (F.tid < 64) { gl[F.tid] = gb[(size_t)(tb + F.tid) * 8 + h]; gl[64 + F.tid] = bb[(size_t)(tb + F.tid) * 8 + h]; }
        __syncthreads();
        if (F.wave < 4) {
#pragma unroll 1
            for (int t = 0; t < 64; ++t) {
                const float vt_ = __builtin_bit_cast(float, ((unsigned)vv[(size_t)(tb + t) * 1024 + h * 128 + vcol]) << 16);
                const float eg = __expf(gl[t]), be = gl[64 + t];
                const LAS float* kp = kq + t * 128 + 64 * kh; const LAS float* qp = kq + 8192 + t * 128 + 64 * kh;
                float ks = 0.f;
#pragma unroll
                for (int i = 0; i < 16; ++i) { const f32x4 k4 = *(const LAS f32x4*)(kp + 4 * i); ks += k4.x * S[4 * i] + k4.y * S[4 * i + 1] + k4.z * S[4 * i + 2] + k4.w * S[4 * i + 3]; }
                ks = xor32_sum(ks);
                const float coef = be * (vt_ - eg * ks);
                float o = 0.f;
#pragma unroll
                for (int i = 0; i < 16; ++i) { const f32x4 k4 = *(const LAS f32x4*)(kp + 4 * i); const f32x4 q4 = *(const LAS f32x4*)(qp + 4 * i);
                    S[4 * i] = eg * S[4 * i] + k4.x * coef; S[4 * i + 1] = eg * S[4 * i + 1] + k4.y * coef; S[4 * i + 2] = eg * S[4 * i + 2] + k4.z * coef; S[4 * i + 3] = eg * S[4 * i + 3] + k4.w * coef;
                    o += q4.x * S[4 * i] + q4.y * S[4 * i + 1] + q4.z * S[4 * i + 2] + q4.w * S[4 * i + 3]; }
                o = xor32_sum(o);
                if (kh == 0) ob[(size_t)(tb + t) * 1024 + h * 128 + vcol] = o;
            }
        }
    }
    __syncthreads();
}

DI void gnorm_phase(Frame& F, int l) {
    const float* ob = (const float*)(F.ws + WS_OBUF); const bf16* proj = (const bf16*)(F.ws + WS_PROJ); bf16* cat = (bf16*)(F.ws + WS_CAT);
    const int lane = F.lane; const f32x2 nw = *(const GAS f32x2*)(F.in[I_DNW] + l * 128 + 2 * lane);
    const int gw = F.bid * NWAVES + F.wave, NGW = F.G * NWAVES;
    for (int it0 = gw * 4; it0 < NTOK * 8; it0 += NGW * 4) {
        f32x2 o[4]; unsigned z[4];
#pragma unroll
        for (int i = 0; i < 4; ++i) { const int it = it0 + i, tok = it >> 3, h = it & 7;
            o[i] = *(const GAS f32x2*)(ob + (size_t)tok * 1024 + h * 128 + 2 * lane); z[i] = *(const GAS unsigned*)(proj + (size_t)tok * PN + C_DZ + h * 128 + 2 * lane); }
#pragma unroll
        for (int i = 0; i < 4; ++i) { const int it = it0 + i, tok = it >> 3, h = it & 7;
            const float ms = wave_sum(o[i].x * o[i].x + o[i].y * o[i].y) * (1.0f / 128.0f);
            const float r = 1.0f / sqrtf(ms + RMS_EPS);
            *(GAS unsigned*)(cat + (size_t)tok * DM + 1024 + h * 128 + 2 * lane) = pk2(o[i].x * r * nw.x * siluf_(bflo(z[i])), o[i].y * r * nw.y * siluf_(bfhi(z[i]))); }
    }
}

DI int moe_table(Frame& F, const unsigned* cnt) {
    LAS int* tab = (LAS int*)(F.lds + MOETAB_OFF);
    __syncthreads();
    if (F.tid == 0) { int acc = 0;
        for (int e = 0; e < 16; ++e) { const int c = (int)__hip_atomic_load(cnt + e, __ATOMIC_RELAXED, __HIP_MEMORY_SCOPE_AGENT); tab[e] = acc; tab[17 + e] = c; acc += (c + 255) >> 8; }
        tab[16] = acc; }
    __syncthreads();
    return tab[16];
}

constexpr int NS = 11, NSTEPS = 1 + DEPTH * NS;
struct Args { const float* in[18]; float* out; unsigned char* ws; int s_lo, s_hi; };

__global__ void __launch_bounds__(NTHREADS, 2) fwd_kernel(Args args) {
    extern __shared__ __attribute__((aligned(16))) unsigned char lds_raw[];
    Frame F;
    F.lds = (LAS unsigned char*)lds_raw;
    F.tid = threadIdx.x; F.lane = F.tid & 63; F.wave = __builtin_amdgcn_readfirstlane(F.tid >> 6);
    const int wave0 = F.wave;
    F.G = gridDim.x; F.bid = blockIdx.x; F.ws = args.ws; F.out = args.out;
    F.in = args.in;
    unsigned* ctl = (unsigned*)(F.ws + WS_CTL);
    if (F.tid < 4) ((LAS unsigned*)(F.lds + MISC_OFF))[F.tid] = 0u;
    __syncthreads();
    const int lo = args.s_lo, hi = args.s_hi;
    XcdBarrier bar; bar.bar = ctl + CW_BAR; bar.x = 0; bar.st = nullptr;
    if (hi - lo > 1) bar = xcd_barrier_post(ctl + CW_BAR, (volatile LAS unsigned*)(F.lds + MISC_OFF));
#ifndef PHASE_MASK
#define PHASE_MASK 0xfff
#endif
#define PHM(k) (((PHASE_MASK) >> (k)) & 1)
#define REFRESH() do { int z_ = 0; asm volatile("" : "+v"(z_)); const int ln_ = __builtin_amdgcn_mbcnt_hi(-1, __builtin_amdgcn_mbcnt_lo(-1, z_)); F.lane = ln_; F.wave = wave0; F.tid = wave0 * 64 + ln_; asm volatile("" : "+s"(F.ws)); } while (0)
#define RUN(s) (lo <= (s) && (s) < hi)
#define SEAM(s) do { if ((s) + 1 < hi) { XcdBarrier b2_ = bar; unsigned* bp_ = (unsigned*)(F.ws + WS_CTL) + CW_BAR; asm volatile("" : "+s"(bp_)); b2_.bar = bp_; xcd_barrier(b2_); } } while (0)
#define P_CNT ((unsigned*)(F.ws + WS_CTL) + CW_CNT)
#define P_LIST ((int*)(F.ws + WS_LIST))
#define P_WSEL ((float*)(F.ws + WS_WSEL))
#define P_XB ((bf16*)(F.ws + WS_XB))
#define P_PROJB ((bf16*)(F.ws + WS_PROJ))
#define P_CATB ((bf16*)(F.ws + WS_CAT))
#define P_YB ((float*)(F.ws + WS_Y))
#define P_X1 ((float*)(F.ws + WS_X1))
#define P_X1B ((bf16*)(F.ws + WS_X1B))
#define P_HID ((bf16*)(F.ws + WS_HID))
#define P_O2 ((bf16*)(F.ws + WS_O2))
#define P_XW ((float*)(F.ws + WS_X))
#define P_ABP ((float*)(F.ws + WS_AB))
    if (PHM(11) && RUN(0)) { REFRESH();
        rope_phase(F);
        ln_phase<0>(F, F.in[I_X], nullptr, nullptr, nullptr, nullptr, P_XB, F.in[I_WIN] + C_AB, PROJ, true, P_ABP, nullptr, nullptr, nullptr, nullptr);
        SEAM(0);
    }
    for (int l = 0; l < DEPTH; ++l) {
        const int sb = 1 + l * NS;
        const int slot = 0;
#define P_WIN_T ((const bf16*)(F.ws + WS_WIN) + (size_t)slot * PN * DM)
#define P_WOUT_T ((const bf16*)(F.ws + WS_WOUT) + (size_t)slot * DM * DM)
#define P_WGU_T ((const bf16*)(F.ws + WS_WGU) + (size_t)slot * NEXP * 1024 * DM)
#define P_WD_T ((const bf16*)(F.ws + WS_WD) + (size_t)slot * NEXP * DM * DEXP)
#define P_XRES ((l == 0) ? F.in[I_X] : P_XW)
        if (PHM(0) && RUN(sb + 0)) { REFRESH(); convw_phase(F, l, slot); __syncthreads(); SEAM(sb + 0); }
        if (PHM(1) && RUN(sb + 1)) { REFRESH();
            if (F.bid == 0 && F.tid < 16) __hip_atomic_store(P_CNT + F.tid, 0u, __ATOMIC_RELAXED, __HIP_MEMORY_SCOPE_AGENT);
            g8::DenseSched<NTOK, PN, DM> S; S.init(P_WIN_T, F.G, F.bid);
            g8::EpiBf16 E{P_PROJB, PN};
            g8::gemm_phase<g8::EpiBf16, g8::DenseSched<NTOK, PN, DM>>(F.lds, F.wave, (const char*)P_XB, DM, S, E);
            SEAM(sb + 1);
        }
        if (PHM(2) && RUN(sb + 2)) { REFRESH();
            for (int it = F.bid; it < 256; it += F.G) {
                if (it < 128) attn_unit(F, it, l);
                else dn_pre_item(F, (it - 128) * NWAVES + F.wave, l);
            }
            SEAM(sb + 2);
        }
        if (PHM(3) && RUN(sb + 3)) { REFRESH(); dn_naive_phase(F); SEAM(sb + 3); }
        if (PHM(4) && RUN(sb + 4)) { REFRESH(); SEAM(sb + 4); }
        if (PHM(5) && RUN(sb + 5)) { REFRESH(); gnorm_phase(F, l); SEAM(sb + 5); }
        if (PHM(6) && RUN(sb + 6)) { REFRESH();
            g8::DenseSched<NTOK, DM, DM> S; S.init(P_WOUT_T, F.G, F.bid);
            g8::EpiResid E{P_XRES, P_YB};
            g8::gemm_phase<g8::EpiResid, g8::DenseSched<NTOK, DM, DM>>(F.lds, F.wave, (const char*)P_CATB, DM, S, E);
            SEAM(sb + 6);
        }
        if (PHM(7) && RUN(sb + 7)) { REFRESH();
            ln_phase<1>(F, P_YB, nullptr, F.in[I_LN1G] + l * DM, F.in[I_LN1B] + l * DM, P_X1, P_X1B, F.in[I_RW], 16, true, nullptr, F.in[I_RB], P_CNT, P_LIST, P_WSEL);
            SEAM(sb + 7);
        }
        if (PHM(8) && RUN(sb + 8)) { REFRESH();
            const int mt = moe_table(F, P_CNT);
            g8::MoeSched<true> S; S.tab = (const LAS int*)(F.lds + MOETAB_OFF); S.list = P_LIST; S.W = (const char*)P_WGU_T; S.wstride = (size_t)1024 * DM * 2; S.NB = 4; S.K = DM; S.G = F.G; S.c = F.bid; S.total = mt * 4;
            g8::EpiSwiglu E{P_HID, P_LIST, P_WSEL};
            g8::gemm_phase<g8::EpiSwiglu, g8::MoeSched<true>>(F.lds, F.wave, (const char*)P_X1B, DM, S, E);
            SEAM(sb + 8);
        }
        if (PHM(9) && RUN(sb + 9)) { REFRESH();
            const int mt = moe_table(F, P_CNT);
            g8::MoeSched<false> S; S.tab = (const LAS int*)(F.lds + MOETAB_OFF); S.list = P_LIST; S.W = (const char*)P_WD_T; S.wstride = (size_t)DM * DEXP * 2; S.NB = 8; S.K = DEXP; S.G = F.G; S.c = F.bid; S.total = mt * 8;
            g8::EpiDown E{P_O2, P_LIST};
            g8::gemm_phase<g8::EpiDown, g8::MoeSched<false>>(F.lds, F.wave, (const char*)P_HID, DEXP, S, E);
            SEAM(sb + 9);
        }
        if (PHM(10) && RUN(sb + 10)) { REFRESH();
            const bool lastl = (l == DEPTH - 1);
            ln_phase<2>(F, P_X1, P_O2, F.in[I_LN2G] + l * DM, F.in[I_LN2B] + l * DM, lastl ? F.out : P_XW, P_XB, F.in[I_WIN] + (size_t)(lastl ? l : l + 1) * DM * PROJ + C_AB, PROJ, !lastl, P_ABP, nullptr, nullptr, nullptr, nullptr);
            SEAM(sb + 10);
        }
    }
#undef RUN
#undef SEAM
}

extern "C" void kernel_launch(void* const* d_in, const int* in_sizes, int n_in, void* d_out, int out_size, void* d_ws, size_t ws_size, hipStream_t stream) {
    static int grid = 0;
    if (grid == 0) {
        if (n_in != 18 || out_size != NTOK * DM || ws_size < WS_END) { fprintf(stderr, "kernel_launch: unexpected shapes (n_in %d, out %d, ws %zu < %zu)\n", n_in, out_size, ws_size, (size_t)WS_END); grid = -1; return; }
        int dev = 0, cus = 0, per_cu = 0;
        if (hipGetDevice(&dev) != hipSuccess || hipDeviceGetAttribute(&cus, hipDeviceAttributeMultiprocessorCount, dev) != hipSuccess) { grid = -1; return; }
        if (hipFuncSetAttribute((const void*)fwd_kernel, hipFuncAttributeMaxDynamicSharedMemorySize, LDS_BYTES) != hipSuccess) { fprintf(stderr, "kernel_launch: hipFuncSetAttribute failed\n"); grid = -1; return; }
        if (hipOccupancyMaxActiveBlocksPerMultiprocessor(&per_cu, (const void*)fwd_kernel, NTHREADS, LDS_BYTES) != hipSuccess || per_cu < 1) { fprintf(stderr, "kernel_launch: occupancy query says %d\n", per_cu); }
        (void)hipGetLastError();
        grid = cus;
    }
    if (grid < 0) return;
    (void)hipMemsetAsync((char*)d_ws + WS_CTL, 0, CTL_BYTES, stream);
    Args a{};
    for (int i = 0; i < 18; ++i) a.in[i] = (const float*)d_in[i];
    a.out = (float*)d_out; a.ws = (unsigned char*)d_ws;
#if MK_ONE_LAUNCH
    a.s_lo = 0; a.s_hi = NSTEPS;
    hipLaunchKernelGGL(fwd_kernel, dim3(grid), dim3(NTHREADS), LDS_BYTES, stream, a);
#else
    for (int s = 0; s < NSTEPS; ++s) {
        if ((s - 1) % NS == 4 && s > 0) continue;
        a.s_lo = s; a.s_hi = s + 1;
        hipLaunchKernelGGL(fwd_kernel, dim3(grid), dim3(NTHREADS), LDS_BYTES, stream, a);
    }
#endif
}
```

```cpp
#include <hip/hip_runtime.h>
#include <cstdio>
#include <cstdint>

#ifndef MK_ONE_LAUNCH
#define MK_ONE_LAUNCH 1
#endif
#ifndef DN_NAIVE
#define DN_NAIVE 1
#endif

#define DI __device__ __forceinline__
#define LAS __attribute__((address_space(3)))
#define GAS __attribute__((address_space(1)))
typedef unsigned short bf16;
typedef short bf16x8 __attribute__((ext_vector_type(8)));
typedef short s16x4 __attribute__((ext_vector_type(4)));
typedef float f32x4 __attribute__((ext_vector_type(4)));
typedef float f32x2 __attribute__((ext_vector_type(2)));
typedef unsigned u32x4 __attribute__((ext_vector_type(4)));
typedef unsigned u32x2 __attribute__((ext_vector_type(2)));

constexpr int NTOK = 8192, SEQ = 4096, DM = 2048, PROJ = 5392, PN = 5376, DEPTH = 4;
constexpr int C_SQ = 0, C_SK = 1024, C_SV = 1152, C_DQ = 1280, C_DK = 2304, C_DV = 3328, C_DZ = 4352, C_AB = 5376;
constexpr int NEXP = 16, DEXP = 512;
constexpr float ALPHA = 1.681792830507429f;
constexpr float LN_EPS = 1e-5f, RMS_EPS = 1e-6f;

constexpr size_t MiB = 1u << 20;
constexpr size_t WS_CTL = 0, CTL_BYTES = 1 * MiB;
constexpr size_t WS_COS = 1 * MiB, WS_SIN = 2 * MiB;
constexpr size_t WS_AB = 4 * MiB;
constexpr size_t WS_G = 4 * MiB + 512 * 1024, WS_BETA = WS_G + 256 * 1024;
constexpr size_t WS_WSEL = 5 * MiB, WS_LIST = 5 * MiB + 64 * 1024;
constexpr size_t WS_WIN = 8 * MiB, WS_WOUT = 50 * MiB, WS_WGU = 66 * MiB, WS_WD = 194 * MiB;
constexpr size_t WS_X = 258 * MiB, WS_XB = 322 * MiB, WS_PROJ = 354 * MiB, WS_Y = 438 * MiB, WS_X1 = 502 * MiB, WS_X1B = 566 * MiB;
constexpr size_t WS_CAT = 598 * MiB, WS_OBUF = 630 * MiB, WS_QKV = 662 * MiB, WS_SCAN = 710 * MiB, WS_HID = 798 * MiB, WS_O2 = 814 * MiB, WS_END = 878 * MiB;
constexpr int CW_BAR = 4096;
constexpr int CW_CNT = 64;

DI unsigned f2bf(float f) { unsigned u = __builtin_bit_cast(unsigned, f); return (u + 0x7fffu + ((u >> 16) & 1u)) >> 16; }
DI unsigned pk2(float lo, float hi) { return f2bf(lo) | (f2bf(hi) << 16); }
DI float bflo(unsigned w) { return __builtin_bit_cast(float, w << 16); }
DI float bfhi(unsigned w) { return __builtin_bit_cast(float, w & 0xffff0000u); }
#define swz_xor(v, pat) __builtin_bit_cast(float, __builtin_amdgcn_ds_swizzle(__builtin_bit_cast(int, (float)(v)), (pat)))
#define SWZ_X1 0x041F
#define SWZ_X2 0x081F
#define SWZ_X4 0x101F
#define SWZ_X8 0x201F
#define SWZ_X16 0x401F
DI float xor32_sum(float v) { const unsigned u = __builtin_bit_cast(unsigned, v); const auto r = __builtin_amdgcn_permlane32_swap(u, u, false, false); return __builtin_bit_cast(float, (unsigned)r[0]) + __builtin_bit_cast(float, (unsigned)r[1]); }
DI float xor32_max(float v) { const unsigned u = __builtin_bit_cast(unsigned, v); const auto r = __builtin_amdgcn_permlane32_swap(u, u, false, false); return fmaxf(__builtin_bit_cast(float, (unsigned)r[0]), __builtin_bit_cast(float, (unsigned)r[1])); }
DI float wave_sum(float v) {
    v += swz_xor(v, SWZ_X1); v += swz_xor(v, SWZ_X2); v += swz_xor(v, SWZ_X4); v += swz_xor(v, SWZ_X8); v += swz_xor(v, SWZ_X16);
    return xor32_sum(v);
}
DI float sigmoidf_(float x) { return 1.0f / (1.0f + __expf(-x)); }
DI float siluf_(float x) { return x / (1.0f + __expf(-x)); }
#define LDS_WAIT() asm volatile("s_waitcnt lgkmcnt(0)" ::: "memory")

#define XB_TMO      128
#define XB_XCNT(j)  (256  + 64 * (j))
#define XB_XSUB(j)  (1280 + 64 * (j))
#define XB_XGEN(j)  (2304 + 64 * (j))
#define XB_TOP      3328
#define XB_TOPGEN   3392
#define XCD_BAR_WORDS 3456
#define XB_SPIN_CAP (1u << 18)
__device__ __forceinline__ unsigned xb_ld(unsigned* p)              { return __hip_atomic_load(p, __ATOMIC_RELAXED, __HIP_MEMORY_SCOPE_AGENT); }
__device__ __forceinline__ unsigned xb_add(unsigned* p, unsigned v) { return __hip_atomic_fetch_add(p, v, __ATOMIC_RELAXED, __HIP_MEMORY_SCOPE_AGENT); }
__device__ __forceinline__ unsigned xb_xcc_id() { return (unsigned)__builtin_amdgcn_s_getreg((3 << 11) | 20) & 0xFu; }
#define XB_SPIN(cond, bar) do { unsigned _sp = 0; while (cond) { __builtin_amdgcn_s_sleep(1); \
    if ((++_sp & 255u) == 0u) { if (xb_ld(&(bar)[XB_TMO])) break; if (_sp > XB_SPIN_CAP) { atomicAdd(&(bar)[XB_TMO], 1u); break; } } } } while (0)
struct XcdBarrier { unsigned* bar; unsigned x; volatile LAS unsigned* st; };
__device__ __forceinline__ XcdBarrier xcd_barrier_post(unsigned* bar, volatile LAS unsigned* st) {
    XcdBarrier b; b.bar = bar; b.x = xb_xcc_id(); b.st = st;
    if (threadIdx.x == 0) (void)xb_add(&bar[XB_XCNT(b.x)], 1u);
    return b;
}
__device__ __forceinline__ void xcd_barrier_complete(unsigned* bar, unsigned x, unsigned& nloc, unsigned& nx) {
    const unsigned G = gridDim.x * gridDim.y * gridDim.z;
    unsigned sum, cnt, mine, sp = 0u;
    for (;;) {
        sum = 0u; cnt = 0u; mine = 0u;
#pragma unroll
        for (unsigned j = 0; j < 16; ++j) { const unsigned c = xb_ld(&bar[XB_XCNT(j)]); sum += c; cnt += (c > 0u) ? 1u : 0u; mine = (j == x) ? c : mine; }
        if (sum == G) break;
        __builtin_amdgcn_s_sleep(1);
        if ((++sp & 255u) == 0u) { if (xb_ld(&bar[XB_TMO])) break; if (sp > XB_SPIN_CAP) { atomicAdd(&bar[XB_TMO], 1u); break; } }
    }
    nloc = mine > 0u ? mine : 1u; nx = cnt > 0u ? cnt : 1u;
}
__device__ __forceinline__ void xcd_barrier(const XcdBarrier& b) {
    asm volatile("s_waitcnt vmcnt(0)" ::: "memory");
    __syncthreads();
    if (threadIdx.x == 0) {
        unsigned* bar = b.bar;
        __builtin_amdgcn_s_waitcnt(0);
        unsigned nloc = b.st[0], nx = b.st[1];
        if (nloc == 0u) { xcd_barrier_complete(bar, b.x, nloc, nx); b.st[0] = nloc; b.st[1] = nx; }
        const unsigned old = xb_add(&bar[XB_XSUB(b.x)], 1u);
        const unsigned gen = old / nloc;
        if (old + 1u == (gen + 1u) * nloc) {
            __builtin_amdgcn_fence(__ATOMIC_RELEASE, "agent");
            asm volatile("s_waitcnt vmcnt(0)" ::: "memory");
            const unsigned og = xb_add(&bar[XB_TOP], 1u);
            const unsigned tg = og / nx;
            if (og + 1u == (tg + 1u) * nx) xb_add(&bar[XB_TOPGEN], 1u);
            else XB_SPIN(xb_ld(&bar[XB_TOPGEN]) == tg, bar);
            __builtin_amdgcn_fence(__ATOMIC_ACQUIRE, "agent");
            xb_add(&bar[XB_XGEN(b.x)], 1u);
            asm volatile("s_waitcnt vmcnt(0)" ::: "memory");
        } else {
            XB_SPIN(xb_ld(&bar[XB_XGEN(b.x)]) == gen, bar);
            __builtin_amdgcn_fence(__ATOMIC_ACQUIRE, "agent");
            asm volatile("s_waitcnt vmcnt(0)" ::: "memory");
        }
    }
    __syncthreads();
}

namespace g8 {
constexpr int BM = 256, BK = 64, HALF = 128, HTB = HALF * BK * 2, STAGE_BYTES = 8 * HTB, NXCD = 8, WGM = 8;
DI int lds_byte(int r, int c) { const int st = (r >> 4) * 2 + (c >> 5), rr = r & 15, cc = c & 31, ob = rr * 64 + cc * 2; return st * 1024 + (ob ^ (((ob >> 9) & 1) << 5)); }
DI void stage_rc(int b, int& R, int& C) { const int st = b / 1024, sb = b % 1024, swz = sb ^ (((sb >> 9) & 1) << 5); R = (st >> 1) * 16 + swz / 64; C = (st & 1) * 32 + (swz % 64) / 2; }
DI int perm32(int rho) { const int n = rho >> 4, i = rho & 15; return 8 * (i >> 2) + 4 * n + (i & 3); }

struct Unit { const char* B; int m0, n0, rows, e; };

template <int M_, int N_, int K_> struct DenseSched {
    static constexpr bool GATHER = false;
    static constexpr int nM = M_ / BM, nN = N_ / BM, nwg = nM * nN, K = K_;
    int G, c; const char* Bt;
    DI void init(const void* Bt_, int G_, int c_) { G = G_; c = c_; Bt = (const char*)Bt_; }
    DI bool next(int i, Unit& u) const {
        const int L = i * G + c; if (L >= nwg) return false;
        int wgid = L; { constexpr int q = nwg / NXCD, r = nwg % NXCD; const int xcd = wgid % NXCD, off = wgid / NXCD; wgid = (xcd < r ? xcd * (q + 1) : r * (q + 1) + (xcd - r) * q) + off; }
        constexpr int nig = WGM * nN; const int gid = wgid / nig, fm = gid * WGM, gsz = (nM - fm) < WGM ? (nM - fm) : WGM;
        const int pm = fm + ((wgid % nig) % gsz), pn = (wgid % nig) / gsz;
        u.m0 = pm * BM; u.n0 = pn * BM; u.rows = BM; u.e = 0; u.B = Bt + (size_t)pn * BM * K * 2; return true;
    }
    DI unsigned arow(const Unit& u, int r) const { return (unsigned)(u.m0 + r); }
};
template <bool TOKEN_ROWS> struct MoeSched {
    static constexpr bool GATHER = true;
    const LAS int* tab; const int* list; const char* W; size_t wstride; int NB, K, G, c, total;
    DI bool next(int i, Unit& u) const {
        const int L = i * G + c; if (L >= total) return false;
        const int mt = L / NB, nb = L - mt * NB;
        int e = 0;
#pragma unroll
        for (int j = 1; j < 16; ++j) e += (tab[j] <= mt) ? 1 : 0;
        const int ti = mt - tab[e], cnt = tab[17 + e];
        u.e = e; u.m0 = e * NTOK + ti * BM; u.rows = (cnt - ti * BM) < BM ? (cnt - ti * BM) : BM; u.n0 = nb * BM;
        u.B = W + (size_t)e * wstride + (size_t)nb * BM * K * 2; return true;
    }
    DI unsigned arow(const Unit& u, int r) const { const int rr = r < u.rows ? r : 0; const unsigned en = (unsigned)list[u.m0 + rr]; return TOKEN_ROWS ? (en & (NTOK - 1)) : en; }
};

DI unsigned cvt_pk_bf16(float lo, float hi) { unsigned r; asm volatile("v_cvt_pk_bf16_f32 %0, %1, %2" : "=v"(r) : "v"(lo), "v"(hi)); return r; }

struct EpiBf16 {
    static constexpr bool PERM = true;
    bf16* O; int ldc;
    DI void operator()(const f32x4 (&acc)[2][2][4][2], const Unit& u, int wr, int wc, int fr, int fq) const {
        const int row0 = u.m0 + wr * 64 + fr, col0 = u.n0 + wc * 32 + 8 * fq;
#pragma unroll
        for (int ai = 0; ai < 2; ++ai)
#pragma unroll
            for (int m = 0; m < 4; ++m) { bf16* rowp = O + (size_t)(row0 + ai * HALF + m * 16) * ldc + col0;
#pragma unroll
                for (int bj = 0; bj < 2; ++bj) { const f32x4 v0 = acc[ai][bj][m][0], v1 = acc[ai][bj][m][1];
                    u32x4 w; w.x = cvt_pk_bf16(v0[0], v0[1]); w.y = cvt_pk_bf16(v0[2], v0[3]); w.z = cvt_pk_bf16(v1[0], v1[1]); w.w = cvt_pk_bf16(v1[2], v1[3]);
                    *(u32x4*)(rowp + bj * HALF) = w; } }
    }
};
struct EpiResid {
    static constexpr bool PERM = false;
    const float* X; float* Y;
    DI void operator()(const f32x4 (&acc)[2][2][4][2], const Unit& u, int wr, int wc, int fr, int fq) const {
        const int row0 = u.m0 + wr * 64 + fr, col0 = u.n0 + wc * 32 + 4 * fq;
#pragma unroll
        for (int ai = 0; ai < 2; ++ai)
#pragma unroll
            for (int m = 0; m < 4; ++m) { const size_t off = (size_t)(row0 + ai * HALF + m * 16) * DM + col0;
#pragma unroll
                for (int bj = 0; bj < 2; ++bj)
#pragma unroll
                    for (int n = 0; n < 2; ++n) { const f32x4 xr = *(const f32x4*)(X + off + bj * HALF + n * 16); *(f32x4*)(Y + off + bj * HALF + n * 16) = xr * ALPHA + acc[ai][bj][m][n]; } }
    }
};
struct EpiSwiglu {
    static constexpr bool PERM = true;
    bf16* H; const int* list; const float* wsel;
    DI void operator()(const f32x4 (&acc)[2][2][4][2], const Unit& u, int wr, int wc, int fr, int fq) const {
        const int col0 = (u.n0 >> 1) + wc * 32 + 8 * fq;
#pragma unroll
        for (int ai = 0; ai < 2; ++ai)
#pragma unroll
            for (int m = 0; m < 4; ++m) { const int r = ai * HALF + wr * 64 + m * 16 + fr;
                if (r < u.rows) { const int en = list[u.m0 + r]; const float ws = wsel[en];
                    const f32x4 g0 = acc[ai][0][m][0], g1 = acc[ai][0][m][1], u0 = acc[ai][1][m][0], u1 = acc[ai][1][m][1];
                    float h[8];
#pragma unroll
                    for (int j = 0; j < 4; ++j) { h[j] = siluf_(g0[j]) * u0[j] * ws; h[4 + j] = siluf_(g1[j]) * u1[j] * ws; }
                    u32x4 w; w.x = cvt_pk_bf16(h[0], h[1]); w.y = cvt_pk_bf16(h[2], h[3]); w.z = cvt_pk_bf16(h[4], h[5]); w.w = cvt_pk_bf16(h[6], h[7]);
                    *(u32x4*)(H + (size_t)en * DEXP + col0) = w; } }
    }
};
struct EpiDown {
    static constexpr bool PERM = true;
    bf16* O; const int* list;
    DI void operator()(const f32x4 (&acc)[2][2][4][2], const Unit& u, int wr, int wc, int fr, int fq) const {
        const int col0 = u.n0 + wc * 32 + 8 * fq;
#pragma unroll
        for (int ai = 0; ai < 2; ++ai)
#pragma unroll
            for (int m = 0; m < 4; ++m) { const int r = ai * HALF + wr * 64 + m * 16 + fr;
                if (r < u.rows) { const int en = list[u.m0 + r]; bf16* rowp = O + (size_t)en * DM + col0;
#pragma unroll
                    for (int bj = 0; bj < 2; ++bj) { const f32x4 v0 = acc[ai][bj][m][0], v1 = acc[ai][bj][m][1];
                        u32x4 w; w.x = cvt_pk_bf16(v0[0], v0[1]); w.y = cvt_pk_bf16(v0[2], v0[3]); w.z = cvt_pk_bf16(v1[0], v1[1]); w.w = cvt_pk_bf16(v1[2], v1[3]);
                        *(u32x4*)(rowp + bj * HALF) = w; } } }
    }
};

template <class Epi, class Sched>
DI void gemm_phase(LAS unsigned char* lds, const int wave_id, const char* Abase, const int K, const Sched& S, const Epi& E) {
    int z_ = 0; asm volatile("" : "+v"(z_));
    const int lane = __builtin_amdgcn_mbcnt_hi(-1, __builtin_amdgcn_mbcnt_lo(-1, z_)), wid = wave_id, tid = wid * 64 + lane, wr = wid >> 2, wc = wid & 3, fr = lane & 15, fq = lane >> 4;
    const int nt = K / BK;
    constexpr bool GATHER = Sched::GATHER;
    int Rr[2]; unsigned C2[2], voffB[2], voffA[2];
#pragma unroll
    for (int i = 0; i < 2; ++i) { int R, C; stage_rc(tid * 16 + i * 8192, R, C); const int Rb = Epi::PERM ? ((R & ~31) + perm32(R & 31)) : R;
        Rr[i] = R; C2[i] = (unsigned)C * 2u; voffB[i] = (unsigned)(Rb * K + C) * 2u; voffA[i] = (unsigned)(R * K + C) * 2u; }
    const size_t kstep = (size_t)(BK * 2);
    const size_t hstepB = (size_t)HALF * K * 2;
    const size_t tstepA = (size_t)K * 2;
    const unsigned ldsw = (unsigned)wid * 1024u;
    const int aoff = lds_byte(wr * 64 + fr, fq * 8), boff = lds_byte(wc * 32 + fr, fq * 8);
#define G8_SA(b, h) (((b) * 2 + (h)) * HTB)
#define G8_SB(b, h) ((4 + (b) * 2 + (h)) * HTB)
#define G8_STAGE(bufoff, gbase, voff) do { _Pragma("unroll") for (int _i = 0; _i < 2; ++_i) \
        __builtin_amdgcn_global_load_lds((const unsigned*)((const char*)(gbase) + (voff)[_i]), (LAS unsigned*)(lds + (bufoff) + ldsw + _i * 8192), 16, 0, 0); } while (0)
#define G8_LDA(dst, b, h) do { _Pragma("unroll") for (int m = 0; m < 4; ++m) _Pragma("unroll") for (int k = 0; k < 2; ++k) dst[m][k] = *(const LAS bf16x8*)(lds + G8_SA(b, h) + aoff + m * 2048 + k * 1024); } while (0)
#define G8_LDB(dst, b, h) do { _Pragma("unroll") for (int n = 0; n < 2; ++n) _Pragma("unroll") for (int k = 0; k < 2; ++k) dst[n][k] = *(const LAS bf16x8*)(lds + G8_SB(b, h) + boff + n * 2048 + k * 1024); } while (0)
#define G8_MMA(ai, bj, At, Bt) do { __builtin_amdgcn_s_setprio(1); _Pragma("unroll") for (int m = 0; m < 4; ++m) _Pragma("unroll") for (int n = 0; n < 2; ++n) _Pragma("unroll") for (int k = 0; k < 2; ++k) \
        acc[ai][bj][m][n] = __builtin_amdgcn_mfma_f32_16x16x32_bf16(Bt[n][k], At[m][k], acc[ai][bj][m][n], 0, 0, 0); __builtin_amdgcn_s_setprio(0); } while (0)
#define G8_WAIT_V(n) asm volatile("s_waitcnt vmcnt(" #n ")" ::: "memory")
#define G8_WAIT_L(n) asm volatile("s_waitcnt lgkmcnt(" #n ")" ::: "memory")
#define G8_BAR __builtin_amdgcn_s_barrier()
#define G8_SCHED __builtin_amdgcn_sched_barrier(0)
    Unit cur, nxt; int ui = 0;
    if (!S.next(0, cur)) return;
    f32x4 acc[2][2][4][2];
#pragma unroll
    for (int a = 0; a < 2; ++a)
#pragma unroll
        for (int b = 0; b < 2; ++b)
#pragma unroll
            for (int m = 0; m < 4; ++m)
#pragma unroll
                for (int n = 0; n < 2; ++n) acc[a][b][m][n] = (f32x4){0.f, 0.f, 0.f, 0.f};
    bf16x8 At[4][2], B0[2][2], B1[2][2];
    unsigned vAc[2][2], vAn[2][2];
    const char* cA0 = Abase; const char* cA1 = Abase;
    if constexpr (GATHER) {
#pragma unroll
        for (int h = 0; h < 2; ++h)
#pragma unroll
            for (int i = 0; i < 2; ++i) vAc[h][i] = S.arow(cur, h * HALF + Rr[i]) * (unsigned)(K * 2) + C2[i];
    } else {
        cA0 = Abase + (size_t)cur.m0 * tstepA; cA1 = cA0 + (size_t)HALF * tstepA;
#pragma unroll
        for (int h = 0; h < 2; ++h)
#pragma unroll
            for (int i = 0; i < 2; ++i) vAc[h][i] = voffA[i];
    }
    const char* cB = cur.B;
    G8_STAGE(G8_SB(0, 0), cB, voffB); G8_STAGE(G8_SA(0, 0), cA0, vAc[0]); G8_STAGE(G8_SB(0, 1), cB + hstepB, voffB); G8_STAGE(G8_SA(0, 1), cA1, vAc[1]);
    if (wr == 1) G8_BAR;
    G8_WAIT_V(4); G8_BAR;
    G8_STAGE(G8_SB(1, 0), cB + kstep, voffB); G8_STAGE(G8_SA(1, 0), cA0 + kstep, vAc[0]); G8_STAGE(G8_SB(1, 1), cB + hstepB + kstep, voffB);
    G8_WAIT_V(6); G8_BAR;
    for (;;) {
        const bool has_next = S.next(ui + 1, nxt);
        const char* nB = has_next ? nxt.B : cB;
        const char* nA0 = cA0; const char* nA1 = cA1;
        if constexpr (GATHER) {
#pragma unroll
            for (int h = 0; h < 2; ++h)
#pragma unroll
                for (int i = 0; i < 2; ++i) vAn[h][i] = has_next ? (S.arow(nxt, h * HALF + Rr[i]) * (unsigned)(K * 2) + C2[i]) : vAc[h][i];
        } else {
            if (has_next) { nA0 = Abase + (size_t)nxt.m0 * tstepA; nA1 = nA0 + (size_t)HALF * tstepA; }
        }
        for (int t = 0; t < nt; t += 2) {
            const bool last = (t == nt - 2);
            const char* a1h1 = cA1 + (size_t)(t + 1) * kstep;
            const char* a2h0 = last ? nA0 : cA0 + (size_t)(t + 2) * kstep; const char* a2h1 = last ? nA1 : cA1 + (size_t)(t + 2) * kstep;
            const char* b2 = last ? nB : cB + (size_t)(t + 2) * kstep;
            const char* a3h0 = a2h0 + kstep; const char* b3 = b2 + kstep;
            unsigned va2[2][2];
#pragma unroll
            for (int h = 0; h < 2; ++h)
#pragma unroll
                for (int i = 0; i < 2; ++i) va2[h][i] = (GATHER && last) ? vAn[h][i] : vAc[h][i];
            G8_LDB(B0, 0, 0); G8_SCHED; G8_LDA(At, 0, 0); G8_STAGE(G8_SA(1, 1), a1h1, vAc[1]);
            G8_WAIT_L(8); G8_BAR; G8_WAIT_L(0); G8_MMA(0, 0, At, B0); G8_BAR; G8_SCHED;
            G8_LDB(B1, 0, 1); G8_STAGE(G8_SB(0, 0), b2, voffB);
            G8_BAR; G8_WAIT_L(0); G8_MMA(0, 1, At, B1); G8_BAR;
            G8_LDA(At, 0, 1); G8_STAGE(G8_SA(0, 0), a2h0, va2[0]);
            G8_BAR; G8_WAIT_L(0); G8_MMA(1, 0, At, B0); G8_BAR; G8_SCHED;
            G8_STAGE(G8_SB(0, 1), b2 + hstepB, voffB);
            G8_WAIT_V(6); G8_BAR; G8_MMA(1, 1, At, B1); G8_BAR;
            G8_LDB(B0, 1, 0); G8_SCHED; G8_LDA(At, 1, 0); G8_STAGE(G8_SA(0, 1), a2h1, va2[1]);
            G8_WAIT_L(8); G8_BAR; G8_WAIT_L(0); G8_MMA(0, 0, At, B0); G8_BAR; G8_SCHED;
            G8_LDB(B1, 1, 1); G8_STAGE(G8_SB(1, 0), b3, voffB);
            G8_BAR; G8_WAIT_L(0); G8_MMA(0, 1, At, B1); G8_BAR;
            G8_LDA(At, 1, 1); G8_STAGE(G8_SA(1, 0), a3h0, va2[0]);
            G8_BAR; G8_WAIT_L(0); G8_MMA(1, 0, At, B0); G8_BAR; G8_SCHED;
            G8_STAGE(G8_SB(1, 1), b3 + hstepB, voffB);
            G8_WAIT_V(6); G8_BAR; G8_MMA(1, 1, At, B1); G8_BAR;
        }
        E(acc, cur, wr, wc, fr, fq);
        if (!has_next) break;
#pragma unroll
        for (int a = 0; a < 2; ++a)
#pragma unroll
            for (int b = 0; b < 2; ++b)
#pragma unroll
                for (int m = 0; m < 4; ++m)
#pragma unroll
                    for (int n = 0; n < 2; ++n) acc[a][b][m][n] = (f32x4){0.f, 0.f, 0.f, 0.f};
        cur = nxt; cB = nB; cA0 = nA0; cA1 = nA1; ++ui;
        if constexpr (GATHER) {
#pragma unroll
            for (int h = 0; h < 2; ++h)
#pragma unroll
                for (int i = 0; i < 2; ++i) vAc[h][i] = vAn[h][i];
        }
    }
    G8_WAIT_V(0);
    if (wr == 0) G8_BAR;
    G8_BAR;
#undef G8_SA
#undef G8_SB
#undef G8_STAGE
#undef G8_LDA
#undef G8_LDB
#undef G8_MMA
#undef G8_WAIT_V
#undef G8_WAIT_L
#undef G8_BAR
#undef G8_SCHED
}
}

constexpr int NWAVES = 8, NTHREADS = 512;
constexpr int RING_BYTES = 131072;
constexpr int LN_STRIDE = 2052;
constexpr int LN_TILE_BYTES = 16 * LN_STRIDE * 4;
constexpr int LN_PART_OFF = LN_TILE_BYTES, LN_LOGIT_OFF = LN_PART_OFF + 8192;
constexpr int MOETAB_OFF = 141312;
constexpr int MISC_OFF = 141824;
constexpr int LDS_BYTES = 147456;
static_assert(LN_LOGIT_OFF + 1024 <= MOETAB_OFF && MISC_OFF + 16 <= LDS_BYTES, "LDS map");

struct Frame {
    LAS unsigned char* lds;
    int tid, lane, wave, G, bid;
    unsigned char* ws;
    const float* const* in;
    float* out;
};
enum { I_X = 0, I_POS, I_WIN, I_SINK, I_CONVW, I_ALOG, I_DTB, I_DNW, I_WOUT, I_LN1G, I_LN1B, I_RW, I_RB, I_WG, I_WU, I_WDN, I_LN2G, I_LN2B };

DI void transpose_item(const float* W, int ldw, bf16* WT, int ldt, int k0, int n0, int drow0, LAS float* scr, int lane) {
#pragma unroll 8
    for (int i = 0; i < 32; ++i) { const int kk = 2 * i + (lane >> 5); scr[kk * 33 + (lane & 31)] = W[(size_t)(k0 + kk) * ldw + n0 + (lane & 31)]; }
    LDS_WAIT(); asm volatile("" ::: "memory");
    const int c = lane & 7;
#pragma unroll
    for (int j = 0; j < 4; ++j) { const int n = (lane >> 3) + 8 * j; const LAS float* s = scr + (8 * c) * 33 + n;
        u32x4 o; o.x = pk2(s[0 * 33], s[1 * 33]); o.y = pk2(s[2 * 33], s[3 * 33]); o.z = pk2(s[4 * 33], s[5 * 33]); o.w = pk2(s[6 * 33], s[7 * 33]);
        *(GAS u32x4*)(WT + (size_t)(drow0 + n) * ldt + k0 + 8 * c) = o; }
    LDS_WAIT(); asm volatile("" ::: "memory");
}
DI void convw_phase(Frame& F, int l, int slot) {
    LAS float* scr = (LAS float*)(F.lds + F.wave * 16384);
    const int gw = F.bid * NWAVES + F.wave, NGW = F.G * NWAVES;
    bf16* win_t = (bf16*)(F.ws + WS_WIN) + (size_t)slot * PN * DM;
    bf16* wout_t = (bf16*)(F.ws + WS_WOUT) + (size_t)slot * DM * DM;
    bf16* wgu_t = (bf16*)(F.ws + WS_WGU) + (size_t)slot * NEXP * 1024 * DM;
    bf16* wd_t = (bf16*)(F.ws + WS_WD) + (size_t)slot * NEXP * DM * DEXP;
    const float* w_in = F.in[I_WIN] + (size_t)l * DM * PROJ;
    const float* w_out = F.in[I_WOUT] + (size_t)l * DM * DM;
    const float* w_g = F.in[I_WG] + (size_t)l * NEXP * DM * DEXP;
    const float* w_u = F.in[I_WU] + (size_t)l * NEXP * DM * DEXP;
    const float* w_d = F.in[I_WDN] + (size_t)l * NEXP * DEXP * DM;
    constexpr int I_IN = 32 * 168, I_OUT = 32 * 64, I_GU = 32 * 16, I_D = 8 * 64, I_E = 2 * I_GU + I_D;
    constexpr int NITEMS = I_IN + I_OUT + NEXP * I_E;
    for (int it = gw; it < NITEMS; it += NGW) {
        int r = it;
        if (r < I_IN) { const int kb = r / 168, nb = r % 168; transpose_item(w_in, PROJ, win_t, DM, kb * 64, nb * 32, nb * 32, scr, F.lane); continue; } r -= I_IN;
        if (r < I_OUT) { const int kb = r / 64, nb = r % 64; transpose_item(w_out, DM, wout_t, DM, kb * 64, nb * 32, nb * 32, scr, F.lane); continue; } r -= I_OUT;
        const int e = r / I_E; r -= e * I_E;
        if (r < 2 * I_GU) { const int up = r / I_GU; r -= up * I_GU; const int kb = r / 16, nb = r % 16, n0 = nb * 32;
            const int drow0 = (n0 >> 7) * 256 + up * 128 + (n0 & 127);
            transpose_item((up ? w_u : w_g) + (size_t)e * DM * DEXP, DEXP, wgu_t + (size_t)e * 1024 * DM, DM, kb * 64, n0, drow0, scr, F.lane); continue; }
        r -= 2 * I_GU;
        { const int kb = r / 64, nb = r % 64; transpose_item(w_d + (size_t)e * DEXP * DM, DM, wd_t + (size_t)e * DM * DEXP, DEXP, kb * 64, nb * 32, nb * 32, scr, F.lane); }
    }
}

DI void rope_phase(Frame& F) {
    float* cs = (float*)(F.ws + WS_COS); float* sn = (float*)(F.ws + WS_SIN);
    const int* pos = (const int*)F.in[I_POS];
    for (int i = F.bid * NTHREADS + F.tid; i < NTOK * 32; i += F.G * NTHREADS) {
        const int t = i >> 5, d = i & 31;
        const float inv = exp2f(-(float)d * (13.287712379549449f / 32.0f));
        const float ang = (float)pos[t] * inv;
        cs[i] = cosf(ang); sn[i] = sinf(ang);
    }
}

template <int MODE>
DI void ln_phase(Frame& F, const float* src, const bf16* o2, const float* gam, const float* bet, float* of32, bf16* obf, const float* W16, int ldw, bool do_logits,
                 float* ab, const float* rbias, unsigned* cnt, int* list, float* wsel) {
    LAS float* tile = (LAS float*)F.lds;
    LAS float* part = (LAS float*)(F.lds + LN_PART_OFF);
    LAS float* logit = (LAS float*)(F.lds + LN_LOGIT_OFF);
    const int lane = F.lane, w = F.wave;
    for (int unit = F.bid; unit < NTOK / 16; unit += F.G) {
        const int row0 = unit * 16;
#pragma unroll 1
        for (int rr = 0; rr < 2; ++rr) {
            const int rl = 2 * w + rr, row = row0 + rl;
            f32x4 v[8];
            const GAS f32x4* sp = (const GAS f32x4*)(src + (size_t)row * DM) + lane;
#pragma unroll
            for (int j = 0; j < 8; ++j) v[j] = sp[64 * j];
            if (MODE == 2) {
                const GAS u32x2* pa = (const GAS u32x2*)(o2 + (size_t)row * DM) + lane;
                const GAS u32x2* pb = (const GAS u32x2*)(o2 + (size_t)(NTOK + row) * DM) + lane;
#pragma unroll
                for (int j = 0; j < 8; ++j) { const u32x2 a = pa[64 * j], b = pb[64 * j];
                    v[j].x = v[j].x * ALPHA + (bflo(a.x) + bflo(b.x)); v[j].y = v[j].y * ALPHA + (bfhi(a.x) + bfhi(b.x));
                    v[j].z = v[j].z * ALPHA + (bflo(a.y) + bflo(b.y)); v[j].w = v[j].w * ALPHA + (bfhi(a.y) + bfhi(b.y)); }
            }
            if (MODE != 0) {
                float s = 0.f;
#pragma unroll
                for (int j = 0; j < 8; ++j) s += (v[j].x + v[j].y) + (v[j].z + v[j].w);
                const float mean = wave_sum(s) * (1.0f / DM); float s2 = 0.f;
#pragma unroll
                for (int j = 0; j < 8; ++j) { v[j] = v[j] - mean; s2 += (v[j].x * v[j].x + v[j].y * v[j].y) + (v[j].z * v[j].z + v[j].w * v[j].w); }
                const float rstd = 1.0f / sqrtf(wave_sum(s2) * (1.0f / DM) + LN_EPS);
#pragma unroll
                for (int j = 0; j < 8; ++j) { const f32x4 g4 = *((const GAS f32x4*)gam + lane + 64 * j), b4 = *((const GAS f32x4*)bet + lane + 64 * j); v[j] = v[j] * rstd * g4 + b4; }
            }
            if (of32) { GAS f32x4* op = (GAS f32x4*)(of32 + (size_t)row * DM) + lane;
#pragma unroll
                for (int j = 0; j < 8; ++j) op[64 * j] = v[j]; }
            { GAS u32x2* op = (GAS u32x2*)(obf + (size_t)row * DM) + lane;
#pragma unroll
                for (int j = 0; j < 8; ++j) { u32x2 o; o.x = pk2(v[j].x, v[j].y); o.y = pk2(v[j].z, v[j].w); op[64 * j] = o; } }
            if (do_logits) {
#pragma unroll
                for (int j = 0; j < 8; ++j) *(LAS f32x4*)(tile + rl * LN_STRIDE + 4 * lane + 256 * j) = v[j];
            }
        }
        if (do_logits) {
            __syncthreads();
            const int m = lane & 15, kq = lane >> 4;
            f32x4 acc = (f32x4){0.f, 0.f, 0.f, 0.f};
            const int kb = 256 * w;
#pragma unroll 4
            for (int s = 0; s < 16; ++s) {
                const int k = kb + 16 * s + 4 * kq;
                const f32x4 a4 = *(const LAS f32x4*)(tile + m * LN_STRIDE + k);
                const float* wp = W16 + (size_t)k * ldw + m;
                const float b0 = wp[0], b1 = wp[ldw], b2 = wp[2 * (size_t)ldw], b3 = wp[3 * (size_t)ldw];
                acc = __builtin_amdgcn_mfma_f32_16x16x4f32(a4.x, b0, acc, 0, 0, 0);
                acc = __builtin_amdgcn_mfma_f32_16x16x4f32(a4.y, b1, acc, 0, 0, 0);
                acc = __builtin_amdgcn_mfma_f32_16x16x4f32(a4.z, b2, acc, 0, 0, 0);
                acc = __builtin_amdgcn_mfma_f32_16x16x4f32(a4.w, b3, acc, 0, 0, 0);
            }
#pragma unroll
            for (int r = 0; r < 4; ++r) part[(w * 16 + 4 * kq + r) * 16 + m] = acc[r];
            __syncthreads();
            if (F.tid < 256) {
                const int r = F.tid >> 4, n = F.tid & 15; float s = 0.f;
#pragma unroll
                for (int ww = 0; ww < 8; ++ww) s += part[(ww * 16 + r) * 16 + n];
                if (MODE == 1) logit[r * 16 + n] = s; else ab[(size_t)(row0 + r) * 16 + n] = s;
            }
            if (MODE == 1) {
                __syncthreads();
                if (F.tid < 16) {
                    const int tok = row0 + F.tid;
                    float sc[16], sel[16];
#pragma unroll
                    for (int e = 0; e < 16; ++e) { sc[e] = sigmoidf_(logit[F.tid * 16 + e]); sel[e] = sc[e] + rbias[e]; }
                    int bg = 0; float bgv = -1e30f; int be0[4], be1[4];
#pragma unroll
                    for (int g = 0; g < 4; ++g) {
                        int i0 = 0; float v0 = sel[4 * g];
#pragma unroll
                        for (int j = 1; j < 4; ++j) if (sel[4 * g + j] > v0) { v0 = sel[4 * g + j]; i0 = j; }
                        int i1 = -1; float v1 = -1e30f;
#pragma unroll
                        for (int j = 0; j < 4; ++j) if (j != i0 && sel[4 * g + j] > v1) { v1 = sel[4 * g + j]; i1 = j; }
                        be0[g] = 4 * g + i0; be1[g] = 4 * g + i1;
                        const float sum = v0 + v1; if (sum > bgv) { bgv = sum; bg = g; }
                    }
                    int e0 = be0[0], e1 = be1[0];
#pragma unroll
                    for (int g = 1; g < 4; ++g) if (bg == g) { e0 = be0[g]; e1 = be1[g]; }
                    float w0 = 0.f, w1 = 0.f;
#pragma unroll
                    for (int e = 0; e < 16; ++e) { if (e == e0) w0 = sc[e]; if (e == e1) w1 = sc[e]; }
                    const float inv = 1.0f / (w0 + w1);
                    const unsigned p0 = atomicAdd(cnt + e0, 1u); list[e0 * NTOK + p0] = tok; wsel[tok] = w0 * inv;
                    const unsigned p1 = atomicAdd(cnt + e1, 1u); list[e1 * NTOK + p1] = NTOK + tok; wsel[NTOK + tok] = w1 * inv;
                }
            }
            __syncthreads();
        }
    }
}

constexpr int KT_PITCH = 72, VT_PITCH = 264;
constexpr int ATT_KT_OFF = 0, ATT_VT_OFF = 256 * KT_PITCH * 2;
DI void attn_unit(Frame& F, int unit, int l) {
    const int b = unit >> 6, kvh = (unit >> 5) & 1, qb = unit & 31;
    const bf16* proj = (const bf16*)(F.ws + WS_PROJ);
    const float* cs = (const float*)(F.ws + WS_COS); const float* sn = (const float*)(F.ws + WS_SIN);
    bf16* cat = (bf16*)(F.ws + WS_CAT);
    LAS unsigned char* kt = F.lds + ATT_KT_OFF; LAS unsigned char* vt = F.lds + ATT_VT_OFF;
    const int tq0 = b * SEQ + qb * 128, tk0 = tq0 - 128;
#pragma unroll
    for (int it = 0; it < 2; ++it) {
        const int idx = F.tid + it * NTHREADS, kj = idx >> 2, c = idx & 3;
        int tk = tk0 + kj; if (tk < b * SEQ) tk = b * SEQ;
        const bf16* kp = proj + (size_t)tk * PN + C_SK + kvh * 64;
        const u32x4 lo = *(const GAS u32x4*)(kp + 8 * c), hi = *(const GAS u32x4*)(kp + 32 + 8 * c);
        const f32x4 c0 = *(const GAS f32x4*)(cs + tk * 32 + 8 * c), c1 = *(const GAS f32x4*)(cs + tk * 32 + 8 * c + 4);
        const f32x4 s0 = *(const GAS f32x4*)(sn + tk * 32 + 8 * c), s1 = *(const GAS f32x4*)(sn + tk * 32 + 8 * c + 4);
        float x1[8], x2[8], cc[8], ss[8];
#pragma unroll
        for (int j = 0; j < 4; ++j) { x1[2 * j] = bflo(lo[j]); x1[2 * j + 1] = bfhi(lo[j]); x2[2 * j] = bflo(hi[j]); x2[2 * j + 1] = bfhi(hi[j]); cc[j] = c0[j]; cc[4 + j] = c1[j]; ss[j] = s0[j]; ss[4 + j] = s1[j]; }
        u32x4 o1, o2;
#pragma unroll
        for (int j = 0; j < 4; ++j) {
            o1[j] = pk2(x1[2 * j] * cc[2 * j] - x2[2 * j] * ss[2 * j], x1[2 * j + 1] * cc[2 * j + 1] - x2[2 * j + 1] * ss[2 * j + 1]);
            o2[j] = pk2(x2[2 * j] * cc[2 * j] + x1[2 * j] * ss[2 * j], x2[2 * j + 1] * cc[2 * j + 1] + x1[2 * j + 1] * ss[2 * j + 1]);
        }
        *(LAS u32x4*)(kt + kj * (KT_PITCH * 2) + 16 * c) = o1;
        *(LAS u32x4*)(kt + kj * (KT_PITCH * 2) + 64 + 16 * c) = o2;
    }
    {
        const int kj = F.tid & 255, dh = F.tid >> 8;
        int tk = tk0 + kj; if (tk < b * SEQ) tk = b * SEQ;
        const bf16* vp = proj + (size_t)tk * PN + C_SV + kvh * 64 + dh * 32;
#pragma unroll
        for (int q = 0; q < 4; ++q) { const u32x4 x = *(const GAS u32x4*)(vp + 8 * q);
#pragma unroll
            for (int j = 0; j < 4; ++j) { const int d = dh * 32 + 8 * q + 2 * j;
                *(LAS unsigned short*)(vt + (d * VT_PITCH + kj) * 2) = (unsigned short)(x[j] & 0xffffu);
                *(LAS unsigned short*)(vt + ((d + 1) * VT_PITCH + kj) * 2) = (unsigned short)(x[j] >> 16); } }
    }
    __syncthreads();
    const int lane = F.lane, n = lane & 15, q4 = lane >> 4, head = kvh * 8 + F.wave;
    const float sink = F.in[I_SINK][l * 16 + head];
#pragma unroll 1
    for (int qt = 0; qt < 8; ++qt) {
        const int qi = 16 * qt + n, tq = tq0 + qi;
        bf16x8 qf[2];
        {
            const bf16* qp = proj + (size_t)tq * PN + C_SQ + head * 64;
            const u32x4 lo = *(const GAS u32x4*)(qp + 8 * q4), hi = *(const GAS u32x4*)(qp + 32 + 8 * q4);
            const f32x4 c0 = *(const GAS f32x4*)(cs + tq * 32 + 8 * q4), c1 = *(const GAS f32x4*)(cs + tq * 32 + 8 * q4 + 4);
            const f32x4 s0 = *(const GAS f32x4*)(sn + tq * 32 + 8 * q4), s1 = *(const GAS f32x4*)(sn + tq * 32 + 8 * q4 + 4);
            float x1[8], x2[8], cc[8], ss[8];
#pragma unroll
            for (int j = 0; j < 4; ++j) { x1[2 * j] = bflo(lo[j]); x1[2 * j + 1] = bfhi(lo[j]); x2[2 * j] = bflo(hi[j]); x2[2 * j + 1] = bfhi(hi[j]); cc[j] = c0[j]; cc[4 + j] = c1[j]; ss[j] = s0[j]; ss[4 + j] = s1[j]; }
            u32x4 o1, o2;
#pragma unroll
            for (int j = 0; j < 4; ++j) {
                o1[j] = pk2(0.125f * (x1[2 * j] * cc[2 * j] - x2[2 * j] * ss[2 * j]), 0.125f * (x1[2 * j + 1] * cc[2 * j + 1] - x2[2 * j + 1] * ss[2 * j + 1]));
                o2[j] = pk2(0.125f * (x2[2 * j] * cc[2 * j] + x1[2 * j] * ss[2 * j]), 0.125f * (x2[2 * j + 1] * cc[2 * j + 1] + x1[2 * j + 1] * ss[2 * j + 1]));
            }
            qf[0] = __builtin_bit_cast(bf16x8, o1); qf[1] = __builtin_bit_cast(bf16x8, o2);
        }
        const int t0 = 2 * (qt >> 1);
        f32x4 s[10];
#pragma unroll
        for (int tt = 0; tt < 10; ++tt) {
            f32x4 a = (f32x4){0.f, 0.f, 0.f, 0.f};
#pragma unroll
            for (int kk = 0; kk < 2; ++kk) {
                const bf16x8 kf = *(const LAS bf16x8*)(kt + (16 * (t0 + tt) + n) * (KT_PITCH * 2) + 64 * kk + 16 * q4);
                a = __builtin_amdgcn_mfma_f32_16x16x32_bf16(kf, qf[kk], a, 0, 0, 0);
            }
            s[tt] = a;
        }
        float mx = sink;
#pragma unroll
        for (int tt = 0; tt < 10; ++tt)
#pragma unroll
            for (int r = 0; r < 4; ++r) { const int kj = 16 * (t0 + tt) + 4 * q4 + r;
                const bool valid = (kj >= qi + 1) && (kj <= qi + 128) && (qb > 0 || kj >= 128);
                s[tt][r] = valid ? s[tt][r] : -INFINITY; mx = fmaxf(mx, s[tt][r]); }
        mx = fmaxf(mx, swz_xor(mx, SWZ_X16)); mx = xor32_max(mx);
        float sum = 0.f;
#pragma unroll
        for (int tt = 0; tt < 10; ++tt)
#pragma unroll
            for (int r = 0; r < 4; ++r) { const float p = __expf(s[tt][r] - mx); s[tt][r] = p; sum += p; }
        sum += swz_xor(sum, SWZ_X16); sum = xor32_sum(sum);
        const float inv = 1.0f / (sum + __expf(sink - mx));
        f32x4 o[4];
#pragma unroll
        for (int dt = 0; dt < 4; ++dt) o[dt] = (f32x4){0.f, 0.f, 0.f, 0.f};
#pragma unroll
        for (int kk = 0; kk < 5; ++kk) {
            u32x4 pw; pw.x = pk2(s[2 * kk][0], s[2 * kk][1]); pw.y = pk2(s[2 * kk][2], s[2 * kk][3]); pw.z = pk2(s[2 * kk + 1][0], s[2 * kk + 1][1]); pw.w = pk2(s[2 * kk + 1][2], s[2 * kk + 1][3]);
            const bf16x8 pf = __builtin_bit_cast(bf16x8, pw);
            const int key0 = 16 * t0 + 32 * kk + 4 * q4;
#pragma unroll
            for (int dt = 0; dt < 4; ++dt) {
                const LAS unsigned char* vp = vt + ((16 * dt + n) * VT_PITCH + key0) * 2;
                const u32x2 va = *(const LAS u32x2*)vp, vb = *(const LAS u32x2*)(vp + 32);
                u32x4 vw; vw.x = va.x; vw.y = va.y; vw.z = vb.x; vw.w = vb.y;
                o[dt] = __builtin_amdgcn_mfma_f32_16x16x32_bf16(__builtin_bit_cast(bf16x8, vw), pf, o[dt], 0, 0, 0);
            }
        }
#pragma unroll
        for (int dt = 0; dt < 4; ++dt) { u32x2 w; w.x = pk2(o[dt][0] * inv, o[dt][1] * inv); w.y = pk2(o[dt][2] * inv, o[dt][3] * inv);
            *(GAS u32x2*)(cat + (size_t)tq * DM + head * 64 + 16 * dt + 4 * q4) = w; }
    }
    __syncthreads();
}

DI void dn_pre_item(Frame& F, int item, int l) {
    const int h = item & 7, ck = (item >> 3) & 63, b = item >> 9;
    const bf16* proj = (const bf16*)(F.ws + WS_PROJ);
    bf16* qn = (bf16*)(F.ws + WS_QKV); bf16* kn = qn + (size_t)NTOK * 1024; bf16* vv = kn + (size_t)NTOK * 1024;
    const int lane = F.lane, tb = b * SEQ + ck * 64;
    {
        const float* ab = (const float*)(F.ws + WS_AB) + (size_t)(tb + lane) * 16;
        const float a = ab[h], bb = ab[8 + h];
        const float x = a + F.in[I_DTB][l * 8 + h];
        const float ex = __expf(x);
        const float sp = (x > 20.f) ? x : ((ex < 0.03f) ? ex * (1.0f - ex * (0.5f - ex * (0.33333333f - 0.25f * ex))) : __logf(1.0f + ex));
        ((float*)(F.ws + WS_G))[(size_t)(tb + lane) * 8 + h] = -__expf(F.in[I_ALOG][l * 8 + h]) * sp;
        ((float*)(F.ws + WS_BETA))[(size_t)(tb + lane) * 8 + h] = sigmoidf_(bb);
    }
    const float* cw = F.in[I_CONVW] + (size_t)l * 4 * 3072;
    float w[3][4][2];
#pragma unroll
    for (int s = 0; s < 3; ++s)
#pragma unroll
        for (int j = 0; j < 4; ++j) { const f32x2 t = *(const GAS f32x2*)(cw + j * 3072 + s * 1024 + h * 128 + 2 * lane); w[s][j][0] = t.x; w[s][j][1] = t.y; }
    const int colq = C_DQ + h * 128 + 2 * lane;
    float hist[3][3][2];
#pragma unroll
    for (int a = 0; a < 3; ++a) {
        const int t = ck * 64 - 3 + a;
#pragma unroll
        for (int s = 0; s < 3; ++s) {
            unsigned x = 0u;
            if (t >= 0) x = *(const GAS unsigned*)(proj + (size_t)(b * SEQ + t) * PN + colq + s * 1024);
            hist[s][a][0] = bflo(x); hist[s][a][1] = bfhi(x);
        }
    }
#pragma unroll 1
    for (int t8 = 0; t8 < 64; t8 += 8) {
        unsigned xs[8][3];
#pragma unroll
        for (int i = 0; i < 8; ++i)
#pragma unroll
            for (int s = 0; s < 3; ++s) xs[i][s] = *(const GAS unsigned*)(proj + (size_t)(tb + t8 + i) * PN + colq + s * 1024);
#pragma unroll
        for (int i = 0; i < 8; ++i) {
            float y[3][2];
#pragma unroll
            for (int s = 0; s < 3; ++s) {
                const float c0 = bflo(xs[i][s]), c1 = bfhi(xs[i][s]);
                const float a0 = w[s][0][0] * hist[s][0][0] + w[s][1][0] * hist[s][1][0] + w[s][2][0] * hist[s][2][0] + w[s][3][0] * c0;
                const float a1 = w[s][0][1] * hist[s][0][1] + w[s][1][1] * hist[s][1][1] + w[s][2][1] * hist[s][2][1] + w[s][3][1] * c1;
                hist[s][0][0] = hist[s][1][0]; hist[s][0][1] = hist[s][1][1]; hist[s][1][0] = hist[s][2][0]; hist[s][1][1] = hist[s][2][1]; hist[s][2][0] = c0; hist[s][2][1] = c1;
                y[s][0] = siluf_(a0); y[s][1] = siluf_(a1);
            }
            const float sq = wave_sum(y[0][0] * y[0][0] + y[0][1] * y[0][1]);
            const float sk = wave_sum(y[1][0] * y[1][0] + y[1][1] * y[1][1]);
            const float rq = 1.0f / sqrtf(sq + RMS_EPS) * 0.08838834764831845f, rk = 1.0f / sqrtf(sk + RMS_EPS);
            const size_t o = (size_t)(tb + t8 + i) * 1024 + h * 128 + 2 * lane;
            *(GAS unsigned*)(qn + o) = pk2(y[0][0] * rq, y[0][1] * rq);
            *(GAS unsigned*)(kn + o) = pk2(y[1][0] * rk, y[1][1] * rk);
            *(GAS unsigned*)(vv + o) = pk2(y[2][0], y[2][1]);
        }
    }
}

DI void dn_naive_phase(Frame& F) {
    if (F.bid >= 16) return;
    const int b = F.bid >> 3, h = F.bid & 7;
    const bf16* qn = (const bf16*)(F.ws + WS_QKV); const bf16* kn = qn + (size_t)NTOK * 1024; const bf16* vv = kn + (size_t)NTOK * 1024;
    const float* gb = (const float*)(F.ws + WS_G); const float* bb = (const float*)(F.ws + WS_BETA);
    float* ob = (float*)(F.ws + WS_OBUF);
    LAS float* kq = (LAS float*)F.lds;
    LAS float* gl = (LAS float*)(F.lds + 65536);
    float S[64];
#pragma unroll
    for (int i = 0; i < 64; ++i) S[i] = 0.f;
    const int vcol = (F.wave & 3) * 32 + (F.lane & 31), kh = F.lane >> 5;
    for (int ck = 0; ck < 64; ++ck) {
        const int tb = b * SEQ + ck * 64;
        __syncthreads();
        for (int i = F.tid; i < 64 * 64; i += NTHREADS) { const int t = i >> 6, d2 = i & 63;
            const unsigned kw = *(const GAS unsigned*)(kn + (size_t)(tb + t) * 1024 + h * 128 + 2 * d2), qw = *(const GAS unsigned*)(qn + (size_t)(tb + t) * 1024 + h * 128 + 2 * d2);
            kq[t * 128 + 2 * d2] = bflo(kw); kq[t * 128 + 2 * d2 + 1] = bfhi(kw); kq[8192 + t * 128 + 2 * d2] = bflo(qw); kq[8192 + t * 128 + 2 * d2 + 1] = bfhi(qw); }
        if (F.tid < 64) { gl[F.tid] = gb[(size_t)(tb + F.tid) * 8 + h]; gl[64 + F.tid] = bb[(size_t)(tb + F.tid) * 8 + h]; }
        __syncthreads();
        if (F.wave < 4) {
#pragma unroll 1
            for (int t = 0; t < 64; ++t) {
                const float vt_ = __builtin_bit_cast(float, ((unsigned)vv[(size_t)(tb + t) * 1024 + h * 128 + vcol]) << 16);
                const float eg = __expf(gl[t]), be = gl[64 + t];
                const LAS float* kp = kq + t * 128 + 64 * kh; const LAS float* qp = kq + 8192 + t * 128 + 64 * kh;
                float ks = 0.f;
#pragma unroll
                for (int i = 0; i < 16; ++i) { const f32x4 k4 = *(const LAS f32x4*)(kp + 4 * i); ks += k4.x * S[4 * i] + k4.y * S[4 * i + 1] + k4.z * S[4 * i + 2] + k4.w * S[4 * i + 3]; }
                ks = xor32_sum(ks);
                const float coef = be * (vt_ - eg * ks);
                float o = 0.f;
#pragma unroll
                for (int i = 0; i < 16; ++i) { const f32x4 k4 = *(const LAS f32x4*)(kp + 4 * i); const f32x4 q4 = *(const LAS f32x4*)(qp + 4 * i);
                    S[4 * i] = eg * S[4 * i] + k4.x * coef; S[4 * i + 1] = eg * S[4 * i + 1] + k4.y * coef; S[4 * i + 2] = eg * S[4 * i + 2] + k4.z * coef; S[4 * i + 3] = eg * S[4 * i + 3] + k4.w * coef;
                    o += q4.x * S[4 * i] + q4.y * S[4 * i + 1] + q4.z * S[4 * i + 2] + q4.w * S[4 * i + 3]; }
                o = xor32_sum(o);
                if (kh == 0) ob[(size_t)(tb + t) * 1024 + h * 128 + vcol] = o;
            }
        }
    }
    __syncthreads();
}

DI void gnorm_phase(Frame& F, int l) {
    const float* ob = (const float*)(F.ws + WS_OBUF); const bf16* proj = (const bf16*)(F.ws + WS_PROJ); bf16* cat = (bf16*)(F.ws + WS_CAT);
    const int lane = F.lane; const f32x2 nw = *(const GAS f32x2*)(F.in[I_DNW] + l * 128 + 2 * lane);
    const int gw = F.bid * NWAVES + F.wave, NGW = F.G * NWAVES;
    for (int it0 = gw * 4; it0 < NTOK * 8; it0 += NGW * 4) {
        f32x2 o[4]; unsigned z[4];
#pragma unroll
        for (int i = 0; i < 4; ++i) { const int it = it0 + i, tok = it >> 3, h = it & 7;
            o[i] = *(const GAS f32x2*)(ob + (size_t)tok * 1024 + h * 128 + 2 * lane); z[i] = *(const GAS unsigned*)(proj + (size_t)tok * PN + C_DZ + h * 128 + 2 * lane); }
#pragma unroll
        for (int i = 0; i < 4; ++i) { const int it = it0 + i, tok = it >> 3, h = it & 7;
            const float ms = wave_sum(o[i].x * o[i].x + o[i].y * o[i].y) * (1.0f / 128.0f);
            const float r = 1.0f / sqrtf(ms + RMS_EPS);
            *(GAS unsigned*)(cat + (size_t)tok * DM + 1024 + h * 128 + 2 * lane) = pk2(o[i].x * r * nw.x * siluf_(bflo(z[i])), o[i].y * r * nw.y * siluf_(bfhi(z[i]))); }
    }
}

DI int moe_table(Frame& F, const unsigned* cnt) {
    LAS int* tab = (LAS int*)(F.lds + MOETAB_OFF);
    __syncthreads();
    if (F.tid == 0) { int acc = 0;
        for (int e = 0; e < 16; ++e) { const int c = (int)__hip_atomic_load(cnt + e, __ATOMIC_RELAXED, __HIP_MEMORY_SCOPE_AGENT); tab[e] = acc; tab[17 + e] = c; acc += (c + 255) >> 8; }
        tab[16] = acc; }
    __syncthreads();
    return tab[16];
}

constexpr int NS = 11, NSTEPS = 1 + DEPTH * NS;
struct Args { const float* in[18]; float* out; unsigned char* ws; int s_lo, s_hi; };

__global__ void __launch_bounds__(NTHREADS, 2) fwd_kernel(Args args) {
    extern __shared__ __attribute__((aligned(16))) unsigned char lds_raw[];
    Frame F;
    F.lds = (LAS unsigned char*)lds_raw;
    F.tid = threadIdx.x; F.lane = F.tid & 63; F.wave = __builtin_amdgcn_readfirstlane(F.tid >> 6);
    const int wave0 = F.wave;
    F.G = gridDim.x; F.bid = blockIdx.x; F.ws = args.ws; F.out = args.out;
    F.in = args.in;
    unsigned* ctl = (unsigned*)(F.ws + WS_CTL);
    if (F.tid < 4) ((LAS unsigned*)(F.lds + MISC_OFF))[F.tid] = 0u;
    __syncthreads();
    const int lo = args.s_lo, hi = args.s_hi;
    XcdBarrier bar; bar.bar = ctl + CW_BAR; bar.x = 0; bar.st = nullptr;
    if (hi - lo > 1) bar = xcd_barrier_post(ctl + CW_BAR, (volatile LAS unsigned*)(F.lds + MISC_OFF));
#ifndef PHASE_MASK
#define PHASE_MASK 0xfff
#endif
#define PHM(k) (((PHASE_MASK) >> (k)) & 1)
#define REFRESH() do { int z_ = 0; asm volatile("" : "+v"(z_)); const int ln_ = __builtin_amdgcn_mbcnt_hi(-1, __builtin_amdgcn_mbcnt_lo(-1, z_)); F.lane = ln_; F.wave = wave0; F.tid = wave0 * 64 + ln_; asm volatile("" : "+s"(F.ws)); } while (0)
#define RUN(s) (lo <= (s) && (s) < hi)
#define SEAM(s) do { if ((s) + 1 < hi) { XcdBarrier b2_ = bar; unsigned* bp_ = (unsigned*)(F.ws + WS_CTL) + CW_BAR; asm volatile("" : "+s"(bp_)); b2_.bar = bp_; xcd_barrier(b2_); } } while (0)
#define P_CNT ((unsigned*)(F.ws + WS_CTL) + CW_CNT)
#define P_LIST ((int*)(F.ws + WS_LIST))
#define P_WSEL ((float*)(F.ws + WS_WSEL))
#define P_XB ((bf16*)(F.ws + WS_XB))
#define P_PROJB ((bf16*)(F.ws + WS_PROJ))
#define P_CATB ((bf16*)(F.ws + WS_CAT))
#define P_YB ((float*)(F.ws + WS_Y))
#define P_X1 ((float*)(F.ws + WS_X1))
#define P_X1B ((bf16*)(F.ws + WS_X1B))
#define P_HID ((bf16*)(F.ws + WS_HID))
#define P_O2 ((bf16*)(F.ws + WS_O2))
#define P_XW ((float*)(F.ws + WS_X))
#define P_ABP ((float*)(F.ws + WS_AB))
    if (PHM(11) && RUN(0)) { REFRESH();
        rope_phase(F);
        ln_phase<0>(F, F.in[I_X], nullptr, nullptr, nullptr, nullptr, P_XB, F.in[I_WIN] + C_AB, PROJ, true, P_ABP, nullptr, nullptr, nullptr, nullptr);
        SEAM(0);
    }
    for (int l = 0; l < DEPTH; ++l) {
        const int sb = 1 + l * NS;
        const int slot = 0;
#define P_WIN_T ((const bf16*)(F.ws + WS_WIN) + (size_t)slot * PN * DM)
#define P_WOUT_T ((const bf16*)(F.ws + WS_WOUT) + (size_t)slot * DM * DM)
#define P_WGU_T ((const bf16*)(F.ws + WS_WGU) + (size_t)slot * NEXP * 1024 * DM)
#define P_WD_T ((const bf16*)(F.ws + WS_WD) + (size_t)slot * NEXP * DM * DEXP)
#define P_XRES ((l == 0) ? F.in[I_X] : P_XW)
        if (PHM(0) && RUN(sb + 0)) { REFRESH(); convw_phase(F, l, slot); __syncthreads(); SEAM(sb + 0); }
        if (PHM(1) && RUN(sb + 1)) { REFRESH();
            if (F.bid == 0 && F.tid < 16) __hip_atomic_store(P_CNT + F.tid, 0u, __ATOMIC_RELAXED, __HIP_MEMORY_SCOPE_AGENT);
            g8::DenseSched<NTOK, PN, DM> S; S.init(P_WIN_T, F.G, F.bid);
            g8::EpiBf16 E{P_PROJB, PN};
            g8::gemm_phase<g8::EpiBf16, g8::DenseSched<NTOK, PN, DM>>(F.lds, F.wave, (const char*)P_XB, DM, S, E);
            SEAM(sb + 1);
        }
        if (PHM(2) && RUN(sb + 2)) { REFRESH();
            for (int it = F.bid; it < 256; it += F.G) {
                if (it < 128) attn_unit(F, it, l);
                else dn_pre_item(F, (it - 128) * NWAVES + F.wave, l);
            }
            SEAM(sb + 2);
        }
        if (PHM(3) && RUN(sb + 3)) { REFRESH(); dn_naive_phase(F); SEAM(sb + 3); }
        if (PHM(4) && RUN(sb + 4)) { REFRESH(); SEAM(sb + 4); }
        if (PHM(5) && RUN(sb + 5)) { REFRESH(); gnorm_phase(F, l); SEAM(sb + 5); }
        if (PHM(6) && RUN(sb + 6)) { REFRESH();
            g8::DenseSched<NTOK, DM, DM> S; S.init(P_WOUT_T, F.G, F.bid);
            g8::EpiResid E{P_XRES, P_YB};
            g8::gemm_phase<g8::EpiResid, g8::DenseSched<NTOK, DM, DM>>(F.lds, F.wave, (const char*)P_CATB, DM, S, E);
            SEAM(sb + 6);
        }
        if (PHM(7) && RUN(sb + 7)) { REFRESH();
            ln_phase<1>(F, P_YB, nullptr, F.in[I_LN1G] + l * DM, F.in[I_LN1B] + l * DM, P_X1, P_X1B, F.in[I_RW], 16, true, nullptr, F.in[I_RB], P_CNT, P_LIST, P_WSEL);
            SEAM(sb + 7);
        }
        if (PHM(8) && RUN(sb + 8)) { REFRESH();
            const int mt = moe_table(F, P_CNT);
            g8::MoeSched<true> S; S.tab = (const LAS int*)(F.lds + MOETAB_OFF); S.list = P_LIST; S.W = (const char*)P_WGU_T; S.wstride = (size_t)1024 * DM * 2; S.NB = 4; S.K = DM; S.G = F.G; S.c = F.bid; S.total = mt * 4;
            g8::EpiSwiglu E{P_HID, P_LIST, P_WSEL};
            g8::gemm_phase<g8::EpiSwiglu, g8::MoeSched<true>>(F.lds, F.wave, (const char*)P_X1B, DM, S, E);
            SEAM(sb + 8);
        }
        if (PHM(9) && RUN(sb + 9)) { REFRESH();
            const int mt = moe_table(F, P_CNT);
            g8::MoeSched<false> S; S.tab = (const LAS int*)(F.lds + MOETAB_OFF); S.list = P_LIST; S.W = (const char*)P_WD_T; S.wstride = (size_t)DM * DEXP * 2; S.NB = 8; S.K = DEXP; S.G = F.G; S.c = F.bid; S.total = mt * 8;
            g8::EpiDown E{P_O2, P_LIST};
            g8::gemm_phase<g8::EpiDown, g8::MoeSched<false>>(F.lds, F.wave, (const char*)P_HID, DEXP, S, E);
            SEAM(sb + 9);
        }
        if (PHM(10) && RUN(sb + 10)) { REFRESH();
            const bool lastl = (l == DEPTH - 1);
            ln_phase<2>(F, P_X1, P_O2, F.in[I_LN2G] + l * DM, F.in[I_LN2B] + l * DM, lastl ? F.out : P_XW, P_XB, F.in[I_WIN] + (size_t)(lastl ? l : l + 1) * DM * PROJ + C_AB, PROJ, !lastl, P_ABP, nullptr, nullptr, nullptr, nullptr);
            SEAM(sb + 10);
        }
    }
#undef RUN
#undef SEAM
}

extern "C" void kernel_launch(void* const* d_in, const int* in_sizes, int n_in, void* d_out, int out_size, void* d_ws, size_t ws_size, hipStream_t stream) {
    static int grid = 0;
    if (grid == 0) {
        if (n_in != 18 || out_size != NTOK * DM || ws_size < WS_END) { fprintf(stderr, "kernel_launch: unexpected shapes (n_in %d, out %d, ws %zu < %zu)\n", n_in, out_size, ws_size, (size_t)WS_END); grid = -1; return; }
        int dev = 0, cus = 0, per_cu = 0;
        if (hipGetDevice(&dev) != hipSuccess || hipDeviceGetAttribute(&cus, hipDeviceAttributeMultiprocessorCount, dev) != hipSuccess) { grid = -1; return; }
        if (hipFuncSetAttribute((const void*)fwd_kernel, hipFuncAttributeMaxDynamicSharedMemorySize, LDS_BYTES) != hipSuccess) { fprintf(stderr, "kernel_launch: hipFuncSetAttribute failed\n"); grid = -1; return; }
        if (hipOccupancyMaxActiveBlocksPerMultiprocessor(&per_cu, (const void*)fwd_kernel, NTHREADS, LDS_BYTES) != hipSuccess || per_cu < 1) { fprintf(stderr, "kernel_launch: occupancy query says %d\n", per_cu); }
        (void)hipGetLastError();
        grid = cus;
    }
    if (grid < 0) return;
    (void)hipMemsetAsync((char*)d_ws + WS_CTL, 0, CTL_BYTES, stream);
    Args a{};
    for (int i = 0; i < 18; ++i) a.in[i] = (const float*)d_in[i];
    a.out = (float*)d_out; a.ws = (unsigned char*)d_ws;
#if MK_ONE_LAUNCH
    a.s_lo = 0; a.s_hi = NSTEPS;
    hipLaunchKernelGGL(fwd_kernel, dim3(grid), dim3(NTHREADS), LDS_BYTES, stream, a);
#else
    for (int s = 0; s < NSTEPS; ++s) {
        if ((s - 1) % NS == 4 && s > 0) continue;
        a.s_lo = s; a.s_hi = s + 1;
        hipLaunchKernelGGL(fwd_kernel, dim3(grid), dim3(NTHREADS), LDS_BYTES, stream, a);
    }
#endif
}
```

```cpp
#include <hip/hip_runtime.h>
#include <cstdio>
#include <cstdint>

#ifndef MK_ONE_LAUNCH
#define MK_ONE_LAUNCH 1
#endif
#ifndef DN_NAIVE
#define DN_NAIVE 0
#endif

#define DI __device__ __forceinline__
#define LAS __attribute__((address_space(3)))
#define GAS __attribute__((address_space(1)))
typedef unsigned short bf16;
typedef short bf16x8 __attribute__((ext_vector_type(8)));
typedef short s16x4 __attribute__((ext_vector_type(4)));
typedef float f32x4 __attribute__((ext_vector_type(4)));
typedef float f32x2 __attribute__((ext_vector_type(2)));
typedef unsigned u32x4 __attribute__((ext_vector_type(4)));
typedef unsigned u32x2 __attribute__((ext_vector_type(2)));

constexpr int NTOK = 8192, SEQ = 4096, DM = 2048, PROJ = 5392, PN = 5376, DEPTH = 4;
constexpr int C_SQ = 0, C_SK = 1024, C_SV = 1152, C_DQ = 1280, C_DK = 2304, C_DV = 3328, C_DZ = 4352, C_AB = 5376;
constexpr int NEXP = 16, DEXP = 512;
constexpr float ALPHA = 1.681792830507429f;
constexpr float LN_EPS = 1e-5f, RMS_EPS = 1e-6f;

constexpr size_t MiB = 1u << 20;
constexpr size_t WS_CTL = 0, CTL_BYTES = 1 * MiB;
constexpr size_t WS_COS = 1 * MiB, WS_SIN = 2 * MiB;
constexpr size_t WS_AB = 4 * MiB;
constexpr size_t WS_G = 4 * MiB + 512 * 1024, WS_BETA = WS_G + 256 * 1024;
constexpr size_t WS_WSEL = 5 * MiB, WS_LIST = 5 * MiB + 64 * 1024;
constexpr size_t WS_WIN = 8 * MiB, WS_WOUT = 50 * MiB, WS_WGU = 66 * MiB, WS_WD = 194 * MiB;
constexpr size_t WS_X = 258 * MiB, WS_XB = 322 * MiB, WS_PROJ = 354 * MiB, WS_Y = 438 * MiB, WS_X1 = 502 * MiB, WS_X1B = 566 * MiB;
constexpr size_t WS_CAT = 598 * MiB, WS_OBUF = 630 * MiB, WS_QKV = 662 * MiB, WS_SCAN = 710 * MiB, WS_HID = 798 * MiB, WS_O2 = 814 * MiB, WS_END = 878 * MiB;
constexpr int CW_BAR = 4096;
constexpr int CW_CNT = 64;

DI unsigned f2bf(float f) { unsigned u = __builtin_bit_cast(unsigned, f); return (u + 0x7fffu + ((u >> 16) & 1u)) >> 16; }
DI unsigned pk2(float lo, float hi) { return f2bf(lo) | (f2bf(hi) << 16); }
DI float bflo(unsigned w) { return __builtin_bit_cast(float, w << 16); }
DI float bfhi(unsigned w) { return __builtin_bit_cast(float, w & 0xffff0000u); }
#define swz_xor(v, pat) __builtin_bit_cast(float, __builtin_amdgcn_ds_swizzle(__builtin_bit_cast(int, (float)(v)), (pat)))
#define SWZ_X1 0x041F
#define SWZ_X2 0x081F
#define SWZ_X4 0x101F
#define SWZ_X8 0x201F
#define SWZ_X16 0x401F
DI float xor32_sum(float v) { const unsigned u = __builtin_bit_cast(unsigned, v); const auto r = __builtin_amdgcn_permlane32_swap(u, u, false, false); return __builtin_bit_cast(float, (unsigned)r[0]) + __builtin_bit_cast(float, (unsigned)r[1]); }
DI float xor32_max(float v) { const unsigned u = __builtin_bit_cast(unsigned, v); const auto r = __builtin_amdgcn_permlane32_swap(u, u, false, false); return fmaxf(__builtin_bit_cast(float, (unsigned)r[0]), __builtin_bit_cast(float, (unsigned)r[1])); }
DI float wave_sum(float v) {
    v += swz_xor(v, SWZ_X1); v += swz_xor(v, SWZ_X2); v += swz_xor(v, SWZ_X4); v += swz_xor(v, SWZ_X8); v += swz_xor(v, SWZ_X16);
    return xor32_sum(v);
}
DI float sigmoidf_(float x) { return 1.0f / (1.0f + __expf(-x)); }
DI float siluf_(float x) { return x / (1.0f + __expf(-x)); }
#define LDS_WAIT() asm volatile("s_waitcnt lgkmcnt(0)" ::: "memory")

#define XB_TMO      128
#define XB_XCNT(j)  (256  + 64 * (j))
#define XB_XSUB(j)  (1280 + 64 * (j))
#define XB_XGEN(j)  (2304 + 64 * (j))
#define XB_TOP      3328
#define XB_TOPGEN   3392
#define XCD_BAR_WORDS 3456
#define XB_SPIN_CAP (1u << 18)
__device__ __forceinline__ unsigned xb_ld(unsigned* p)              { return __hip_atomic_load(p, __ATOMIC_RELAXED, __HIP_MEMORY_SCOPE_AGENT); }
__device__ __forceinline__ unsigned xb_add(unsigned* p, unsigned v) { return __hip_atomic_fetch_add(p, v, __ATOMIC_RELAXED, __HIP_MEMORY_SCOPE_AGENT); }
__device__ __forceinline__ unsigned xb_xcc_id() { return (unsigned)__builtin_amdgcn_s_getreg((3 << 11) | 20) & 0xFu; }
#define XB_SPIN(cond, bar) do { unsigned _sp = 0; while (cond) { __builtin_amdgcn_s_sleep(1); \
    if ((++_sp & 255u) == 0u) { if (xb_ld(&(bar)[XB_TMO])) break; if (_sp > XB_SPIN_CAP) { atomicAdd(&(bar)[XB_TMO], 1u); break; } } } } while (0)
struct XcdBarrier { unsigned* bar; unsigned x; volatile LAS unsigned* st; };
__device__ __forceinline__ XcdBarrier xcd_barrier_post(unsigned* bar, volatile LAS unsigned* st) {
    XcdBarrier b; b.bar = bar; b.x = xb_xcc_id(); b.st = st;
    if (threadIdx.x == 0) (void)xb_add(&bar[XB_XCNT(b.x)], 1u);
    return b;
}
__device__ __forceinline__ void xcd_barrier_complete(unsigned* bar, unsigned x, unsigned& nloc, unsigned& nx) {
    const unsigned G = gridDim.x * gridDim.y * gridDim.z;
    unsigned sum, cnt, mine, sp = 0u;
    for (;;) {
        sum = 0u; cnt = 0u; mine = 0u;
#pragma unroll
        for (unsigned j = 0; j < 16; ++j) { const unsigned c = xb_ld(&bar[XB_XCNT(j)]); sum += c; cnt += (c > 0u) ? 1u : 0u; mine = (j == x) ? c : mine; }
        if (sum == G) break;
        __builtin_amdgcn_s_sleep(1);
        if ((++sp & 255u) == 0u) { if (xb_ld(&bar[XB_TMO])) break; if (sp > XB_SPIN_CAP) { atomicAdd(&bar[XB_TMO], 1u); break; } }
    }
    nloc = mine > 0u ? mine : 1u; nx = cnt > 0u ? cnt : 1u;
}
__device__ __forceinline__ void xcd_barrier(const XcdBarrier& b) {
    asm volatile("s_waitcnt vmcnt(0)" ::: "memory");
    __syncthreads();
    if (threadIdx.x == 0) {
        unsigned* bar = b.bar;
        __builtin_amdgcn_s_waitcnt(0);
        unsigned nloc = b.st[0], nx = b.st[1];
        if (nloc == 0u) { xcd_barrier_complete(bar, b.x, nloc, nx); b.st[0] = nloc; b.st[1] = nx; }
        const unsigned old = xb_add(&bar[XB_XSUB(b.x)], 1u);
        const unsigned gen = old / nloc;
        if (old + 1u == (gen + 1u) * nloc) {
            __builtin_amdgcn_fence(__ATOMIC_RELEASE, "agent");
            asm volatile("s_waitcnt vmcnt(0)" ::: "memory");
            const unsigned og = xb_add(&bar[XB_TOP], 1u);
            const unsigned tg = og / nx;
            if (og + 1u == (tg + 1u) * nx) xb_add(&bar[XB_TOPGEN], 1u);
            else XB_SPIN(xb_ld(&bar[XB_TOPGEN]) == tg, bar);
            __builtin_amdgcn_fence(__ATOMIC_ACQUIRE, "agent");
            xb_add(&bar[XB_XGEN(b.x)], 1u);
            asm volatile("s_waitcnt vmcnt(0)" ::: "memory");
        } else {
            XB_SPIN(xb_ld(&bar[XB_XGEN(b.x)]) == gen, bar);
            __builtin_amdgcn_fence(__ATOMIC_ACQUIRE, "agent");
            asm volatile("s_waitcnt vmcnt(0)" ::: "memory");
        }
    }
    __syncthreads();
}

namespace g8 {
constexpr int BM = 256, BK = 64, HALF = 128, HTB = HALF * BK * 2, STAGE_BYTES = 8 * HTB, NXCD = 8, WGM = 8;
DI int lds_byte(int r, int c) { const int st = (r >> 4) * 2 + (c >> 5), rr = r & 15, cc = c & 31, ob = rr * 64 + cc * 2; return st * 1024 + (ob ^ (((ob >> 9) & 1) << 5)); }
DI void stage_rc(int b, int& R, int& C) { const int st = b / 1024, sb = b % 1024, swz = sb ^ (((sb >> 9) & 1) << 5); R = (st >> 1) * 16 + swz / 64; C = (st & 1) * 32 + (swz % 64) / 2; }
DI int perm32(int rho) { const int n = rho >> 4, i = rho & 15; return 8 * (i >> 2) + 4 * n + (i & 3); }

struct Unit { const char* B; int m0, n0, rows, e; };

template <int M_, int N_, int K_> struct DenseSched {
    static constexpr bool GATHER = false;
    static constexpr int nM = M_ / BM, nN = N_ / BM, nwg = nM * nN, K = K_;
    int G, c; const char* Bt;
    DI void init(const void* Bt_, int G_, int c_) { G = G_; c = c_; Bt = (const char*)Bt_; }
    DI bool next(int i, Unit& u) const {
        const int L = i * G + c; if (L >= nwg) return false;
        int wgid = L; { constexpr int q = nwg / NXCD, r = nwg % NXCD; const int xcd = wgid % NXCD, off = wgid / NXCD; wgid = (xcd < r ? xcd * (q + 1) : r * (q + 1) + (xcd - r) * q) + off; }
        constexpr int nig = WGM * nN; const int gid = wgid / nig, fm = gid * WGM, gsz = (nM - fm) < WGM ? (nM - fm) : WGM;
        const int pm = fm + ((wgid % nig) % gsz), pn = (wgid % nig) / gsz;
        u.m0 = pm * BM; u.n0 = pn * BM; u.rows = BM; u.e = 0; u.B = Bt + (size_t)pn * BM * K * 2; return true;
    }
    DI unsigned arow(const Unit& u, int r) const { return (unsigned)(u.m0 + r); }
};
template <bool TOKEN_ROWS> struct MoeSched {
    static constexpr bool GATHER = true;
    const LAS int* tab; const int* list; const char* W; size_t wstride; int NB, K, G, c, total;
    DI bool next(int i, Unit& u) const {
        const int L = i * G + c; if (L >= total) return false;
        const int mt = L / NB, nb = L - mt * NB;
        int e = 0;
#pragma unroll
        for (int j = 1; j < 16; ++j) e += (tab[j] <= mt) ? 1 : 0;
        const int ti = mt - tab[e], cnt = tab[17 + e];
        u.e = e; u.m0 = e * NTOK + ti * BM; u.rows = (cnt - ti * BM) < BM ? (cnt - ti * BM) : BM; u.n0 = nb * BM;
        u.B = W + (size_t)e * wstride + (size_t)nb * BM * K * 2; return true;
    }
    DI unsigned arow(const Unit& u, int r) const { const int rr = r < u.rows ? r : 0; const unsigned en = (unsigned)list[u.m0 + rr]; return TOKEN_ROWS ? (en & (NTOK - 1)) : en; }
};

DI unsigned cvt_pk_bf16(float lo, float hi) { unsigned r; asm volatile("v_cvt_pk_bf16_f32 %0, %1, %2" : "=v"(r) : "v"(lo), "v"(hi)); return r; }

struct EpiBf16 {
    static constexpr bool PERM = true;
    bf16* O; int ldc;
    DI void operator()(const f32x4 (&acc)[2][2][4][2], const Unit& u, int wr, int wc, int fr, int fq) const {
        const int row0 = u.m0 + wr * 64 + fr, col0 = u.n0 + wc * 32 + 8 * fq;
#pragma unroll
        for (int ai = 0; ai < 2; ++ai)
#pragma unroll
            for (int m = 0; m < 4; ++m) { bf16* rowp = O + (size_t)(row0 + ai * HALF + m * 16) * ldc + col0;
#pragma unroll
                for (int bj = 0; bj < 2; ++bj) { const f32x4 v0 = acc[ai][bj][m][0], v1 = acc[ai][bj][m][1];
                    u32x4 w; w.x = cvt_pk_bf16(v0[0], v0[1]); w.y = cvt_pk_bf16(v0[2], v0[3]); w.z = cvt_pk_bf16(v1[0], v1[1]); w.w = cvt_pk_bf16(v1[2], v1[3]);
                    *(u32x4*)(rowp + bj * HALF) = w; } }
    }
};
struct EpiResid {
    static constexpr bool PERM = false;
    const float* X; float* Y;
    DI void operator()(const f32x4 (&acc)[2][2][4][2], const Unit& u, int wr, int wc, int fr, int fq) const {
        const int row0 = u.m0 + wr * 64 + fr, col0 = u.n0 + wc * 32 + 4 * fq;
#pragma unroll
        for (int ai = 0; ai < 2; ++ai)
#pragma unroll
            for (int m = 0; m < 4; ++m) { const size_t off = (size_t)(row0 + ai * HALF + m * 16) * DM + col0;
#pragma unroll
                for (int bj = 0; bj < 2; ++bj)
#pragma unroll
                    for (int n = 0; n < 2; ++n) { const f32x4 xr = *(const f32x4*)(X + off + bj * HALF + n * 16); *(f32x4*)(Y + off + bj * HALF + n * 16) = xr * ALPHA + acc[ai][bj][m][n]; } }
    }
};
struct EpiSwiglu {
    static constexpr bool PERM = true;
    bf16* H; const int* list; const float* wsel;
    DI void operator()(const f32x4 (&acc)[2][2][4][2], const Unit& u, int wr, int wc, int fr, int fq) const {
        const int col0 = (u.n0 >> 1) + wc * 32 + 8 * fq;
#pragma unroll
        for (int ai = 0; ai < 2; ++ai)
#pragma unroll
            for (int m = 0; m < 4; ++m) { const int r = ai * HALF + wr * 64 + m * 16 + fr;
                if (r < u.rows) { const int en = list[u.m0 + r]; const float ws = wsel[en];
                    const f32x4 g0 = acc[ai][0][m][0], g1 = acc[ai][0][m][1], u0 = acc[ai][1][m][0], u1 = acc[ai][1][m][1];
                    float h[8];
#pragma unroll
                    for (int j = 0; j < 4; ++j) { h[j] = siluf_(g0[j]) * u0[j] * ws; h[4 + j] = siluf_(g1[j]) * u1[j] * ws; }
                    u32x4 w; w.x = cvt_pk_bf16(h[0], h[1]); w.y = cvt_pk_bf16(h[2], h[3]); w.z = cvt_pk_bf16(h[4], h[5]); w.w = cvt_pk_bf16(h[6], h[7]);
                    *(u32x4*)(H + (size_t)en * DEXP + col0) = w; } }
    }
};
struct EpiDown {
    static constexpr bool PERM = true;
    bf16* O; const int* list;
    DI void operator()(const f32x4 (&acc)[2][2][4][2], const Unit& u, int wr, int wc, int fr, int fq) const {
        const int col0 = u.n0 + wc * 32 + 8 * fq;
#pragma unroll
        for (int ai = 0; ai < 2; ++ai)
#pragma unroll
            for (int m = 0; m < 4; ++m) { const int r = ai * HALF + wr * 64 + m * 16 + fr;
                if (r < u.rows) { const int en = list[u.m0 + r]; bf16* rowp = O + (size_t)en * DM + col0;
#pragma unroll
                    for (int bj = 0; bj < 2; ++bj) { const f32x4 v0 = acc[ai][bj][m][0], v1 = acc[ai][bj][m][1];
                        u32x4 w; w.x = cvt_pk_bf16(v0[0], v0[1]); w.y = cvt_pk_bf16(v0[2], v0[3]); w.z = cvt_pk_bf16(v1[0], v1[1]); w.w = cvt_pk_bf16(v1[2], v1[3]);
                        *(u32x4*)(rowp + bj * HALF) = w; } } }
    }
};

template <class Epi, class Sched>
DI void gemm_phase(LAS unsigned char* lds, const int wave_id, const char* Abase, const int K, const Sched& S, const Epi& E) {
    int z_ = 0; asm volatile("" : "+v"(z_));
    const int lane = __builtin_amdgcn_mbcnt_hi(-1, __builtin_amdgcn_mbcnt_lo(-1, z_)), wid = wave_id, tid = wid * 64 + lane, wr = wid >> 2, wc = wid & 3, fr = lane & 15, fq = lane >> 4;
    const int nt = K / BK;
    constexpr bool GATHER = Sched::GATHER;
    int Rr[2]; unsigned C2[2], voffB[2], voffA[2];
#pragma unroll
    for (int i = 0; i < 2; ++i) { int R, C; stage_rc(tid * 16 + i * 8192, R, C); const int Rb = Epi::PERM ? ((R & ~31) + perm32(R & 31)) : R;
        Rr[i] = R; C2[i] = (unsigned)C * 2u; voffB[i] = (unsigned)(Rb * K + C) * 2u; voffA[i] = (unsigned)(R * K + C) * 2u; }
    const size_t kstep = (size_t)(BK * 2);
    const size_t hstepB = (size_t)HALF * K * 2;
    const size_t tstepA = (size_t)K * 2;
    const unsigned ldsw = (unsigned)wid * 1024u;
    const int aoff = lds_byte(wr * 64 + fr, fq * 8), boff = lds_byte(wc * 32 + fr, fq * 8);
#define G8_SA(b, h) (((b) * 2 + (h)) * HTB)
#define G8_SB(b, h) ((4 + (b) * 2 + (h)) * HTB)
#define G8_STAGE(bufoff, gbase, voff) do { _Pragma("unroll") for (int _i = 0; _i < 2; ++_i) \
        __builtin_amdgcn_global_load_lds((const unsigned*)((const char*)(gbase) + (voff)[_i]), (LAS unsigned*)(lds + (bufoff) + ldsw + _i * 8192), 16, 0, 0); } while (0)
#define G8_LDA(dst, b, h) do { _Pragma("unroll") for (int m = 0; m < 4; ++m) _Pragma("unroll") for (int k = 0; k < 2; ++k) dst[m][k] = *(const LAS bf16x8*)(lds + G8_SA(b, h) + aoff + m * 2048 + k * 1024); } while (0)
#define G8_LDB(dst, b, h) do { _Pragma("unroll") for (int n = 0; n < 2; ++n) _Pragma("unroll") for (int k = 0; k < 2; ++k) dst[n][k] = *(const LAS bf16x8*)(lds + G8_SB(b, h) + boff + n * 2048 + k * 1024); } while (0)
#define G8_MMA(ai, bj, At, Bt) do { __builtin_amdgcn_s_setprio(1); _Pragma("unroll") for (int m = 0; m < 4; ++m) _Pragma("unroll") for (int n = 0; n < 2; ++n) _Pragma("unroll") for (int k = 0; k < 2; ++k) \
        acc[ai][bj][m][n] = __builtin_amdgcn_mfma_f32_16x16x32_bf16(Bt[n][k], At[m][k], acc[ai][bj][m][n], 0, 0, 0); __builtin_amdgcn_s_setprio(0); } while (0)
#define G8_WAIT_V(n) asm volatile("s_waitcnt vmcnt(" #n ")" ::: "memory")
#define G8_WAIT_L(n) asm volatile("s_waitcnt lgkmcnt(" #n ")" ::: "memory")
#define G8_BAR __builtin_amdgcn_s_barrier()
#define G8_SCHED __builtin_amdgcn_sched_barrier(0)
    Unit cur, nxt; int ui = 0;
    if (!S.next(0, cur)) return;
    f32x4 acc[2][2][4][2];
#pragma unroll
    for (int a = 0; a < 2; ++a)
#pragma unroll
        for (int b = 0; b < 2; ++b)
#pragma unroll
            for (int m = 0; m < 4; ++m)
#pragma unroll
                for (int n = 0; n < 2; ++n) acc[a][b][m][n] = (f32x4){0.f, 0.f, 0.f, 0.f};
    bf16x8 At[4][2], B0[2][2], B1[2][2];
    unsigned vAc[2][2], vAn[2][2];
    const char* cA0 = Abase; const char* cA1 = Abase;
    if constexpr (GATHER) {
#pragma unroll
        for (int h = 0; h < 2; ++h)
#pragma unroll
            for (int i = 0; i < 2; ++i) vAc[h][i] = S.arow(cur, h * HALF + Rr[i]) * (unsigned)(K * 2) + C2[i];
    } else {
        cA0 = Abase + (size_t)cur.m0 * tstepA; cA1 = cA0 + (size_t)HALF * tstepA;
#pragma unroll
        for (int h = 0; h < 2; ++h)
#pragma unroll
            for (int i = 0; i < 2; ++i) vAc[h][i] = voffA[i];
    }
    const char* cB = cur.B;
    G8_STAGE(G8_SB(0, 0), cB, voffB); G8_STAGE(G8_SA(0, 0), cA0, vAc[0]); G8_STAGE(G8_SB(0, 1), cB + hstepB, voffB); G8_STAGE(G8_SA(0, 1), cA1, vAc[1]);
    if (wr == 1) G8_BAR;
    G8_WAIT_V(4); G8_BAR;
    G8_STAGE(G8_SB(1, 0), cB + kstep, voffB); G8_STAGE(G8_SA(1, 0), cA0 + kstep, vAc[0]); G8_STAGE(G8_SB(1, 1), cB + hstepB + kstep, voffB);
    G8_WAIT_V(6); G8_BAR;
    for (;;) {
        const bool has_next = S.next(ui + 1, nxt);
        const char* nB = has_next ? nxt.B : cB;
        const char* nA0 = cA0; const char* nA1 = cA1;
        if constexpr (GATHER) {
#pragma unroll
            for (int h = 0; h < 2; ++h)
#pragma unroll
                for (int i = 0; i < 2; ++i) vAn[h][i] = has_next ? (S.arow(nxt, h * HALF + Rr[i]) * (unsigned)(K * 2) + C2[i]) : vAc[h][i];
        } else {
            if (has_next) { nA0 = Abase + (size_t)nxt.m0 * tstepA; nA1 = nA0 + (size_t)HALF * tstepA; }
        }
        for (int t = 0; t < nt; t += 2) {
            const bool last = (t == nt - 2);
            const char* a1h1 = cA1 + (size_t)(t + 1) * kstep;
            const char* a2h0 = last ? nA0 : cA0 + (size_t)(t + 2) * kstep; const char* a2h1 = last ? nA1 : cA1 + (size_t)(t + 2) * kstep;
            const char* b2 = last ? nB : cB + (size_t)(t + 2) * kstep;
            const char* a3h0 = a2h0 + kstep; const char* b3 = b2 + kstep;
            unsigned va2[2][2];
#pragma unroll
            for (int h = 0; h < 2; ++h)
#pragma unroll
                for (int i = 0; i < 2; ++i) va2[h][i] = (GATHER && last) ? vAn[h][i] : vAc[h][i];
            G8_LDB(B0, 0, 0); G8_SCHED; G8_LDA(At, 0, 0); G8_STAGE(G8_SA(1, 1), a1h1, vAc[1]);
            G8_WAIT_L(8); G8_BAR; G8_WAIT_L(0); G8_MMA(0, 0, At, B0); G8_BAR; G8_SCHED;
            G8_LDB(B1, 0, 1); G8_STAGE(G8_SB(0, 0), b2, voffB);
            G8_BAR; G8_WAIT_L(0); G8_MMA(0, 1, At, B1); G8_BAR;
            G8_LDA(At, 0, 1); G8_STAGE(G8_SA(0, 0), a2h0, va2[0]);
            G8_BAR; G8_WAIT_L(0); G8_MMA(1, 0, At, B0); G8_BAR; G8_SCHED;
            G8_STAGE(G8_SB(0, 1), b2 + hstepB, voffB);
            G8_WAIT_V(6); G8_BAR; G8_MMA(1, 1, At, B1); G8_BAR;
            G8_LDB(B0, 1, 0); G8_SCHED; G8_LDA(At, 1, 0); G8_STAGE(G8_SA(0, 1), a2h1, va2[1]);
            G8_WAIT_L(8); G8_BAR; G8_WAIT_L(0); G8_MMA(0, 0, At, B0); G8_BAR; G8_SCHED;
            G8_LDB(B1, 1, 1); G8_STAGE(G8_SB(1, 0), b3, voffB);
            G8_BAR; G8_WAIT_L(0); G8_MMA(0, 1, At, B1); G8_BAR;
            G8_LDA(At, 1, 1); G8_STAGE(G8_SA(1, 0), a3h0, va2[0]);
            G8_BAR; G8_WAIT_L(0); G8_MMA(1, 0, At, B0); G8_BAR; G8_SCHED;
            G8_STAGE(G8_SB(1, 1), b3 + hstepB, voffB);
            G8_WAIT_V(6); G8_BAR; G8_MMA(1, 1, At, B1); G8_BAR;
        }
        E(acc, cur, wr, wc, fr, fq);
        if (!has_next) break;
#pragma unroll
        for (int a = 0; a < 2; ++a)
#pragma unroll
            for (int b = 0; b < 2; ++b)
#pragma unroll
                for (int m = 0; m < 4; ++m)
#pragma unroll
                    for (int n = 0; n < 2; ++n) acc[a][b][m][n] = (f32x4){0.f, 0.f, 0.f, 0.f};
        cur = nxt; cB = nB; cA0 = nA0; cA1 = nA1; ++ui;
        if constexpr (GATHER) {
#pragma unroll
            for (int h = 0; h < 2; ++h)
#pragma unroll
                for (int i = 0; i < 2; ++i) vAc[h][i] = vAn[h][i];
        }
    }
    G8_WAIT_V(0);
    if (wr == 0) G8_BAR;
    G8_BAR;
#undef G8_SA
#undef G8_SB
#undef G8_STAGE
#undef G8_LDA
#undef G8_LDB
#undef G8_MMA
#undef G8_WAIT_V
#undef G8_WAIT_L
#undef G8_BAR
#undef G8_SCHED
}
}

constexpr int NWAVES = 8, NTHREADS = 512;
constexpr int RING_BYTES = 131072;
constexpr int LN_STRIDE = 2052;
constexpr int LN_TILE_BYTES = 16 * LN_STRIDE * 4;
constexpr int LN_PART_OFF = LN_TILE_BYTES, LN_LOGIT_OFF = LN_PART_OFF + 8192;
constexpr int MOETAB_OFF = 141312;
constexpr int MISC_OFF = 141824;
constexpr int LDS_BYTES = 147456;
static_assert(LN_LOGIT_OFF + 1024 <= MOETAB_OFF && MISC_OFF + 16 <= LDS_BYTES, "LDS map");

struct Frame {
    LAS unsigned char* lds;
    int tid, lane, wave, G, bid;
    unsigned char* ws;
    const float* const* in;
    float* out;
};
enum { I_X = 0, I_POS, I_WIN, I_SINK, I_CONVW, I_ALOG, I_DTB, I_DNW, I_WOUT, I_LN1G, I_LN1B, I_RW, I_RB, I_WG, I_WU, I_WDN, I_LN2G, I_LN2B };

DI void transpose_item(const float* W, int ldw, bf16* WT, int ldt, int k0, int n0, int drow0, LAS float* scr, int lane) {
#pragma unroll 8
    for (int i = 0; i < 32; ++i) { const int kk = 2 * i + (lane >> 5); scr[kk * 33 + (lane & 31)] = W[(size_t)(k0 + kk) * ldw + n0 + (lane & 31)]; }
    LDS_WAIT(); asm volatile("" ::: "memory");
    const int c = lane & 7;
#pragma unroll
    for (int j = 0; j < 4; ++j) { const int n = (lane >> 3) + 8 * j; const LAS float* s = scr + (8 * c) * 33 + n;
        u32x4 o; o.x = pk2(s[0 * 33], s[1 * 33]); o.y = pk2(s[2 * 33], s[3 * 33]); o.z = pk2(s[4 * 33], s[5 * 33]); o.w = pk2(s[6 * 33], s[7 * 33]);
        *(GAS u32x4*)(WT + (size_t)(drow0 + n) * ldt + k0 + 8 * c) = o; }
    LDS_WAIT(); asm volatile("" ::: "memory");
}
DI void convw_phase(Frame& F, int l, int slot) {
    LAS float* scr = (LAS float*)(F.lds + F.wave * 16384);
    const int gw = F.bid * NWAVES + F.wave, NGW = F.G * NWAVES;
    bf16* win_t = (bf16*)(F.ws + WS_WIN) + (size_t)slot * PN * DM;
    bf16* wout_t = (bf16*)(F.ws + WS_WOUT) + (size_t)slot * DM * DM;
    bf16* wgu_t = (bf16*)(F.ws + WS_WGU) + (size_t)slot * NEXP * 1024 * DM;
    bf16* wd_t = (bf16*)(F.ws + WS_WD) + (size_t)slot * NEXP * DM * DEXP;
    const float* w_in = F.in[I_WIN] + (size_t)l * DM * PROJ;
    const float* w_out = F.in[I_WOUT] + (size_t)l * DM * DM;
    const float* w_g = F.in[I_WG] + (size_t)l * NEXP * DM * DEXP;
    const float* w_u = F.in[I_WU] + (size_t)l * NEXP * DM * DEXP;
    const float* w_d = F.in[I_WDN] + (size_t)l * NEXP * DEXP * DM;
    constexpr int I_IN = 32 * 168, I_OUT = 32 * 64, I_GU = 32 * 16, I_D = 8 * 64, I_E = 2 * I_GU + I_D;
    constexpr int NITEMS = I_IN + I_OUT + NEXP * I_E;
    for (int it = gw; it < NITEMS; it += NGW) {
        int r = it;
        if (r < I_IN) { const int kb = r / 168, nb = r % 168; transpose_item(w_in, PROJ, win_t, DM, kb * 64, nb * 32, nb * 32, scr, F.lane); continue; } r -= I_IN;
        if (r < I_OUT) { const int kb = r / 64, nb = r % 64; transpose_item(w_out, DM, wout_t, DM, kb * 64, nb * 32, nb * 32, scr, F.lane); continue; } r -= I_OUT;
        const int e = r / I_E; r -= e * I_E;
        if (r < 2 * I_GU) { const int up = r / I_GU; r -= up * I_GU; const int kb = r / 16, nb = r % 16, n0 = nb * 32;
            const int drow0 = (n0 >> 7) * 256 + up * 128 + (n0 & 127);
            transpose_item((up ? w_u : w_g) + (size_t)e * DM * DEXP, DEXP, wgu_t + (size_t)e * 1024 * DM, DM, kb * 64, n0, drow0, scr, F.lane); continue; }
        r -= 2 * I_GU;
        { const int kb = r / 64, nb = r % 64; transpose_item(w_d + (size_t)e * DEXP * DM, DM, wd_t + (size_t)e * DM * DEXP, DEXP, kb * 64, nb * 32, nb * 32, scr, F.lane); }
    }
}

DI void rope_phase(Frame& F) {
    float* cs = (float*)(F.ws + WS_COS); float* sn = (float*)(F.ws + WS_SIN);
    const int* pos = (const int*)F.in[I_POS];
    for (int i = F.bid * NTHREADS + F.tid; i < NTOK * 32; i += F.G * NTHREADS) {
        const int t = i >> 5, d = i & 31;
        const float inv = exp2f(-(float)d * (13.287712379549449f / 32.0f));
        const float ang = (float)pos[t] * inv;
        cs[i] = cosf(ang); sn[i] = sinf(ang);
    }
}

template <int MODE>
DI void ln_phase(Frame& F, const float* src, const bf16* o2, const float* gam, const float* bet, float* of32, bf16* obf, const float* W16, int ldw, bool do_logits,
                 float* ab, const float* rbias, unsigned* cnt, int* list, float* wsel) {
    LAS float* tile = (LAS float*)F.lds;
    LAS float* part = (LAS float*)(F.lds + LN_PART_OFF);
    LAS float* logit = (LAS float*)(F.lds + LN_LOGIT_OFF);
    const int lane = F.lane, w = F.wave;
    for (int unit = F.bid; unit < NTOK / 16; unit += F.G) {
        const int row0 = unit * 16;
#pragma unroll 1
        for (int rr = 0; rr < 2; ++rr) {
            const int rl = 2 * w + rr, row = row0 + rl;
            f32x4 v[8];
            const GAS f32x4* sp = (const GAS f32x4*)(src + (size_t)row * DM) + lane;
#pragma unroll
            for (int j = 0; j < 8; ++j) v[j] = sp[64 * j];
            if (MODE == 2) {
                const GAS u32x2* pa = (const GAS u32x2*)(o2 + (size_t)row * DM) + lane;
                const GAS u32x2* pb = (const GAS u32x2*)(o2 + (size_t)(NTOK + row) * DM) + lane;
#pragma unroll
                for (int j = 0; j < 8; ++j) { const u32x2 a = pa[64 * j], b = pb[64 * j];
                    v[j].x = v[j].x * ALPHA + (bflo(a.x) + bflo(b.x)); v[j].y = v[j].y * ALPHA + (bfhi(a.x) + bfhi(b.x));
                    v[j].z = v[j].z * ALPHA + (bflo(a.y) + bflo(b.y)); v[j].w = v[j].w * ALPHA + (bfhi(a.y) + bfhi(b.y)); }
            }
            if (MODE != 0) {
                float s = 0.f;
#pragma unroll
                for (int j = 0; j < 8; ++j) s += (v[j].x + v[j].y) + (v[j].z + v[j].w);
                const float mean = wave_sum(s) * (1.0f / DM); float s2 = 0.f;
#pragma unroll
                for (int j = 0; j < 8; ++j) { v[j] = v[j] - mean; s2 += (v[j].x * v[j].x + v[j].y * v[j].y) + (v[j].z * v[j].z + v[j].w * v[j].w); }
                const float rstd = 1.0f / sqrtf(wave_sum(s2) * (1.0f / DM) + LN_EPS);
#pragma unroll
                for (int j = 0; j < 8; ++j) { const f32x4 g4 = *((const GAS f32x4*)gam + lane + 64 * j), b4 = *((const GAS f32x4*)bet + lane + 64 * j); v[j] = v[j] * rstd * g4 + b4; }
            }
            if (of32) { GAS f32x4* op = (GAS f32x4*)(of32 + (size_t)row * DM) + lane;
#pragma unroll
                for (int j = 0; j < 8; ++j) op[64 * j] = v[j]; }
            { GAS u32x2* op = (GAS u32x2*)(obf + (size_t)row * DM) + lane;
#pragma unroll
                for (int j = 0; j < 8; ++j) { u32x2 o; o.x = pk2(v[j].x, v[j].y); o.y = pk2(v[j].z, v[j].w); op[64 * j] = o; } }
            if (do_logits) {
#pragma unroll
                for (int j = 0; j < 8; ++j) *(LAS f32x4*)(tile + rl * LN_STRIDE + 4 * lane + 256 * j) = v[j];
            }
        }
        if (do_logits) {
            __syncthreads();
            const int m = lane & 15, kq = lane >> 4;
            f32x4 acc = (f32x4){0.f, 0.f, 0.f, 0.f};
            const int kb = 256 * w;
#pragma unroll 4
            for (int s = 0; s < 16; ++s) {
                const int k = kb + 16 * s + 4 * kq;
                const f32x4 a4 = *(const LAS f32x4*)(tile + m * LN_STRIDE + k);
                const float* wp = W16 + (size_t)k * ldw + m;
                const float b0 = wp[0], b1 = wp[ldw], b2 = wp[2 * (size_t)ldw], b3 = wp[3 * (size_t)ldw];
                acc = __builtin_amdgcn_mfma_f32_16x16x4f32(a4.x, b0, acc, 0, 0, 0);
                acc = __builtin_amdgcn_mfma_f32_16x16x4f32(a4.y, b1, acc, 0, 0, 0);
                acc = __builtin_amdgcn_mfma_f32_16x16x4f32(a4.z, b2, acc, 0, 0, 0);
                acc = __builtin_amdgcn_mfma_f32_16x16x4f32(a4.w, b3, acc, 0, 0, 0);
            }
#pragma unroll
            for (int r = 0; r < 4; ++r) part[(w * 16 + 4 * kq + r) * 16 + m] = acc[r];
            __syncthreads();
            if (F.tid < 256) {
                const int r = F.tid >> 4, n = F.tid & 15; float s = 0.f;
#pragma unroll
                for (int ww = 0; ww < 8; ++ww) s += part[(ww * 16 + r) * 16 + n];
                if (MODE == 1) logit[r * 16 + n] = s; else ab[(size_t)(row0 + r) * 16 + n] = s;
            }
            if (MODE == 1) {
                __syncthreads();
                if (F.tid < 16) {
                    const int tok = row0 + F.tid;
                    float sc[16], sel[16];
#pragma unroll
                    for (int e = 0; e < 16; ++e) { sc[e] = sigmoidf_(logit[F.tid * 16 + e]); sel[e] = sc[e] + rbias[e]; }
                    int bg = 0; float bgv = -1e30f; int be0[4], be1[4];
#pragma unroll
                    for (int g = 0; g < 4; ++g) {
                        int i0 = 0; float v0 = sel[4 * g];
#pragma unroll
                        for (int j = 1; j < 4; ++j) if (sel[4 * g + j] > v0) { v0 = sel[4 * g + j]; i0 = j; }
                        int i1 = -1; float v1 = -1e30f;
#pragma unroll
                        for (int j = 0; j < 4; ++j) if (j != i0 && sel[4 * g + j] > v1) { v1 = sel[4 * g + j]; i1 = j; }
                        be0[g] = 4 * g + i0; be1[g] = 4 * g + i1;
                        const float sum = v0 + v1; if (sum > bgv) { bgv = sum; bg = g; }
                    }
                    int e0 = be0[0], e1 = be1[0];
#pragma unroll
                    for (int g = 1; g < 4; ++g) if (bg == g) { e0 = be0[g]; e1 = be1[g]; }
                    float w0 = 0.f, w1 = 0.f;
#pragma unroll
                    for (int e = 0; e < 16; ++e) { if (e == e0) w0 = sc[e]; if (e == e1) w1 = sc[e]; }
                    const float inv = 1.0f / (w0 + w1);
                    const unsigned p0 = atomicAdd(cnt + e0, 1u); list[e0 * NTOK + p0] = tok; wsel[tok] = w0 * inv;
                    const unsigned p1 = atomicAdd(cnt + e1, 1u); list[e1 * NTOK + p1] = NTOK + tok; wsel[NTOK + tok] = w1 * inv;
                }
            }
            __syncthreads();
        }
    }
}

constexpr int KT_PITCH = 72, VT_PITCH = 264;
constexpr int ATT_KT_OFF = 0, ATT_VT_OFF = 256 * KT_PITCH * 2;
DI void attn_unit(Frame& F, int unit, int l) {
    const int b = unit >> 6, kvh = (unit >> 5) & 1, qb = unit & 31;
    const bf16* proj = (const bf16*)(F.ws + WS_PROJ);
    const float* cs = (const float*)(F.ws + WS_COS); const float* sn = (const float*)(F.ws + WS_SIN);
    bf16* cat = (bf16*)(F.ws + WS_CAT);
    LAS unsigned char* kt = F.lds + ATT_KT_OFF; LAS unsigned char* vt = F.lds + ATT_VT_OFF;
    const int tq0 = b * SEQ + qb * 128, tk0 = tq0 - 128;
#pragma unroll
    for (int it = 0; it < 2; ++it) {
        const int idx = F.tid + it * NTHREADS, kj = idx >> 2, c = idx & 3;
        int tk = tk0 + kj; if (tk < b * SEQ) tk = b * SEQ;
        const bf16* kp = proj + (size_t)tk * PN + C_SK + kvh * 64;
        const u32x4 lo = *(const GAS u32x4*)(kp + 8 * c), hi = *(const GAS u32x4*)(kp + 32 + 8 * c);
        const f32x4 c0 = *(const GAS f32x4*)(cs + tk * 32 + 8 * c), c1 = *(const GAS f32x4*)(cs + tk * 32 + 8 * c + 4);
        const f32x4 s0 = *(const GAS f32x4*)(sn + tk * 32 + 8 * c), s1 = *(const GAS f32x4*)(sn + tk * 32 + 8 * c + 4);
        float x1[8], x2[8], cc[8], ss[8];
#pragma unroll
        for (int j = 0; j < 4; ++j) { x1[2 * j] = bflo(lo[j]); x1[2 * j + 1] = bfhi(lo[j]); x2[2 * j] = bflo(hi[j]); x2[2 * j + 1] = bfhi(hi[j]); cc[j] = c0[j]; cc[4 + j] = c1[j]; ss[j] = s0[j]; ss[4 + j] = s1[j]; }
        u32x4 o1, o2;
#pragma unroll
        for (int j = 0; j < 4; ++j) {
            o1[j] = pk2(x1[2 * j] * cc[2 * j] - x2[2 * j] * ss[2 * j], x1[2 * j + 1] * cc[2 * j + 1] - x2[2 * j + 1] * ss[2 * j + 1]);
            o2[j] = pk2(x2[2 * j] * cc[2 * j] + x1[2 * j] * ss[2 * j], x2[2 * j + 1] * cc[2 * j + 1] + x1[2 * j + 1] * ss[2 * j + 1]);
        }
        *(LAS u32x4*)(kt + kj * (KT_PITCH * 2) + 16 * c) = o1;
        *(LAS u32x4*)(kt + kj * (KT_PITCH * 2) + 64 + 16 * c) = o2;
    }
    {
        const int kj = F.tid & 255, dh = F.tid >> 8;
        int tk = tk0 + kj; if (tk < b * SEQ) tk = b * SEQ;
        const bf16* vp = proj + (size_t)tk * PN + C_SV + kvh * 64 + dh * 32;
#pragma unroll
        for (int q = 0; q < 4; ++q) { const u32x4 x = *(const GAS u32x4*)(vp + 8 * q);
#pragma unroll
            for (int j = 0; j < 4; ++j) { const int d = dh * 32 + 8 * q + 2 * j;
                *(LAS unsigned short*)(vt + (d * VT_PITCH + kj) * 2) = (unsigned short)(x[j] & 0xffffu);
                *(LAS unsigned short*)(vt + ((d + 1) * VT_PITCH + kj) * 2) = (unsigned short)(x[j] >> 16); } }
    }
    __syncthreads();
    const int lane = F.lane, n = lane & 15, q4 = lane >> 4, head = kvh * 8 + F.wave;
    const float sink = F.in[I_SINK][l * 16 + head];
#pragma unroll 1
    for (int qt = 0; qt < 8; ++qt) {
        const int qi = 16 * qt + n, tq = tq0 + qi;
        bf16x8 qf[2];
        {
            const bf16* qp = proj + (size_t)tq * PN + C_SQ + head * 64;
            const u32x4 lo = *(const GAS u32x4*)(qp + 8 * q4), hi = *(const GAS u32x4*)(qp + 32 + 8 * q4);
            const f32x4 c0 = *(const GAS f32x4*)(cs + tq * 32 + 8 * q4), c1 = *(const GAS f32x4*)(cs + tq * 32 + 8 * q4 + 4);
            const f32x4 s0 = *(const GAS f32x4*)(sn + tq * 32 + 8 * q4), s1 = *(const GAS f32x4*)(sn + tq * 32 + 8 * q4 + 4);
            float x1[8], x2[8], cc[8], ss[8];
#pragma unroll
            for (int j = 0; j < 4; ++j) { x1[2 * j] = bflo(lo[j]); x1[2 * j + 1] = bfhi(lo[j]); x2[2 * j] = bflo(hi[j]); x2[2 * j + 1] = bfhi(hi[j]); cc[j] = c0[j]; cc[4 + j] = c1[j]; ss[j] = s0[j]; ss[4 + j] = s1[j]; }
            u32x4 o1, o2;
#pragma unroll
            for (int j = 0; j < 4; ++j) {
                o1[j] = pk2(0.125f * (x1[2 * j] * cc[2 * j] - x2[2 * j] * ss[2 * j]), 0.125f * (x1[2 * j + 1] * cc[2 * j + 1] - x2[2 * j + 1] * ss[2 * j + 1]));
                o2[j] = pk2(0.125f * (x2[2 * j] * cc[2 * j] + x1[2 * j] * ss[2 * j]), 0.125f * (x2[2 * j + 1] * cc[2 * j + 1] + x1[2 * j + 1] * ss[2 * j + 1]));
            }
            qf[0] = __builtin_bit_cast(bf16x8, o1); qf[1] = __builtin_bit_cast(bf16x8, o2);
        }
        const int t0 = 2 * (qt >> 1);
        f32x4 s[10];
#pragma unroll
        for (int tt = 0; tt < 10; ++tt) {
            f32x4 a = (f32x4){0.f, 0.f, 0.f, 0.f};
#pragma unroll
            for (int kk = 0; kk < 2; ++kk) {
                const bf16x8 kf = *(const LAS bf16x8*)(kt + (16 * (t0 + tt) + n) * (KT_PITCH * 2) + 64 * kk + 16 * q4);
                a = __builtin_amdgcn_mfma_f32_16x16x32_bf16(kf, qf[kk], a, 0, 0, 0);
            }
            s[tt] = a;
        }
        float mx = sink;
#pragma unroll
        for (int tt = 0; tt < 10; ++tt)
#pragma unroll
            for (int r = 0; r < 4; ++r) { const int kj = 16 * (t0 + tt) + 4 * q4 + r;
                const bool valid = (kj >= qi + 1) && (kj <= qi + 128) && (qb > 0 || kj >= 128);
                s[tt][r] = valid ? s[tt][r] : -INFINITY; mx = fmaxf(mx, s[tt][r]); }
        mx = fmaxf(mx, swz_xor(mx, SWZ_X16)); mx = xor32_max(mx);
        float sum = 0.f;
#pragma unroll
        for (int tt = 0; tt < 10; ++tt)
#pragma unroll
            for (int r = 0; r < 4; ++r) { const float p = __expf(s[tt][r] - mx); s[tt][r] = p; sum += p; }
        sum += swz_xor(sum, SWZ_X16); sum = xor32_sum(sum);
        const float inv = 1.0f / (sum + __expf(sink - mx));
        f32x4 o[4];
#pragma unroll
        for (int dt = 0; dt < 4; ++dt) o[dt] = (f32x4){0.f, 0.f, 0.f, 0.f};
#pragma unroll
        for (int kk = 0; kk < 5; ++kk) {
            u32x4 pw; pw.x = pk2(s[2 * kk][0], s[2 * kk][1]); pw.y = pk2(s[2 * kk][2], s[2 * kk][3]); pw.z = pk2(s[2 * kk + 1][0], s[2 * kk + 1][1]); pw.w = pk2(s[2 * kk + 1][2], s[2 * kk + 1][3]);
            const bf16x8 pf = __builtin_bit_cast(bf16x8, pw);
            const int key0 = 16 * t0 + 32 * kk + 4 * q4;
#pragma unroll
            for (int dt = 0; dt < 4; ++dt) {
                const LAS unsigned char* vp = vt + ((16 * dt + n) * VT_PITCH + key0) * 2;
                const u32x2 va = *(const LAS u32x2*)vp, vb = *(const LAS u32x2*)(vp + 32);
                u32x4 vw; vw.x = va.x; vw.y = va.y; vw.z = vb.x; vw.w = vb.y;
                o[dt] = __builtin_amdgcn_mfma_f32_16x16x32_bf16(__builtin_bit_cast(bf16x8, vw), pf, o[dt], 0, 0, 0);
            }
        }
#pragma unroll
        for (int dt = 0; dt < 4; ++dt) { u32x2 w; w.x = pk2(o[dt][0] * inv, o[dt][1] * inv); w.y = pk2(o[dt][2] * inv, o[dt][3] * inv);
            *(GAS u32x2*)(cat + (size_t)tq * DM + head * 64 + 16 * dt + 4 * q4) = w; }
    }
    __syncthreads();
}

DI void dn_pre_item(Frame& F, int item, int l) {
    const int h = item & 7, ck = (item >> 3) & 63, b = item >> 9;
    const bf16* proj = (const bf16*)(F.ws + WS_PROJ);
    bf16* qn = (bf16*)(F.ws + WS_QKV); bf16* kn = qn + (size_t)NTOK * 1024; bf16* vv = kn + (size_t)NTOK * 1024;
    const int lane = F.lane, tb = b * SEQ + ck * 64;
    {
        const float* ab = (const float*)(F.ws + WS_AB) + (size_t)(tb + lane) * 16;
        const float a = ab[h], bb = ab[8 + h];
        const float x = a + F.in[I_DTB][l * 8 + h];
        const float ex = __expf(x);
        const float sp = (x > 20.f) ? x : ((ex < 0.03f) ? ex * (1.0f - ex * (0.5f - ex * (0.33333333f - 0.25f * ex))) : __logf(1.0f + ex));
        ((float*)(F.ws + WS_G))[(size_t)(tb + lane) * 8 + h] = -__expf(F.in[I_ALOG][l * 8 + h]) * sp;
        ((float*)(F.ws + WS_BETA))[(size_t)(tb + lane) * 8 + h] = sigmoidf_(bb);
    }
    const float* cw = F.in[I_CONVW] + (size_t)l * 4 * 3072;
    float w[3][4][2];
#pragma unroll
    for (int s = 0; s < 3; ++s)
#pragma unroll
        for (int j = 0; j < 4; ++j) { const f32x2 t = *(const GAS f32x2*)(cw + j * 3072 + s * 1024 + h * 128 + 2 * lane); w[s][j][0] = t.x; w[s][j][1] = t.y; }
    const int colq = C_DQ + h * 128 + 2 * lane;
    float hist[3][3][2];
#pragma unroll
    for (int a = 0; a < 3; ++a) {
        const int t = ck * 64 - 3 + a;
#pragma unroll
        for (int s = 0; s < 3; ++s) {
            unsigned x = 0u;
            if (t >= 0) x = *(const GAS unsigned*)(proj + (size_t)(b * SEQ + t) * PN + colq + s * 1024);
            hist[s][a][0] = bflo(x); hist[s][a][1] = bfhi(x);
        }
    }
#pragma unroll 1
    for (int t8 = 0; t8 < 64; t8 += 8) {
        unsigned xs[8][3];
#pragma unroll
        for (int i = 0; i < 8; ++i)
#pragma unroll
            for (int s = 0; s < 3; ++s) xs[i][s] = *(const GAS unsigned*)(proj + (size_t)(tb + t8 + i) * PN + colq + s * 1024);
#pragma unroll
        for (int i = 0; i < 8; ++i) {
            float y[3][2];
#pragma unroll
            for (int s = 0; s < 3; ++s) {
                const float c0 = bflo(xs[i][s]), c1 = bfhi(xs[i][s]);
                const float a0 = w[s][0][0] * hist[s][0][0] + w[s][1][0] * hist[s][1][0] + w[s][2][0] * hist[s][2][0] + w[s][3][0] * c0;
                const float a1 = w[s][0][1] * hist[s][0][1] + w[s][1][1] * hist[s][1][1] + w[s][2][1] * hist[s][2][1] + w[s][3][1] * c1;
                hist[s][0][0] = hist[s][1][0]; hist[s][0][1] = hist[s][1][1]; hist[s][1][0] = hist[s][2][0]; hist[s][1][1] = hist[s][2][1]; hist[s][2][0] = c0; hist[s][2][1] = c1;
                y[s][0] = siluf_(a0); y[s][1] = siluf_(a1);
            }
            const float sq = wave_sum(y[0][0] * y[0][0] + y[0][1] * y[0][1]);
            const float sk = wave_sum(y[1][0] * y[1][0] + y[1][1] * y[1][1]);
            const float rq = 1.0f / sqrtf(sq + RMS_EPS) * 0.08838834764831845f, rk = 1.0f / sqrtf(sk + RMS_EPS);
            const size_t o = (size_t)(tb + t8 + i) * 1024 + h * 128 + 2 * lane;
            *(GAS unsigned*)(qn + o) = pk2(y[0][0] * rq, y[0][1] * rq);
            *(GAS unsigned*)(kn + o) = pk2(y[1][0] * rk, y[1][1] * rk);
            *(GAS unsigned*)(vv + o) = pk2(y[2][0], y[2][1]);
        }
    }
}

DI void dn_naive_phase(Frame& F) {
    if (F.bid >= 16) return;
    const int b = F.bid >> 3, h = F.bid & 7;
    const bf16* qn = (const bf16*)(F.ws + WS_QKV); const bf16* kn = qn + (size_t)NTOK * 1024; const bf16* vv = kn + (size_t)NTOK * 1024;
    const float* gb = (const float*)(F.ws + WS_G); const float* bb = (const float*)(F.ws + WS_BETA);
    float* ob = (float*)(F.ws + WS_OBUF);
    LAS float* kq = (LAS float*)F.lds;
    LAS float* gl = (LAS float*)(F.lds + 65536);
    float S[64];
#pragma unroll
    for (int i = 0; i < 64; ++i) S[i] = 0.f;
    const int vcol = (F.wave & 3) * 32 + (F.lane & 31), kh = F.lane >> 5;
    for (int ck = 0; ck < 64; ++ck) {
        const int tb = b * SEQ + ck * 64;
        __syncthreads();
        for (int i = F.tid; i < 64 * 64; i += NTHREADS) { const int t = i >> 6, d2 = i & 63;
            const unsigned kw = *(const GAS unsigned*)(kn + (size_t)(tb + t) * 1024 + h * 128 + 2 * d2), qw = *(const GAS unsigned*)(qn + (size_t)(tb + t) * 1024 + h * 128 + 2 * d2);
            kq[t * 128 + 2 * d2] = bflo(kw); kq[t * 128 + 2 * d2 + 1] = bfhi(kw); kq[8192 + t * 128 + 2 * d2] = bflo(qw); kq[8192 + t * 128 + 2 * d2 + 1] = bfhi(qw); }
        if (F.tid < 64) { gl[F.tid] = gb[(size_t)(tb + F.tid) * 8 + h]; gl[64 + F.tid] = bb[(size_t)(tb + F.tid) * 8 + h]; }
        __syncthreads();
        if (F.wave < 4) {
#pragma unroll 1
            for (int t = 0; t < 64; ++t) {
                const float vt_ = __builtin_bit_cast(float, ((unsigned)vv[(size_t)(tb + t) * 1024 + h * 128 + vcol]) << 16);
                const float eg = __expf(gl[t]), be = gl[64 + t];
                const LAS float* kp = kq + t * 128 + 64 * kh; const LAS float* qp = kq + 8192 + t * 128 + 64 * kh;
                float ks = 0.f;
#pragma unroll
                for (int i = 0; i < 16; ++i) { const f32x4 k4 = *(const LAS f32x4*)(kp + 4 * i); ks += k4.x * S[4 * i] + k4.y * S[4 * i + 1] + k4.z * S[4 * i + 2] + k4.w * S[4 * i + 3]; }
                ks = xor32_sum(ks);
                const float coef = be * (vt_ - eg * ks);
                float o = 0.f;
#pragma unroll
                for (int i = 0; i < 16; ++i) { const f32x4 k4 = *(const LAS f32x4*)(kp + 4 * i); const f32x4 q4 = *(const LAS f32x4*)(qp + 4 * i);
                    S[4 * i] = eg * S[4 * i] + k4.x * coef; S[4 * i + 1] = eg * S[4 * i + 1] + k4.y * coef; S[4 * i + 2] = eg * S[4 * i + 2] + k4.z * coef; S[4 * i + 3] = eg * S[4 * i + 3] + k4.w * coef;
                    o += q4.x * S[4 * i] + q4.y * S[4 * i + 1] + q4.z * S[4 * i + 2] + q4.w * S[4 * i + 3]; }
                o = xor32_sum(o);
                if (kh == 0) ob[(size_t)(tb + t) * 1024 + h * 128 + vcol] = o;
            }
        }
    }
    __syncthreads();
}

constexpr int OPS_BYTES = 57344, U_BYTES = 32768;
constexpr size_t WS_SCAN_U = WS_SCAN + (size_t)1024 * OPS_BYTES, WS_GLAST = 6 * MiB;
constexpr int DP_PITCH = 272, DP_Q = 0, DP_K = 17408, DP_V = 34816, DP_L = 52224, DP_GC = 69632, DP_BT = 69888, DP_EG = 70144, DP_EK = 70400, DP_GROUP = 70656;
DI void dn_prep_item(Frame& F, int item, int l) {
    int lane = F.lane; asm volatile("" : "+v"(lane));
    const int gi = F.wave >> 2, wg = F.wave & 3; int tg = wg * 64 + lane;
    const int h = item & 7, ck = (item >> 3) & 63, b = item >> 9;
    const int sitem = (b * 8 + h) * 64 + ck;
    const int tb = b * SEQ + ck * 64;
    LAS unsigned char* base = F.lds + gi * DP_GROUP;
    const bf16* qn = (const bf16*)(F.ws + WS_QKV); const bf16* kn = qn + (size_t)NTOK * 1024; const bf16* vv = kn + (size_t)NTOK * 1024;
    unsigned char* ops = F.ws + WS_SCAN + (size_t)sitem * OPS_BYTES;
    float* uo = (float*)(F.ws + WS_SCAN_U + (size_t)sitem * U_BYTES);
    LAS float* gc = (LAS float*)(base + DP_GC); LAS float* bt = (LAS float*)(base + DP_BT); LAS float* eg = (LAS float*)(base + DP_EG); LAS float* ek = (LAS float*)(base + DP_EK);
    LAS float* Lm = (LAS float*)(base + DP_L);
#pragma unroll
    for (int i = 0; i < 4; ++i) { const int p = tg + 256 * i, row = p >> 4, c16 = p & 15; const size_t go = (size_t)(tb + row) * 1024 + h * 128 + c16 * 8;
        const u32x4 a = *(const GAS u32x4*)(qn + go), bb = *(const GAS u32x4*)(kn + go), c = *(const GAS u32x4*)(vv + go);
        *(LAS u32x4*)(base + DP_Q + row * DP_PITCH + c16 * 16) = a; *(LAS u32x4*)(base + DP_K + row * DP_PITCH + c16 * 16) = bb; *(LAS u32x4*)(base + DP_V + row * DP_PITCH + c16 * 16) = c; }
    if (tg < 64) { eg[tg] = ((const float*)(F.ws + WS_G))[(size_t)(tb + tg) * 8 + h]; bt[tg] = ((const float*)(F.ws + WS_BETA))[(size_t)(tb + tg) * 8 + h]; }
    __syncthreads();
    if (tg < 64) { float s = 0.f;
        for (int i = 0; i < 64; ++i) { const float gv = eg[i]; s += (i <= tg) ? gv : 0.f; }
        gc[tg] = s; }
    __syncthreads();
    if (tg < 64) { const float g63 = gc[63], gme = gc[tg]; eg[tg] = __expf(gme); ek[tg] = __expf(g63 - gme);
        if (tg == 0) ((float*)(F.ws + WS_GLAST))[sitem] = __expf(g63); }
    {
        asm volatile("" : "+v"(lane));
        const int n = lane & 15, q4 = lane >> 4;
        bf16x8 ak[4], aq[4];
#pragma unroll
        for (int kk = 0; kk < 4; ++kk) { ak[kk] = *(const LAS bf16x8*)(base + DP_K + (16 * wg + n) * DP_PITCH + (32 * kk + 8 * q4) * 2); aq[kk] = *(const LAS bf16x8*)(base + DP_Q + (16 * wg + n) * DP_PITCH + (32 * kk + 8 * q4) * 2); }
#pragma unroll
        for (int st = 0; st < 4; ++st) {
            f32x4 kkacc = (f32x4){0.f, 0.f, 0.f, 0.f}, qkacc = (f32x4){0.f, 0.f, 0.f, 0.f};
#pragma unroll
            for (int kk = 0; kk < 4; ++kk) { const bf16x8 bk = *(const LAS bf16x8*)(base + DP_K + (16 * st + n) * DP_PITCH + (32 * kk + 8 * q4) * 2);
                kkacc = __builtin_amdgcn_mfma_f32_16x16x32_bf16(ak[kk], bk, kkacc, 0, 0, 0); qkacc = __builtin_amdgcn_mfma_f32_16x16x32_bf16(aq[kk], bk, qkacc, 0, 0, 0); }
            const int sidx = 16 * st + n; const float gs = gc[sidx];
#pragma unroll
            for (int r = 0; r < 4; ++r) { const int c = 16 * wg + 4 * q4 + r; const float dec = (c >= sidx) ? __expf(gc[c] - gs) : 0.f;
                Lm[c * 68 + sidx] = (c > sidx) ? bt[c] * kkacc[r] * dec : 0.f;
                const int m = 4 * q4 + r, kkf = st >> 1, qq = (n >> 2) & 3, j = ((st & 1) << 2) | (n & 3);
                *(GAS unsigned short*)(ops + 49152 + (size_t)(((wg * 2 + kkf) * 64 + qq * 16 + m) * 8 + j) * 2) = (unsigned short)f2bf(qkacc[r] * dec); }
        }
    }
    __syncthreads();
    float X[64];
    asm volatile("" : "+v"(tg));
    {
        const int col = tg & 127; const LAS unsigned char* src = base + ((tg < 128) ? DP_V : DP_K) + col * 2;
#pragma unroll
        for (int c = 0; c < 64; ++c) { const float x = __builtin_bit_cast(float, ((unsigned)*(const LAS unsigned short*)(src + c * DP_PITCH)) << 16); const float sc = bt[c] * ((tg < 128) ? 1.0f : eg[c]); X[c] = x * sc; }
#pragma unroll
        for (int c = 1; c < 64; ++c) {
            float a0 = 0.f, a1 = 0.f, a2 = 0.f, a3 = 0.f;
#pragma unroll
            for (int s4 = 0; s4 < (c + 3) / 4; ++s4) { const f32x4 l4 = *(const LAS f32x4*)(Lm + c * 68 + 4 * s4);
                a0 += l4.x * X[4 * s4]; if (4 * s4 + 1 < c) a1 += l4.y * X[4 * s4 + 1]; if (4 * s4 + 2 < c) a2 += l4.z * X[4 * s4 + 2]; if (4 * s4 + 3 < c) a3 += l4.w * X[4 * s4 + 3]; }
            X[c] -= (a0 + a1) + (a2 + a3);
            if ((c & 3) == 3) asm volatile("" ::: "memory");
        }
    }
    __syncthreads();
    asm volatile("" : "+v"(tg));
    if (tg < 128) { const int vs = tg >> 4, n = tg & 15;
#pragma unroll
        for (int t = 0; t < 4; ++t)
#pragma unroll
            for (int q4 = 0; q4 < 4; ++q4) *(GAS f32x4*)(uo + (size_t)(((vs * 4 + t) * 64 + q4 * 16 + n) * 4)) = (f32x4){X[16 * t + 4 * q4], X[16 * t + 4 * q4 + 1], X[16 * t + 4 * q4 + 2], X[16 * t + 4 * q4 + 3]};
    } else { const int d = tg - 128;
#pragma unroll
        for (int c = 0; c < 64; ++c) *(LAS unsigned short*)(base + DP_V + c * DP_PITCH + d * 2) = (unsigned short)f2bf(X[c]); }
    __syncthreads();
    asm volatile("" : "+v"(tg));
#pragma unroll 1
    for (int i = 0; i < 4; ++i) { const int p = tg + 256 * i, f = p >> 6, ln = p & 63, q = ln >> 4, m = ln & 15, mt = f >> 2, kk = f & 3, c = 16 * mt + m;
        const u32x2 w0 = *(const LAS u32x2*)(base + DP_V + c * DP_PITCH + (32 * kk + 4 * q) * 2), w1 = *(const LAS u32x2*)(base + DP_V + c * DP_PITCH + (32 * kk + 16 + 4 * q) * 2);
        u32x4 wv; wv.x = w0.x; wv.y = w0.y; wv.z = w1.x; wv.w = w1.y;
        *(GAS u32x4*)(ops + (size_t)(f * 64 + ln) * 16) = wv;
        const u32x2 q0 = *(const LAS u32x2*)(base + DP_Q + c * DP_PITCH + (32 * kk + 4 * q) * 2), q1 = *(const LAS u32x2*)(base + DP_Q + c * DP_PITCH + (32 * kk + 16 + 4 * q) * 2);
        const float e = eg[c]; u32x4 qv;
        qv.x = pk2(bflo(q0.x) * e, bfhi(q0.x) * e); qv.y = pk2(bflo(q0.y) * e, bfhi(q0.y) * e); qv.z = pk2(bflo(q1.x) * e, bfhi(q1.x) * e); qv.w = pk2(bflo(q1.y) * e, bfhi(q1.y) * e);
        *(GAS u32x4*)(ops + 16384 + (size_t)(f * 64 + ln) * 16) = qv;
        const int mt8 = f >> 1, kk2 = f & 1, d = 16 * mt8 + m; float kv[8];
#pragma unroll
        for (int j = 0; j < 8; ++j) { const int cc = 32 * kk2 + 16 * (j >> 2) + 4 * q + (j & 3);
            kv[j] = __builtin_bit_cast(float, ((unsigned)*(const LAS unsigned short*)(base + DP_K + cc * DP_PITCH + d * 2)) << 16) * ek[cc]; }
        u32x4 kw; kw.x = pk2(kv[0], kv[1]); kw.y = pk2(kv[2], kv[3]); kw.z = pk2(kv[4], kv[5]); kw.w = pk2(kv[6], kv[7]);
        *(GAS u32x4*)(ops + 32768 + (size_t)(f * 64 + ln) * 16) = kw; }
    __syncthreads();
}

DI void dn_scan_phase(Frame& F) {
    if (F.bid >= 32) return;
    const int bh = F.bid >> 1, vg = F.bid & 1, b = bh >> 3, h = bh & 7, lane = F.lane;
    const unsigned char* opsg = F.ws + WS_SCAN + (size_t)bh * 64 * OPS_BYTES;
    const float* ug = (const float*)(F.ws + WS_SCAN_U + (size_t)bh * 64 * U_BYTES);
    const float* glast = (const float*)(F.ws + WS_GLAST) + bh * 64;
    float* ob = (float*)(F.ws + WS_OBUF);
    const bool loader = F.wave >= 4;
    const int lw = F.wave - 4;
    if (loader) {
#pragma unroll
        for (int p = 0; p < 14; ++p) __builtin_amdgcn_global_load_lds((const unsigned*)(opsg + (size_t)(lw * 14 + p) * 1024 + lane * 16), (LAS unsigned*)(F.lds + (lw * 14 + p) * 1024), 16, 0, 0);
    }
    asm volatile("s_waitcnt vmcnt(0)" ::: "memory");
    __syncthreads();
    const int vs = vg * 4 + F.wave, n = lane & 15, q4 = lane >> 4;
    f32x4 S[8];
#pragma unroll
    for (int i = 0; i < 8; ++i) S[i] = (f32x4){0.f, 0.f, 0.f, 0.f};
    f32x4 un[4];
    if (!loader) {
#pragma unroll
        for (int t = 0; t < 4; ++t) un[t] = *(const GAS f32x4*)(ug + (size_t)(((vs * 4 + t) * 64 + lane) * 4));
    }
#pragma unroll 1
    for (int i = 0; i < 64; ++i) {
        LAS unsigned char* buf = F.lds + (i & 1) * OPS_BYTES;
        if (loader) {
            if (i + 1 < 64) { LAS unsigned char* nb = F.lds + ((i + 1) & 1) * OPS_BYTES; const unsigned char* src = opsg + (size_t)(i + 1) * OPS_BYTES;
#pragma unroll
                for (int p = 0; p < 14; ++p) __builtin_amdgcn_global_load_lds((const unsigned*)(src + (size_t)(lw * 14 + p) * 1024 + lane * 16), (LAS unsigned*)(nb + (lw * 14 + p) * 1024), 16, 0, 0); }
        } else {
            f32x4 u[4];
#pragma unroll
            for (int t = 0; t < 4; ++t) u[t] = un[t];
            if (i + 1 < 64) {
#pragma unroll
                for (int t = 0; t < 4; ++t) un[t] = *(const GAS f32x4*)(ug + (size_t)(i + 1) * (U_BYTES / 4) + (size_t)(((vs * 4 + t) * 64 + lane) * 4)); }
            const float gl = glast[i];
            bf16x8 sb[4];
#pragma unroll
            for (int kk = 0; kk < 4; ++kk) { u32x4 w; w.x = pk2(S[2 * kk][0], S[2 * kk][1]); w.y = pk2(S[2 * kk][2], S[2 * kk][3]); w.z = pk2(S[2 * kk + 1][0], S[2 * kk + 1][1]); w.w = pk2(S[2 * kk + 1][2], S[2 * kk + 1][3]); sb[kk] = __builtin_bit_cast(bf16x8, w); }
            f32x4 P[4], O[4];
#pragma unroll
            for (int t = 0; t < 4; ++t) { P[t] = (f32x4){0.f, 0.f, 0.f, 0.f}; O[t] = (f32x4){0.f, 0.f, 0.f, 0.f};
#pragma unroll
                for (int kk = 0; kk < 4; ++kk) { const bf16x8 wf = *(const LAS bf16x8*)(buf + ((t * 4 + kk) * 64 + lane) * 16); const bf16x8 qf = *(const LAS bf16x8*)(buf + 16384 + ((t * 4 + kk) * 64 + lane) * 16);
                    P[t] = __builtin_amdgcn_mfma_f32_16x16x32_bf16(wf, sb[kk], P[t], 0, 0, 0); O[t] = __builtin_amdgcn_mfma_f32_16x16x32_bf16(qf, sb[kk], O[t], 0, 0, 0); } }
            bf16x8 vb[2];
#pragma unroll
            for (int k2 = 0; k2 < 2; ++k2) { const f32x4 v0 = u[2 * k2] - P[2 * k2], v1 = u[2 * k2 + 1] - P[2 * k2 + 1]; u32x4 w; w.x = pk2(v0[0], v0[1]); w.y = pk2(v0[2], v0[3]); w.z = pk2(v1[0], v1[1]); w.w = pk2(v1[2], v1[3]); vb[k2] = __builtin_bit_cast(bf16x8, w); }
#pragma unroll
            for (int t = 0; t < 4; ++t)
#pragma unroll
                for (int k2 = 0; k2 < 2; ++k2) { const bf16x8 af = *(const LAS bf16x8*)(buf + 49152 + ((t * 2 + k2) * 64 + lane) * 16); O[t] = __builtin_amdgcn_mfma_f32_16x16x32_bf16(af, vb[k2], O[t], 0, 0, 0); }
#pragma unroll
            for (int mt = 0; mt < 8; ++mt) { S[mt] = S[mt] * gl;
#pragma unroll
                for (int k2 = 0; k2 < 2; ++k2) { const bf16x8 kf = *(const LAS bf16x8*)(buf + 32768 + ((mt * 2 + k2) * 64 + lane) * 16); S[mt] = __builtin_amdgcn_mfma_f32_16x16x32_bf16(kf, vb[k2], S[mt], 0, 0, 0); } }
            const int tok0 = b * SEQ + i * 64;
#pragma unroll
            for (int t = 0; t < 4; ++t)
#pragma unroll
                for (int r = 0; r < 4; ++r) ob[(size_t)(tok0 + 16 * t + 4 * q4 + r) * 1024 + h * 128 + vs * 16 + n] = O[t][r];
        }
        asm volatile("s_waitcnt vmcnt(0)" ::: "memory");
        __syncthreads();
    }
}

DI void gnorm_phase(Frame& F, int l) {
    const float* ob = (const float*)(F.ws + WS_OBUF); const bf16* proj = (const bf16*)(F.ws + WS_PROJ); bf16* cat = (bf16*)(F.ws + WS_CAT);
    const int lane = F.lane; const f32x2 nw = *(const GAS f32x2*)(F.in[I_DNW] + l * 128 + 2 * lane);
    const int gw = F.bid * NWAVES + F.wave, NGW = F.G * NWAVES;
    for (int it0 = gw * 4; it0 < NTOK * 8; it0 += NGW * 4) {
        f32x2 o[4]; unsigned z[4];
#pragma unroll
        for (int i = 0; i < 4; ++i) { const int it = it0 + i, tok = it >> 3, h = it & 7;
            o[i] = *(const GAS f32x2*)(ob + (size_t)tok * 1024 + h * 128 + 2 * lane); z[i] = *(const GAS unsigned*)(proj + (size_t)tok * PN + C_DZ + h * 128 + 2 * lane); }
#pragma unroll
        for (int i = 0; i < 4; ++i) { const int it = it0 + i, tok = it >> 3, h = it & 7;
            const float ms = wave_sum(o[i].x * o[i].x + o[i].y * o[i].y) * (1.0f / 128.0f);
            const float r = 1.0f / sqrtf(ms + RMS_EPS);
            *(GAS unsigned*)(cat + (size_t)tok * DM + 1024 + h * 128 + 2 * lane) = pk2(o[i].x * r * nw.x * siluf_(bflo(z[i])), o[i].y * r * nw.y * siluf_(bfhi(z[i]))); }
    }
}

DI int moe_table(Frame& F, const unsigned* cnt) {
    LAS int* tab = (LAS int*)(F.lds + MOETAB_OFF);
    __syncthreads();
    if (F.tid == 0) { int acc = 0;
        for (int e = 0; e < 16; ++e) { const int c = (int)__hip_atomic_load(cnt + e, __ATOMIC_RELAXED, __HIP_MEMORY_SCOPE_AGENT); tab[e] = acc; tab[17 + e] = c; acc += (c + 255) >> 8; }
        tab[16] = acc; }
    __syncthreads();
    return tab[16];
}

constexpr int NS = 11, NSTEPS = 1 + DEPTH * NS;
struct Args { const float* in[18]; float* out; unsigned char* ws; int s_lo, s_hi; };

__global__ void __launch_bounds__(NTHREADS, 2) fwd_kernel(Args args) {
    extern __shared__ __attribute__((aligned(16))) unsigned char lds_raw[];
    Frame F;
    F.lds = (LAS unsigned char*)lds_raw;
    F.tid = threadIdx.x; F.lane = F.tid & 63; F.wave = __builtin_amdgcn_readfirstlane(F.tid >> 6);
    const int wave0 = F.wave;
    F.G = gridDim.x; F.bid = blockIdx.x; F.ws = args.ws; F.out = args.out;
    F.in = args.in;
    unsigned* ctl = (unsigned*)(F.ws + WS_CTL);
    if (F.tid < 4) ((LAS unsigned*)(F.lds + MISC_OFF))[F.tid] = 0u;
    __syncthreads();
    const int lo = args.s_lo, hi = args.s_hi;
    XcdBarrier bar; bar.bar = ctl + CW_BAR; bar.x = 0; bar.st = nullptr;
    if (hi - lo > 1) bar = xcd_barrier_post(ctl + CW_BAR, (volatile LAS unsigned*)(F.lds + MISC_OFF));
#ifndef PHASE_MASK
#define PHASE_MASK 0xfff
#endif
#define PHM(k) (((PHASE_MASK) >> (k)) & 1)
#define REFRESH() do { int z_ = 0; asm volatile("" : "+v"(z_)); const int ln_ = __builtin_amdgcn_mbcnt_hi(-1, __builtin_amdgcn_mbcnt_lo(-1, z_)); F.lane = ln_; F.wave = wave0; F.tid = wave0 * 64 + ln_; asm volatile("" : "+s"(F.ws)); } while (0)
#define RUN(s) (lo <= (s) && (s) < hi)
#define SEAM(s) do { if ((s) + 1 < hi) { XcdBarrier b2_ = bar; unsigned* bp_ = (unsigned*)(F.ws + WS_CTL) + CW_BAR; asm volatile("" : "+s"(bp_)); b2_.bar = bp_; xcd_barrier(b2_); } } while (0)
#define P_CNT ((unsigned*)(F.ws + WS_CTL) + CW_CNT)
#define P_LIST ((int*)(F.ws + WS_LIST))
#define P_WSEL ((float*)(F.ws + WS_WSEL))
#define P_XB ((bf16*)(F.ws + WS_XB))
#define P_PROJB ((bf16*)(F.ws + WS_PROJ))
#define P_CATB ((bf16*)(F.ws + WS_CAT))
#define P_YB ((float*)(F.ws + WS_Y))
#define P_X1 ((float*)(F.ws + WS_X1))
#define P_X1B ((bf16*)(F.ws + WS_X1B))
#define P_HID ((bf16*)(F.ws + WS_HID))
#define P_O2 ((bf16*)(F.ws + WS_O2))
#define P_XW ((float*)(F.ws + WS_X))
#define P_ABP ((float*)(F.ws + WS_AB))
    if (PHM(11) && RUN(0)) { REFRESH();
        rope_phase(F);
        ln_phase<0>(F, F.in[I_X], nullptr, nullptr, nullptr, nullptr, P_XB, F.in[I_WIN] + C_AB, PROJ, true, P_ABP, nullptr, nullptr, nullptr, nullptr);
        SEAM(0);
    }
    for (int l = 0; l < DEPTH; ++l) {
        const int sb = 1 + l * NS;
        const int slot = 0;
#define P_WIN_T ((const bf16*)(F.ws + WS_WIN) + (size_t)slot * PN * DM)
#define P_WOUT_T ((const bf16*)(F.ws + WS_WOUT) + (size_t)slot * DM * DM)
#define P_WGU_T ((const bf16*)(F.ws + WS_WGU) + (size_t)slot * NEXP * 1024 * DM)
#define P_WD_T ((const bf16*)(F.ws + WS_WD) + (size_t)slot * NEXP * DM * DEXP)
#define P_XRES ((l == 0) ? F.in[I_X] : P_XW)
        if (PHM(0) && RUN(sb + 0)) { REFRESH(); convw_phase(F, l, slot); __syncthreads(); SEAM(sb + 0); }
        if (PHM(1) && RUN(sb + 1)) { REFRESH();
            if (F.bid == 0 && F.tid < 16) __hip_atomic_store(P_CNT + F.tid, 0u, __ATOMIC_RELAXED, __HIP_MEMORY_SCOPE_AGENT);
            g8::DenseSched<NTOK, PN, DM> S; S.init(P_WIN_T, F.G, F.bid);
            g8::EpiBf16 E{P_PROJB, PN};
            g8::gemm_phase<g8::EpiBf16, g8::DenseSched<NTOK, PN, DM>>(F.lds, F.wave, (const char*)P_XB, DM, S, E);
            SEAM(sb + 1);
        }
        if (PHM(2) && RUN(sb + 2)) { REFRESH();
            for (int it = F.bid; it < 256; it += F.G) {
                if (it < 128) attn_unit(F, it, l);
                else dn_pre_item(F, (it - 128) * NWAVES + F.wave, l);
            }
            SEAM(sb + 2);
        }
#if DN_NAIVE
        if (PHM(3) && RUN(sb + 3)) { REFRESH(); dn_naive_phase(F); SEAM(sb + 3); }
        if (PHM(4) && RUN(sb + 4)) { REFRESH(); SEAM(sb + 4); }
#else
        if (PHM(3) && RUN(sb + 3)) { REFRESH();
            for (int it = F.bid; it < 512; it += F.G) dn_prep_item(F, it * 2 + (F.wave >> 2), l);
            SEAM(sb + 3); }
        if (PHM(4) && RUN(sb + 4)) { REFRESH(); dn_scan_phase(F); SEAM(sb + 4); }
#endif
        if (PHM(5) && RUN(sb + 5)) { REFRESH(); gnorm_phase(F, l); SEAM(sb + 5); }
        if (PHM(6) && RUN(sb + 6)) { REFRESH();
            g8::DenseSched<NTOK, DM, DM> S; S.init(P_WOUT_T, F.G, F.bid);
            g8::EpiResid E{P_XRES, P_YB};
            g8::gemm_phase<g8::EpiResid, g8::DenseSched<NTOK, DM, DM>>(F.lds, F.wave, (const char*)P_CATB, DM, S, E);
            SEAM(sb + 6);
        }
        if (PHM(7) && RUN(sb + 7)) { REFRESH();
            ln_phase<1>(F, P_YB, nullptr, F.in[I_LN1G] + l * DM, F.in[I_LN1B] + l * DM, P_X1, P_X1B, F.in[I_RW], 16, true, nullptr, F.in[I_RB], P_CNT, P_LIST, P_WSEL);
            SEAM(sb + 7);
        }
        if (PHM(8) && RUN(sb + 8)) { REFRESH();
            const int mt = moe_table(F, P_CNT);
            g8::MoeSched<true> S; S.tab = (const LAS int*)(F.lds + MOETAB_OFF); S.list = P_LIST; S.W = (const char*)P_WGU_T; S.wstride = (size_t)1024 * DM * 2; S.NB = 4; S.K = DM; S.G = F.G; S.c = F.bid; S.total = mt * 4;
            g8::EpiSwiglu E{P_HID, P_LIST, P_WSEL};
            g8::gemm_phase<g8::EpiSwiglu, g8::MoeSched<true>>(F.lds, F.wave, (const char*)P_X1B, DM, S, E);
            SEAM(sb + 8);
        }
        if (PHM(9) && RUN(sb + 9)) { REFRESH();
            const int mt = moe_table(F, P_CNT);
            g8::MoeSched<false> S; S.tab = (const LAS int*)(F.lds + MOETAB_OFF); S.list = P_LIST; S.W = (const char*)P_WD_T; S.wstride = (size_t)DM * DEXP * 2; S.NB = 8; S.K = DEXP; S.G = F.G; S.c = F.bid; S.total = mt * 8;
            g8::EpiDown E{P_O2, P_LIST};
            g8::gemm_phase<g8::EpiDown, g8::MoeSched<false>>(F.lds, F.wave, (const char*)P_HID, DEXP, S, E);
            SEAM(sb + 9);
        }
        if (PHM(10) && RUN(sb + 10)) { REFRESH();
            const bool lastl = (l == DEPTH - 1);
            ln_phase<2>(F, P_X1, P_O2, F.in[I_LN2G] + l * DM, F.in[I_LN2B] + l * DM, lastl ? F.out : P_XW, P_XB, F.in[I_WIN] + (size_t)(lastl ? l : l + 1) * DM * PROJ + C_AB, PROJ, !lastl, P_ABP, nullptr, nullptr, nullptr, nullptr);
            SEAM(sb + 10);
        }
    }
#undef RUN
#undef SEAM
}

extern "C" void kernel_launch(void* const* d_in, const int* in_sizes, int n_in, void* d_out, int out_size, void* d_ws, size_t ws_size, hipStream_t stream) {
    static int grid = 0;
    if (grid == 0) {
        if (n_in != 18 || out_size != NTOK * DM || ws_size < WS_END) { fprintf(stderr, "kernel_launch: unexpected shapes (n_in %d, out %d, ws %zu < %zu)\n", n_in, out_size, ws_size, (size_t)WS_END); grid = -1; return; }
        int dev = 0, cus = 0, per_cu = 0;
        if (hipGetDevice(&dev) != hipSuccess || hipDeviceGetAttribute(&cus, hipDeviceAttributeMultiprocessorCount, dev) != hipSuccess) { grid = -1; return; }
        if (hipFuncSetAttribute((const void*)fwd_kernel, hipFuncAttributeMaxDynamicSharedMemorySize, LDS_BYTES) != hipSuccess) { fprintf(stderr, "kernel_launch: hipFuncSetAttribute failed\n"); grid = -1; return; }
        if (hipOccupancyMaxActiveBlocksPerMultiprocessor(&per_cu, (const void*)fwd_kernel, NTHREADS, LDS_BYTES) != hipSuccess || per_cu < 1) { fprintf(stderr, "kernel_launch: occupancy query says %d\n", per_cu); }
        (void)hipGetLastError();
        grid = cus;
    }
    if (grid < 0) return;
    (void)hipMemsetAsync((char*)d_ws + WS_CTL, 0, CTL_BYTES, stream);
    Args a{};
    for (int i = 0; i < 18; ++i) a.in[i] = (const float*)d_in[i];
    a.out = (float*)d_out; a.ws = (unsigned char*)d_ws;
#if MK_ONE_LAUNCH
    a.s_lo = 0; a.s_hi = NSTEPS;
    hipLaunchKernelGGL(fwd_kernel, dim3(grid), dim3(NTHREADS), LDS_BYTES, stream, a);
#else
    for (int s = 0; s < NSTEPS; ++s) {
        if (DN_NAIVE && (s - 1) % NS == 4 && s > 0) continue;
        a.s_lo = s; a.s_hi = s + 1;
        hipLaunchKernelGGL(fwd_kernel, dim3(grid), dim3(NTHREADS), LDS_BYTES, stream, a);
    }
#endif
}
```

```cpp
#include <hip/hip_runtime.h>
#include <cstdio>
#include <cstdint>

#ifndef MK_ONE_LAUNCH
#define MK_ONE_LAUNCH 1
#endif

#define DI __device__ __forceinline__
#define LAS __attribute__((address_space(3)))
#define GAS __attribute__((address_space(1)))
typedef unsigned short bf16;
typedef short bf16x8 __attribute__((ext_vector_type(8)));
typedef short s16x4 __attribute__((ext_vector_type(4)));
typedef float f32x4 __attribute__((ext_vector_type(4)));
typedef float f32x2 __attribute__((ext_vector_type(2)));
typedef unsigned u32x4 __attribute__((ext_vector_type(4)));
typedef unsigned u32x2 __attribute__((ext_vector_type(2)));

constexpr int NTOK = 8192, SEQ = 4096, DM = 2048, PROJ = 5392, PN = 5376, DEPTH = 4;
constexpr int C_SQ = 0, C_SK = 1024, C_SV = 1152, C_DQ = 1280, C_DK = 2304, C_DV = 3328, C_DZ = 4352, C_AB = 5376;
constexpr int NEXP = 16, DEXP = 512;
constexpr float ALPHA = 1.681792830507429f;
constexpr float LN_EPS = 1e-5f, RMS_EPS = 1e-6f;

constexpr size_t MiB = 1u << 20;
constexpr size_t WS_CTL = 0, CTL_BYTES = 1 * MiB;
constexpr size_t WS_COS = 1 * MiB, WS_SIN = 2 * MiB;
constexpr size_t WS_AB = 4 * MiB;
constexpr size_t WS_G = 4 * MiB + 512 * 1024, WS_BETA = WS_G + 256 * 1024;
constexpr size_t WS_WSEL = 5 * MiB, WS_LIST = 5 * MiB + 64 * 1024;
constexpr size_t WS_WIN = 8 * MiB, WS_WOUT = 50 * MiB, WS_WGU = 66 * MiB, WS_WD = 194 * MiB;
constexpr size_t WS_X = 258 * MiB, WS_XB = 322 * MiB, WS_PROJ = 354 * MiB, WS_Y = 438 * MiB, WS_X1 = 502 * MiB, WS_X1B = 566 * MiB;
constexpr size_t WS_CAT = 598 * MiB, WS_OBUF = 630 * MiB, WS_QKV = 662 * MiB, WS_SCAN = 710 * MiB, WS_HID = 798 * MiB, WS_O2 = 814 * MiB, WS_END = 878 * MiB;
constexpr int CW_BAR = 4096;
constexpr int CW_CNT = 64;
constexpr int CW_DONE = 32768;

DI unsigned f2bf(float f) { unsigned u = __builtin_bit_cast(unsigned, f); return (u + 0x7fffu + ((u >> 16) & 1u)) >> 16; }
typedef __bf16 bf16n2 __attribute__((ext_vector_type(2)));
DI unsigned pk2(float lo, float hi) { return __builtin_bit_cast(unsigned, __builtin_convertvector((f32x2){lo, hi}, bf16n2)); }
DI unsigned pk2n(float lo, float hi) { return __builtin_bit_cast(unsigned, __builtin_convertvector((f32x2){lo, hi}, bf16n2)); }
DI float bflo(unsigned w) { return __builtin_bit_cast(float, w << 16); }
DI float bfhi(unsigned w) { return __builtin_bit_cast(float, w & 0xffff0000u); }
#define swz_xor(v, pat) __builtin_bit_cast(float, __builtin_amdgcn_ds_swizzle(__builtin_bit_cast(int, (float)(v)), (pat)))
#define SWZ_X1 0x041F
#define SWZ_X2 0x081F
#define SWZ_X4 0x101F
#define SWZ_X8 0x201F
#define SWZ_X16 0x401F
DI float xor32_sum(float v) { const unsigned u = __builtin_bit_cast(unsigned, v); const auto r = __builtin_amdgcn_permlane32_swap(u, u, false, false); return __builtin_bit_cast(float, (unsigned)r[0]) + __builtin_bit_cast(float, (unsigned)r[1]); }
DI float xor32_max(float v) { const unsigned u = __builtin_bit_cast(unsigned, v); const auto r = __builtin_amdgcn_permlane32_swap(u, u, false, false); return fmaxf(__builtin_bit_cast(float, (unsigned)r[0]), __builtin_bit_cast(float, (unsigned)r[1])); }
DI float wave_sum(float v) {
    v += swz_xor(v, SWZ_X1); v += swz_xor(v, SWZ_X2); v += swz_xor(v, SWZ_X4); v += swz_xor(v, SWZ_X8); v += swz_xor(v, SWZ_X16);
    return xor32_sum(v);
}
DI float sigmoidf_(float x) { return __builtin_amdgcn_rcpf(1.0f + __expf(-x)); }
DI float siluf_(float x) { return x * __builtin_amdgcn_rcpf(1.0f + __expf(-x)); }
#define LDS_WAIT() asm volatile("s_waitcnt lgkmcnt(0)" ::: "memory")

typedef short s16x4 __attribute__((ext_vector_type(4)));
#define XB_TMO      128
#define XB_XCNT(j)  (256  + 64 * (j))
#define XB_XSUB(j)  (1280 + 64 * (j))
#define XB_XGEN(j)  (2304 + 64 * (j))
#define XB_TOP      3328
#define XB_TOPGEN   3392
#define XCD_BAR_WORDS 3456
#define XB_SPIN_CAP (1u << 18)
__device__ __forceinline__ unsigned xb_ld(unsigned* p)              { return __hip_atomic_load(p, __ATOMIC_RELAXED, __HIP_MEMORY_SCOPE_AGENT); }
__device__ __forceinline__ unsigned xb_add(unsigned* p, unsigned v) { return __hip_atomic_fetch_add(p, v, __ATOMIC_RELAXED, __HIP_MEMORY_SCOPE_AGENT); }
__device__ __forceinline__ unsigned xb_xcc_id() { return (unsigned)__builtin_amdgcn_s_getreg((3 << 11) | 20) & 0xFu; }
#define XB_SPIN(cond, bar) do { unsigned _sp = 0; while (cond) { __builtin_amdgcn_s_sleep(1); \
    if ((++_sp & 255u) == 0u) { if (xb_ld(&(bar)[XB_TMO])) break; if (_sp > XB_SPIN_CAP) { atomicAdd(&(bar)[XB_TMO], 1u); break; } } } } while (0)
struct XcdBarrier { unsigned* bar; unsigned x; volatile LAS unsigned* st; };
__device__ __forceinline__ XcdBarrier xcd_barrier_post(unsigned* bar, volatile LAS unsigned* st) {
    XcdBarrier b; b.bar = bar; b.x = xb_xcc_id(); b.st = st;
    if (threadIdx.x == 0) (void)xb_add(&bar[XB_XCNT(b.x)], 1u);
    return b;
}
__device__ __forceinline__ void xcd_barrier_complete(unsigned* bar, unsigned x, unsigned& nloc, unsigned& nx) {
    const unsigned G = gridDim.x * gridDim.y * gridDim.z;
    unsigned sum, cnt, mine, sp = 0u;
    for (;;) {
        sum = 0u; cnt = 0u; mine = 0u;
#pragma unroll
        for (unsigned j = 0; j < 16; ++j) { const unsigned c = xb_ld(&bar[XB_XCNT(j)]); sum += c; cnt += (c > 0u) ? 1u : 0u; mine = (j == x) ? c : mine; }
        if (sum == G) break;
        __builtin_amdgcn_s_sleep(1);
        if ((++sp & 255u) == 0u) { if (xb_ld(&bar[XB_TMO])) break; if (sp > XB_SPIN_CAP) { atomicAdd(&bar[XB_TMO], 1u); break; } }
    }
    nloc = mine > 0u ? mine : 1u; nx = cnt > 0u ? cnt : 1u;
}
__device__ __forceinline__ void xcd_barrier(const XcdBarrier& b) {
    asm volatile("s_waitcnt vmcnt(0)" ::: "memory");
    __syncthreads();
    if (threadIdx.x == 0) {
        unsigned* bar = b.bar;
        __builtin_amdgcn_s_waitcnt(0);
        asm volatile("buffer_inv sc1" ::: "memory");
        unsigned nloc = b.st[0], nx = b.st[1];
        if (nloc == 0u) { xcd_barrier_complete(bar, b.x, nloc, nx); b.st[0] = nloc; b.st[1] = nx; }
        const unsigned old = xb_add(&bar[XB_XSUB(b.x)], 1u);
        const unsigned gen = old / nloc;
        if (old + 1u == (gen + 1u) * nloc) {
            __builtin_amdgcn_fence(__ATOMIC_RELEASE, "agent");
            asm volatile("s_waitcnt vmcnt(0)" ::: "memory");
            const unsigned og = xb_add(&bar[XB_TOP], 1u);
            const unsigned tg = og / nx;
            if (og + 1u == (tg + 1u) * nx) xb_add(&bar[XB_TOPGEN], 1u);
            else XB_SPIN(xb_ld(&bar[XB_TOPGEN]) == tg, bar);
            xb_add(&bar[XB_XGEN(b.x)], 1u);
            asm volatile("s_waitcnt vmcnt(0)" ::: "memory");
        } else {
            XB_SPIN(xb_ld(&bar[XB_XGEN(b.x)]) == gen, bar);
            asm volatile("s_waitcnt vmcnt(0)" ::: "memory");
        }
    }
    __syncthreads();
}

namespace g8 {
constexpr int BM = 256, BK = 64, HALF = 128, HTB = HALF * BK * 2, STAGE_BYTES = 8 * HTB, NXCD = 8, WGM = 8;
DI int lds_byte(int r, int c) { const int st = (r >> 4) * 2 + (c >> 5), rr = r & 15, cc = c & 31, ob = rr * 64 + cc * 2; return st * 1024 + (ob ^ (((ob >> 9) & 1) << 5)); }
DI void stage_rc(int b, int& R, int& C) { const int st = b / 1024, sb = b % 1024, swz = sb ^ (((sb >> 9) & 1) << 5); R = (st >> 1) * 16 + swz / 64; C = (st & 1) * 32 + (swz % 64) / 2; }
DI int perm32(int rho) { const int n = rho >> 4, i = rho & 15; return 8 * (i >> 2) + 4 * n + (i & 3); }

struct Unit { const char* B; int m0, n0, rows, e; };

template <int M_, int N_, int K_> struct DenseSched {
    static constexpr bool GATHER = false;
    static constexpr int nM = M_ / BM, nN = N_ / BM, nwg = nM * nN, K = K_;
    int G, c; const char* Bt;
    DI void init(const void* Bt_, int G_, int c_) { G = G_; c = c_; Bt = (const char*)Bt_; }
    DI bool next(int i, Unit& u) const {
        const int L = i * G + c; if (L >= nwg) return false;
        int wgid = L; { constexpr int q = nwg / NXCD, r = nwg % NXCD; const int xcd = wgid % NXCD, off = wgid / NXCD; wgid = (xcd < r ? xcd * (q + 1) : r * (q + 1) + (xcd - r) * q) + off; }
        constexpr int nig = WGM * nN; const int gid = wgid / nig, fm = gid * WGM, gsz = (nM - fm) < WGM ? (nM - fm) : WGM;
        const int pm = fm + ((wgid % nig) % gsz), pn = (wgid % nig) / gsz;
        u.m0 = pm * BM; u.n0 = pn * BM; u.rows = BM; u.e = 0; u.B = Bt + (size_t)pn * BM * K * 2; return true;
    }
    DI unsigned arow(const Unit& u, int r) const { return (unsigned)(u.m0 + r); }
};
DI unsigned cvt_pk_bf16(float lo, float hi) { unsigned r; asm volatile("v_cvt_pk_bf16_f32 %0, %1, %2" : "=v"(r) : "v"(lo), "v"(hi)); return r; }

struct EpiBf16 {
    static constexpr bool PERM = true;
    bf16* O; int ldc;
    DI void operator()(const f32x4 (&acc)[2][2][4][2], const Unit& u, int wr, int wc, int fr, int fq) const {
        const int row0 = u.m0 + wr * 64 + fr, col0 = u.n0 + wc * 32 + 8 * fq;
#pragma unroll
        for (int ai = 0; ai < 2; ++ai)
#pragma unroll
            for (int m = 0; m < 4; ++m) { bf16* rowp = O + (size_t)(row0 + ai * HALF + m * 16) * ldc + col0;
#pragma unroll
                for (int bj = 0; bj < 2; ++bj) { const f32x4 v0 = acc[ai][bj][m][0], v1 = acc[ai][bj][m][1];
                    u32x4 w; w.x = cvt_pk_bf16(v0[0], v0[1]); w.y = cvt_pk_bf16(v0[2], v0[3]); w.z = cvt_pk_bf16(v1[0], v1[1]); w.w = cvt_pk_bf16(v1[2], v1[3]);
                    *(u32x4*)(rowp + bj * HALF) = w; } }
    }
};
struct EpiResid {
    static constexpr bool PERM = false;
    const bf16* X; bf16* Y;
    DI void operator()(const f32x4 (&acc)[2][2][4][2], const Unit& u, int wr, int wc, int fr, int fq) const {
        const int row0 = u.m0 + wr * 64 + fr, col0 = u.n0 + wc * 32 + 4 * fq;
#pragma unroll
        for (int ai = 0; ai < 2; ++ai) {
            u32x2 xr[4][2][2];
#pragma unroll
            for (int m = 0; m < 4; ++m) { const size_t off = (size_t)(row0 + ai * HALF + m * 16) * DM + col0;
#pragma unroll
                for (int bj = 0; bj < 2; ++bj)
#pragma unroll
                    for (int n = 0; n < 2; ++n) xr[m][bj][n] = *(const GAS u32x2*)(X + off + bj * HALF + n * 16); }
            __builtin_amdgcn_sched_barrier(0);
#pragma unroll
            for (int m = 0; m < 4; ++m) { const size_t off = (size_t)(row0 + ai * HALF + m * 16) * DM + col0;
#pragma unroll
                for (int bj = 0; bj < 2; ++bj)
#pragma unroll
                    for (int n = 0; n < 2; ++n) { const u32x2 x = xr[m][bj][n]; const f32x4 a = acc[ai][bj][m][n];
                        u32x2 o; o.x = cvt_pk_bf16(bflo(x.x) * ALPHA + a[0], bfhi(x.x) * ALPHA + a[1]); o.y = cvt_pk_bf16(bflo(x.y) * ALPHA + a[2], bfhi(x.y) * ALPHA + a[3]);
                        *(GAS u32x2*)(Y + off + bj * HALF + n * 16) = o; } }
        }
    }
};
template <class Epi, class Sched>
DI void gemm_phase(LAS unsigned char* lds, const int wave_id, const char* Abase, const int K, const Sched& S, const Epi& E) {
    int z_ = 0; asm volatile("" : "+v"(z_));
    const int lane = __builtin_amdgcn_mbcnt_hi(-1, __builtin_amdgcn_mbcnt_lo(-1, z_)), wid = wave_id, tid = wid * 64 + lane, wr = wid >> 2, wc = wid & 3, fr = lane & 15, fq = lane >> 4;
    const int nt = K / BK;
    constexpr bool GATHER = Sched::GATHER;
    int Rr[2]; unsigned C2[2], voffB[2], voffA[2];
#pragma unroll
    for (int i = 0; i < 2; ++i) { int R, C; stage_rc(tid * 16 + i * 8192, R, C); const int Rb = Epi::PERM ? ((R & ~31) + perm32(R & 31)) : R;
        Rr[i] = R; C2[i] = (unsigned)C * 2u; voffB[i] = (unsigned)(Rb * K + C) * 2u; voffA[i] = (unsigned)(R * K + C) * 2u; }
    const size_t kstep = (size_t)(BK * 2);
    const size_t hstepB = (size_t)HALF * K * 2;
    const size_t tstepA = (size_t)K * 2;
    const unsigned ldsw = (unsigned)wid * 1024u;
    const int aoff = lds_byte(wr * 64 + fr, fq * 8), boff = lds_byte(wc * 32 + fr, fq * 8);
#define G8_SA(b, h) (((b) * 2 + (h)) * HTB)
#define G8_SB(b, h) ((4 + (b) * 2 + (h)) * HTB)
#define G8_STAGE(bufoff, gbase, voff) do { _Pragma("unroll") for (int _i = 0; _i < 2; ++_i) \
        __builtin_amdgcn_global_load_lds((const unsigned*)((const char*)(gbase) + (voff)[_i]), (LAS unsigned*)(lds + (bufoff) + ldsw + _i * 8192), 16, 0, 0); } while (0)
#define G8_LDA(dst, b, h) do { _Pragma("unroll") for (int m = 0; m < 4; ++m) _Pragma("unroll") for (int k = 0; k < 2; ++k) dst[m][k] = *(const LAS bf16x8*)(lds + G8_SA(b, h) + aoff + m * 2048 + k * 1024); } while (0)
#define G8_LDB(dst, b, h) do { _Pragma("unroll") for (int n = 0; n < 2; ++n) _Pragma("unroll") for (int k = 0; k < 2; ++k) dst[n][k] = *(const LAS bf16x8*)(lds + G8_SB(b, h) + boff + n * 2048 + k * 1024); } while (0)
#define G8_MMA(ai, bj, At, Bt) do { __builtin_amdgcn_s_setprio(1); _Pragma("unroll") for (int m = 0; m < 4; ++m) _Pragma("unroll") for (int n = 0; n < 2; ++n) _Pragma("unroll") for (int k = 0; k < 2; ++k) \
        acc[ai][bj][m][n] = __builtin_amdgcn_mfma_f32_16x16x32_bf16(Bt[n][k], At[m][k], acc[ai][bj][m][n], 0, 0, 0); __builtin_amdgcn_s_setprio(0); } while (0)
#define G8_WAIT_V(n) asm volatile("s_waitcnt vmcnt(" #n ")" ::: "memory")
#define G8_WAIT_L(n) asm volatile("s_waitcnt lgkmcnt(" #n ")" ::: "memory")
#define G8_BAR __builtin_amdgcn_s_barrier()
#define G8_SCHED __builtin_amdgcn_sched_barrier(0)
    Unit cur, nxt; int ui = 0;
    if (!S.next(0, cur)) return;
    f32x4 acc[2][2][4][2];
#pragma unroll
    for (int a = 0; a < 2; ++a)
#pragma unroll
        for (int b = 0; b < 2; ++b)
#pragma unroll
            for (int m = 0; m < 4; ++m)
#pragma unroll
                for (int n = 0; n < 2; ++n) acc[a][b][m][n] = (f32x4){0.f, 0.f, 0.f, 0.f};
    bf16x8 At[4][2], B0[2][2], B1[2][2];
    unsigned vAc[2][2], vAn[2][2];
    const char* cA0 = Abase; const char* cA1 = Abase;
    if constexpr (GATHER) {
#pragma unroll
        for (int h = 0; h < 2; ++h)
#pragma unroll
            for (int i = 0; i < 2; ++i) vAc[h][i] = S.arow(cur, h * HALF + Rr[i]) * (unsigned)(K * 2) + C2[i];
    } else {
        cA0 = Abase + (size_t)cur.m0 * tstepA; cA1 = cA0 + (size_t)HALF * tstepA;
#pragma unroll
        for (int h = 0; h < 2; ++h)
#pragma unroll
            for (int i = 0; i < 2; ++i) vAc[h][i] = voffA[i];
    }
    const char* cB = cur.B;
    G8_STAGE(G8_SB(0, 0), cB, voffB); G8_STAGE(G8_SB(0, 1), cB + hstepB, voffB); G8_STAGE(G8_SA(0, 0), cA0, vAc[0]); G8_STAGE(G8_SA(0, 1), cA1, vAc[1]);
    if (wr == 1) G8_BAR;
    G8_WAIT_V(2); G8_BAR;
    G8_STAGE(G8_SB(1, 0), cB + kstep, voffB); G8_STAGE(G8_SA(1, 0), cA0 + kstep, vAc[0]); G8_STAGE(G8_SB(1, 1), cB + hstepB + kstep, voffB);
    G8_WAIT_V(6); G8_BAR;
    for (;;) {
        const bool has_next = S.next(ui + 1, nxt);
        const char* nB = has_next ? nxt.B : cB;
        const char* nA0 = cA0; const char* nA1 = cA1;
        if constexpr (GATHER) {
#pragma unroll
            for (int h = 0; h < 2; ++h)
#pragma unroll
                for (int i = 0; i < 2; ++i) vAn[h][i] = has_next ? (S.arow(nxt, h * HALF + Rr[i]) * (unsigned)(K * 2) + C2[i]) : vAc[h][i];
        } else {
            if (has_next) { nA0 = Abase + (size_t)nxt.m0 * tstepA; nA1 = nA0 + (size_t)HALF * tstepA; }
        }
        for (int t = 0; t < nt; t += 2) {
            const bool last = (t == nt - 2);
            const char* a1h1 = cA1 + (size_t)(t + 1) * kstep;
            const char* a2h0 = last ? nA0 : cA0 + (size_t)(t + 2) * kstep; const char* a2h1 = last ? nA1 : cA1 + (size_t)(t + 2) * kstep;
            const char* b2 = last ? nB : cB + (size_t)(t + 2) * kstep;
            const char* a3h0 = a2h0 + kstep; const char* b3 = b2 + kstep;
            unsigned va2[2][2];
#pragma unroll
            for (int h = 0; h < 2; ++h)
#pragma unroll
                for (int i = 0; i < 2; ++i) va2[h][i] = (GATHER && last) ? vAn[h][i] : vAc[h][i];
            G8_LDB(B0, 0, 0); G8_LDB(B1, 0, 1); G8_SCHED; G8_LDA(At, 0, 0); G8_STAGE(G8_SA(1, 1), a1h1, vAc[1]);
            G8_WAIT_V(8); G8_WAIT_L(0); G8_BAR; G8_MMA(0, 0, At, B0); G8_MMA(0, 1, At, B1); G8_BAR; G8_SCHED;
            G8_LDA(At, 0, 1); G8_STAGE(G8_SB(0, 0), b2, voffB); G8_STAGE(G8_SB(0, 1), b2 + hstepB, voffB); G8_STAGE(G8_SA(0, 0), a2h0, va2[0]);
            G8_WAIT_V(8); G8_WAIT_L(0); G8_BAR; G8_MMA(1, 0, At, B0); G8_MMA(1, 1, At, B1); G8_BAR; G8_SCHED;
            G8_LDB(B0, 1, 0); G8_LDB(B1, 1, 1); G8_SCHED; G8_LDA(At, 1, 0); G8_STAGE(G8_SA(0, 1), a2h1, va2[1]);
            G8_WAIT_V(8); G8_WAIT_L(0); G8_BAR; G8_MMA(0, 0, At, B0); G8_MMA(0, 1, At, B1); G8_BAR; G8_SCHED;
            G8_LDA(At, 1, 1); G8_STAGE(G8_SB(1, 0), b3, voffB); G8_STAGE(G8_SB(1, 1), b3 + hstepB, voffB); G8_STAGE(G8_SA(1, 0), a3h0, va2[0]);
            G8_WAIT_V(8); G8_WAIT_L(0); G8_BAR; G8_MMA(1, 0, At, B0); G8_MMA(1, 1, At, B1); G8_BAR; G8_SCHED;
        }
        if (wr == 0) G8_BAR;
        E(acc, cur, wr, wc, fr, fq);
        if (!has_next) break;
#pragma unroll
        for (int a = 0; a < 2; ++a)
#pragma unroll
            for (int b = 0; b < 2; ++b)
#pragma unroll
                for (int m = 0; m < 4; ++m)
#pragma unroll
                    for (int n = 0; n < 2; ++n) acc[a][b][m][n] = (f32x4){0.f, 0.f, 0.f, 0.f};
        cur = nxt; cB = nB; cA0 = nA0; cA1 = nA1; ++ui;
        if (wr == 1) G8_BAR;
        if constexpr (GATHER) {
#pragma unroll
            for (int h = 0; h < 2; ++h)
#pragma unroll
                for (int i = 0; i < 2; ++i) vAc[h][i] = vAn[h][i];
        }
    }
    G8_WAIT_V(0);
    G8_BAR;
#undef G8_SA
#undef G8_SB
#undef G8_STAGE
#undef G8_LDA
#undef G8_LDB
#undef G8_MMA
#undef G8_WAIT_V
#undef G8_WAIT_L
#undef G8_BAR
#undef G8_SCHED
}

struct MUnit { const char* B; int m0, n0, rows, e, kind, mt; };
struct MoeUni {
    const LAS int* tab; const int* list; const char* Wgu; const char* Wd; int G, c, MT;
    DI bool next(int i, MUnit& u) const {
        const int nA = 4 * MT, nB = 8 * MT, x = nA > G ? nA - G : 0;
        const int mineA = (c < nA ? 1 : 0) + (c + G < nA ? 1 : 0);
        int kind, L;
        if (i < mineA) { kind = 0; L = c + i * G; }
        else { const int k = i - mineA;
            if (x > 0) { if (c < x) return false; L = (c - x) + k * (G - x); } else L = c + k * G;
            if (L >= nB) return false; kind = 1; }
        const int NB = kind ? 8 : 4, mt = L / NB, nb = L - mt * NB, nfull = tab[16];
        int e, ti;
        if (mt < nfull) { e = 0;
#pragma unroll
            for (int j = 1; j < 16; ++j) e += (tab[j] <= mt) ? 1 : 0;
            ti = mt - tab[e]; }
        else { e = tab[34 + (mt - nfull)]; ti = tab[17 + e] >> 8; }
        const int cnt = tab[17 + e];
        u.e = e; u.m0 = e * NTOK + ti * BM; u.rows = (cnt - ti * BM) < BM ? (cnt - ti * BM) : BM; u.n0 = nb * BM; u.kind = kind; u.mt = mt;
        u.B = kind ? (Wd + (size_t)e * ((size_t)DM * DEXP * 2) + (size_t)nb * BM * DEXP * 2) : (Wgu + (size_t)e * ((size_t)1024 * DM * 2) + (size_t)nb * BM * DM * 2);
        return true;
    }
    DI unsigned arow(const MUnit& u, int r) const { const int rr = r < u.rows ? r : 0; const unsigned en = (unsigned)list[u.m0 + rr]; return u.kind ? en : (en & (NTOK - 1)); }
};
DI void st16_sc1(void* p, u32x4 v) { asm volatile("global_store_dwordx4 %0, %1, off sc1\n\ts_nop 1" :: "v"((GAS void*)p), "v"(v) : "memory"); }

DI void gemm_moe_phase(LAS unsigned char* lds, const int wave_id, const char* A0  , const char* A1  , const MoeUni& S,
                       bf16* H, const float* wsel, bf16* O2, unsigned* done  , unsigned* tmo) {
    int z_ = 0; asm volatile("" : "+v"(z_));
    const int lane = __builtin_amdgcn_mbcnt_hi(-1, __builtin_amdgcn_mbcnt_lo(-1, z_)), wid = wave_id, tid = wid * 64 + lane, wr = wid >> 2, wc = wid & 3, fr = lane & 15, fq = lane >> 4;
    LAS int* ent = (LAS int*)(lds + STAGE_BYTES); LAS float* wsl = (LAS float*)(lds + STAGE_BYTES + 3 * 1024);
#define MOE_FETCH(u, slot) do { if (tid < 256) { const int e_ = S.list[(u).m0 + (tid < (u).rows ? tid : 0)]; float w_ = 0.f; if ((u).kind == 0) w_ = wsel[e_]; \
            ent[(slot) * 256 + tid] = e_; wsl[(slot) * 256 + tid] = w_; } } while (0)
#define MOE_OFFS(u, slot, vA, vB) do { int tz_ = tid; asm volatile("" : "+v"(tz_)); const int Kk_ = (u).kind ? DEXP : DM; \
        _Pragma("unroll") for (int i = 0; i < 2; ++i) { int R_, C_; stage_rc(tz_ * 16 + i * 8192, R_, C_); const int Rb_ = (R_ & ~31) + perm32(R_ & 31); \
            vB[i] = (unsigned)(Rb_ * Kk_ + C_) * 2u; \
            _Pragma("unroll") for (int h = 0; h < 2; ++h) { const unsigned en_ = (unsigned)ent[(slot) * 256 + h * HALF + R_]; \
                vA[h][i] = ((u).kind ? en_ : (en_ & (NTOK - 1))) * (unsigned)(Kk_ * 2) + (unsigned)C_ * 2u; } } } while (0)
    const size_t kstep = (size_t)(BK * 2);
    const unsigned ldsw = (unsigned)wid * 1024u;
    const int aoff = lds_byte(wr * 64 + fr, fq * 8), boff = lds_byte(wc * 32 + fr, fq * 8);
#define G8_SA(b, h) (((b) * 2 + (h)) * HTB)
#define G8_SB(b, h) ((4 + (b) * 2 + (h)) * HTB)
#define G8_STAGE(bufoff, gbase, voff) do { _Pragma("unroll") for (int _i = 0; _i < 2; ++_i) \
        __builtin_amdgcn_global_load_lds((const unsigned*)((const char*)(gbase) + (voff)[_i]), (LAS unsigned*)(lds + (bufoff) + ldsw + _i * 8192), 16, 0, 0); } while (0)
#define G8_LDA(dst, b, h) do { _Pragma("unroll") for (int m = 0; m < 4; ++m) _Pragma("unroll") for (int k = 0; k < 2; ++k) dst[m][k] = *(const LAS bf16x8*)(lds + G8_SA(b, h) + aoff + m * 2048 + k * 1024); } while (0)
#define G8_LDB(dst, b, h) do { _Pragma("unroll") for (int n = 0; n < 2; ++n) _Pragma("unroll") for (int k = 0; k < 2; ++k) dst[n][k] = *(const LAS bf16x8*)(lds + G8_SB(b, h) + boff + n * 2048 + k * 1024); } while (0)
#define G8_MMA(ai, bj, At, Bt) do { __builtin_amdgcn_s_setprio(1); _Pragma("unroll") for (int m = 0; m < 4; ++m) _Pragma("unroll") for (int n = 0; n < 2; ++n) _Pragma("unroll") for (int k = 0; k < 2; ++k) \
        acc[ai][bj][m][n] = __builtin_amdgcn_mfma_f32_16x16x32_bf16(Bt[n][k], At[m][k], acc[ai][bj][m][n], 0, 0, 0); __builtin_amdgcn_s_setprio(0); } while (0)
#define G8_WAIT_V(n) asm volatile("s_waitcnt vmcnt(" #n ")" ::: "memory")
#define G8_WAIT_L(n) asm volatile("s_waitcnt lgkmcnt(" #n ")" ::: "memory")
#define G8_BAR __builtin_amdgcn_s_barrier()
#define G8_SCHED __builtin_amdgcn_sched_barrier(0)
#define MOE_A_READY(u) do { if ((u).kind) { \
        if (wid == 0 && !ackd) { unsigned sp_ = 0u; \
            while ((unsigned)__builtin_amdgcn_readfirstlane(__hip_atomic_load(done + 16 * (u).mt, __ATOMIC_RELAXED, __HIP_MEMORY_SCOPE_AGENT)) < 32u) { \
                __builtin_amdgcn_s_sleep(2); if (++sp_ > (1u << 20)) { if (lane == 0) __hip_atomic_store(tmo, 1u, __ATOMIC_RELAXED, __HIP_MEMORY_SCOPE_AGENT); break; } } \
            __builtin_amdgcn_fence(__ATOMIC_ACQUIRE, "agent"); asm volatile("s_waitcnt vmcnt(0)" ::: "memory"); } \
        asm volatile("" ::: "memory"); G8_BAR; asm volatile("" ::: "memory"); } } while (0)
    MUnit cur, nxt; int ui = 0; int ackd = 0;
    LAS unsigned* pollw = (LAS unsigned*)(lds + 143360);
    if (!S.next(0, cur)) return;
    f32x4 acc[2][2][4][2];
#pragma unroll
    for (int a = 0; a < 2; ++a)
#pragma unroll
        for (int b = 0; b < 2; ++b)
#pragma unroll
            for (int m = 0; m < 4; ++m)
#pragma unroll
                for (int n = 0; n < 2; ++n) acc[a][b][m][n] = (f32x4){0.f, 0.f, 0.f, 0.f};
    bf16x8 At[4][2], B0[2][2], B1[2][2];
    unsigned vAc[2][2], vAn[2][2], vBc[2], vBn[2];
    int slc = 0, sln = 0;
    MOE_FETCH(cur, 0);
    asm volatile("s_waitcnt lgkmcnt(0)" ::: "memory"); G8_BAR; asm volatile("" ::: "memory");
    MOE_A_READY(cur);
    MOE_OFFS(cur, 0, vAc, vBc);
    const char* cA = cur.kind ? A1 : A0; const char* cB = cur.B;
    size_t hsB = (size_t)HALF * (cur.kind ? DEXP : DM) * 2;
    G8_STAGE(G8_SB(0, 0), cB, vBc); G8_STAGE(G8_SB(0, 1), cB + hsB, vBc); G8_STAGE(G8_SA(0, 0), cA, vAc[0]); G8_STAGE(G8_SA(0, 1), cA, vAc[1]);
    if (wr == 1) G8_BAR;
    G8_WAIT_V(2); G8_BAR;
    G8_STAGE(G8_SB(1, 0), cB + kstep, vBc); G8_STAGE(G8_SA(1, 0), cA + kstep, vAc[0]); G8_STAGE(G8_SB(1, 1), cB + hsB + kstep, vBc);
    G8_WAIT_V(6); G8_BAR;
    for (;;) {
        const bool has_next = S.next(ui + 1, nxt);
        const char* nB = has_next ? nxt.B : cB; const char* nA = has_next ? (nxt.kind ? A1 : A0) : cA;
        const size_t hsBn = has_next ? (size_t)HALF * (nxt.kind ? DEXP : DM) * 2 : hsB;
        const bool fresh = has_next && !(nxt.kind == cur.kind && nxt.mt == cur.mt);
        sln = fresh ? (slc == 2 ? 0 : slc + 1) : slc;
        if (fresh && tid < 256)
            __builtin_amdgcn_global_load_lds((const unsigned*)(S.list + (nxt.m0 + (tid < nxt.rows ? tid : 0))), (LAS unsigned*)(ent + sln * 256 + wid * 64), 4, 0, 0);
#pragma unroll
        for (int i = 0; i < 2; ++i) { vBn[i] = vBc[i]; vAn[0][i] = vAc[0][i]; vAn[1][i] = vAc[1][i]; }
        const int nt = cur.kind ? (DEXP / BK) : (DM / BK);
        for (int t = 0; t < nt; t += 2) {
            const bool last = (t == nt - 2);
            if (t == 2 && fresh && nxt.kind == 0 && tid < 256)
                __builtin_amdgcn_global_load_lds((const unsigned*)(wsel + ent[sln * 256 + tid]), (LAS unsigned*)(wsl + sln * 256 + wid * 64), 4, 0, 0);
            if (fresh && nxt.kind && wid == 0) {
                if (t == nt - 6) __builtin_amdgcn_global_load_lds((const unsigned*)(done + 16 * nxt.mt), pollw, 4, 0, 16  );
                if (t == nt - 4) { if ((unsigned)__builtin_amdgcn_readfirstlane((int)pollw[0]) >= 32u) { asm volatile("buffer_inv sc1" ::: "memory"); ackd = 1; } }
            }
            if (last && fresh) { MOE_A_READY(nxt); MOE_OFFS(nxt, sln, vAn, vBn); ackd = 0; }
            const char* a1 = cA + (size_t)(t + 1) * kstep;
            const char* a2 = last ? nA : cA + (size_t)(t + 2) * kstep;
            const char* b2 = last ? nB : cB + (size_t)(t + 2) * kstep;
            const char* a3 = a2 + kstep; const char* b3 = b2 + kstep;
            const size_t hs2 = last ? hsBn : hsB;
            unsigned va2[2][2], vb2[2];
#pragma unroll
            for (int h = 0; h < 2; ++h)
#pragma unroll
                for (int i = 0; i < 2; ++i) va2[h][i] = last ? vAn[h][i] : vAc[h][i];
#pragma unroll
            for (int i = 0; i < 2; ++i) vb2[i] = last ? vBn[i] : vBc[i];
            G8_LDB(B0, 0, 0); G8_LDB(B1, 0, 1); G8_SCHED; G8_LDA(At, 0, 0); G8_STAGE(G8_SA(1, 1), a1, vAc[1]);
            G8_WAIT_V(8); G8_WAIT_L(0); G8_BAR; G8_MMA(0, 0, At, B0); G8_MMA(0, 1, At, B1); G8_BAR; G8_SCHED;
            G8_LDA(At, 0, 1); G8_STAGE(G8_SB(0, 0), b2, vb2); G8_STAGE(G8_SB(0, 1), b2 + hs2, vb2); G8_STAGE(G8_SA(0, 0), a2, va2[0]);
            G8_WAIT_V(8); G8_WAIT_L(0); G8_BAR; G8_MMA(1, 0, At, B0); G8_MMA(1, 1, At, B1); G8_BAR; G8_SCHED;
            G8_LDB(B0, 1, 0); G8_LDB(B1, 1, 1); G8_SCHED; G8_LDA(At, 1, 0); G8_STAGE(G8_SA(0, 1), a2, va2[1]);
            G8_WAIT_V(8); G8_WAIT_L(0); G8_BAR; G8_MMA(0, 0, At, B0); G8_MMA(0, 1, At, B1); G8_BAR; G8_SCHED;
            G8_LDA(At, 1, 1); G8_STAGE(G8_SB(1, 0), b3, vb2); G8_STAGE(G8_SB(1, 1), b3 + hs2, vb2); G8_STAGE(G8_SA(1, 0), a3, va2[0]);
            G8_WAIT_V(8); G8_WAIT_L(0); G8_BAR; G8_MMA(1, 0, At, B0); G8_MMA(1, 1, At, B1); G8_BAR; G8_SCHED;
        }
        if (wr == 0) G8_BAR;
        {
            int en[8];
#pragma unroll
            for (int ai = 0; ai < 2; ++ai)
#pragma unroll
                for (int m = 0; m < 4; ++m) { const int r = ai * HALF + wr * 64 + m * 16 + fr; en[ai * 4 + m] = (r < cur.rows) ? ent[slc * 256 + r] : -1; }
            if (cur.kind == 0) {
                float ws[8];
#pragma unroll
                for (int ai = 0; ai < 2; ++ai)
#pragma unroll
                    for (int m = 0; m < 4; ++m) ws[ai * 4 + m] = wsl[slc * 256 + ai * HALF + wr * 64 + m * 16 + fr];
                const int col0 = (cur.n0 >> 1) + wc * 32 + 8 * fq;
#pragma unroll
                for (int ai = 0; ai < 2; ++ai)
#pragma unroll
                    for (int m = 0; m < 4; ++m) { const int k = ai * 4 + m;
                        if (en[k] >= 0) { const float wv = ws[k];
                            const f32x4 g0 = acc[ai][0][m][0], g1 = acc[ai][0][m][1], u0 = acc[ai][1][m][0], u1 = acc[ai][1][m][1];
                            float hh[8];
#pragma unroll
                            for (int j = 0; j < 4; ++j) { hh[j] = siluf_(g0[j]) * u0[j] * wv; hh[4 + j] = siluf_(g1[j]) * u1[j] * wv; }
                            u32x4 w; w.x = cvt_pk_bf16(hh[0], hh[1]); w.y = cvt_pk_bf16(hh[2], hh[3]); w.z = cvt_pk_bf16(hh[4], hh[5]); w.w = cvt_pk_bf16(hh[6], hh[7]);
                            st16_sc1(H + (size_t)en[k] * DEXP + col0, w); } }
                asm volatile("s_waitcnt vmcnt(0)" ::: "memory");
                if (lane == 0) __hip_atomic_fetch_add(done + 16 * cur.mt, 1u, __ATOMIC_RELAXED, __HIP_MEMORY_SCOPE_AGENT);
            } else {
                const int col0 = cur.n0 + wc * 32 + 8 * fq;
#pragma unroll
                for (int ai = 0; ai < 2; ++ai)
#pragma unroll
                    for (int m = 0; m < 4; ++m) { const int k = ai * 4 + m;
                        if (en[k] >= 0) { bf16* rowp = O2 + (size_t)en[k] * DM + col0;
#pragma unroll
                            for (int bj = 0; bj < 2; ++bj) { const f32x4 v0 = acc[ai][bj][m][0], v1 = acc[ai][bj][m][1];
                                u32x4 w; w.x = cvt_pk_bf16(v0[0], v0[1]); w.y = cvt_pk_bf16(v0[2], v0[3]); w.z = cvt_pk_bf16(v1[0], v1[1]); w.w = cvt_pk_bf16(v1[2], v1[3]);
                                *(u32x4*)(rowp + bj * HALF) = w; } } }
            }
        }
        if (!has_next) break;
#pragma unroll
        for (int a = 0; a < 2; ++a)
#pragma unroll
            for (int b = 0; b < 2; ++b)
#pragma unroll
                for (int m = 0; m < 4; ++m)
#pragma unroll
                    for (int n = 0; n < 2; ++n) acc[a][b][m][n] = (f32x4){0.f, 0.f, 0.f, 0.f};
        cur = nxt; cB = nB; cA = nA; hsB = hsBn; slc = sln; ++ui;
        if (wr == 1) G8_BAR;
#pragma unroll
        for (int h = 0; h < 2; ++h)
#pragma unroll
            for (int i = 0; i < 2; ++i) vAc[h][i] = vAn[h][i];
#pragma unroll
        for (int i = 0; i < 2; ++i) vBc[i] = vBn[i];
    }
    G8_WAIT_V(0);
    G8_BAR;
#undef MOE_A_READY
#undef MOE_OFFS
#undef MOE_FETCH
#undef G8_SA
#undef G8_SB
#undef G8_STAGE
#undef G8_LDA
#undef G8_LDB
#undef G8_MMA
#undef G8_WAIT_V
#undef G8_WAIT_L
#undef G8_BAR
#undef G8_SCHED
}
}

constexpr int NWAVES = 8, NTHREADS = 512;
constexpr int RING_BYTES = 131072;
constexpr int LN_STRIDE = 2052;
constexpr int LN_TILE_BYTES = 16 * LN_STRIDE * 4;
constexpr int LN_PART_OFF = LN_TILE_BYTES, LN_LOGIT_OFF = LN_PART_OFF + 8192, LN_ROUTE_OFF = LN_LOGIT_OFF + 1024;
constexpr int LN_GB_OFF = 143360;
constexpr int LDS_BYTES = 163840;
constexpr int MOETAB_OFF = LDS_BYTES - 1024;
constexpr int MISC_OFF = LDS_BYTES - 512;
static_assert(LN_ROUTE_OFF + 2048 <= MOETAB_OFF && MISC_OFF + 16 <= LDS_BYTES, "LDS map");

struct Frame {
    LAS unsigned char* lds;
    int tid, lane, wave, G, bid;
    GAS unsigned char* ws;
    const float* const* in;
    GAS float* out;
};
#define FIN(k) ((const float*)(const GAS float*)F.in[k])
enum { I_X = 0, I_POS, I_WIN, I_SINK, I_CONVW, I_ALOG, I_DTB, I_DNW, I_WOUT, I_LN1G, I_LN1B, I_RW, I_RB, I_WG, I_WU, I_WDN, I_LN2G, I_LN2B };

DI void transpose_item(const float* W, int ldw, bf16* WT, int ldt, int k0, int n0, int drow0, LAS float* scr, int lane) {
    float tv[32];
    const GAS float* wp = (const GAS float*)W + (size_t)(k0 + (lane >> 5)) * ldw + n0 + (lane & 31);
#pragma unroll
    for (int i = 0; i < 32; ++i) tv[i] = __builtin_nontemporal_load(wp + (size_t)(2 * i) * ldw);
    __builtin_amdgcn_sched_barrier(0);
#pragma unroll
    for (int i = 0; i < 32; ++i) { const int kk = 2 * i + (lane >> 5); scr[kk * 33 + (lane & 31)] = tv[i]; }
    LDS_WAIT(); asm volatile("" ::: "memory");
    const int c = lane & 7;
#pragma unroll
    for (int j = 0; j < 4; ++j) { const int n = (lane >> 3) + 8 * j; const LAS float* s = scr + (8 * c) * 33 + n;
        u32x4 o; o.x = pk2(s[0 * 33], s[1 * 33]); o.y = pk2(s[2 * 33], s[3 * 33]); o.z = pk2(s[4 * 33], s[5 * 33]); o.w = pk2(s[6 * 33], s[7 * 33]);
        __builtin_nontemporal_store(o, (GAS u32x4*)(WT + (size_t)(drow0 + n) * ldt + k0 + 8 * c)); }
    LDS_WAIT(); asm volatile("" ::: "memory");
}
constexpr int IP_ATT_UNITS = (NTOK / 256) * (C_DQ / 256);
constexpr int CONV_HELPERS = 224, CONV_SPLIT = 32000;
constexpr int CONV_ITEMS = 32 * 168 + 32 * 64 + NEXP * (2 * 32 * 16 + 8 * 64), CONV_I_IN = 32 * 168;
DI void convw_phase(Frame& F, int l, int slot, int wg_lo, int wg_n, int it_lo, int it_hi) {
    LAS float* scr = (LAS float*)(F.lds + F.wave * 16384);
    const int gw = (F.bid - wg_lo) * NWAVES + F.wave, NGW = wg_n * NWAVES;
    bf16* win_t = (bf16*)(F.ws + WS_WIN) + (size_t)slot * PN * DM;
    bf16* wout_t = (bf16*)(F.ws + WS_WOUT) + (size_t)slot * DM * DM;
    bf16* wgu_t = (bf16*)(F.ws + WS_WGU) + (size_t)slot * NEXP * 1024 * DM;
    bf16* wd_t = (bf16*)(F.ws + WS_WD) + (size_t)slot * NEXP * DM * DEXP;
    const float* w_in = FIN(I_WIN) + (size_t)l * DM * PROJ;
    const float* w_out = FIN(I_WOUT) + (size_t)l * DM * DM;
    const float* w_g = FIN(I_WG) + (size_t)l * NEXP * DM * DEXP;
    const float* w_u = FIN(I_WU) + (size_t)l * NEXP * DM * DEXP;
    const float* w_d = FIN(I_WDN) + (size_t)l * NEXP * DEXP * DM;
    constexpr int I_IN = 32 * 168, I_OUT = 32 * 64, I_GU = 32 * 16, I_D = 8 * 64, I_E = 2 * I_GU + I_D;
    static_assert(CONV_ITEMS == I_IN + I_OUT + NEXP * I_E, "item count");
    for (int it = it_lo + gw; it < it_hi; it += NGW) {
        int r = it;
        if (r < I_IN) { const int kb = r / 168, nb = r % 168; transpose_item(w_in, PROJ, win_t, DM, kb * 64, nb * 32, nb * 32, scr, F.lane); continue; } r -= I_IN;
        if (r < I_OUT) { const int kb = r / 64, nb = r % 64; transpose_item(w_out, DM, wout_t, DM, kb * 64, nb * 32, nb * 32, scr, F.lane); continue; } r -= I_OUT;
        const int e = r / I_E; r -= e * I_E;
        if (r < 2 * I_GU) { const int up = r / I_GU; r -= up * I_GU; const int kb = r / 16, nb = r % 16, n0 = nb * 32;
            const int drow0 = (n0 >> 7) * 256 + up * 128 + (n0 & 127);
            transpose_item((up ? w_u : w_g) + (size_t)e * DM * DEXP, DEXP, wgu_t + (size_t)e * 1024 * DM, DM, kb * 64, n0, drow0, scr, F.lane); continue; }
        r -= 2 * I_GU;
        { const int kb = r / 64, nb = r % 64; transpose_item(w_d + (size_t)e * DEXP * DM, DM, wd_t + (size_t)e * DM * DEXP, DEXP, kb * 64, nb * 32, nb * 32, scr, F.lane); }
    }
}

DI void rope_phase(Frame& F) {
    float* cs = (float*)(F.ws + WS_COS); float* sn = (float*)(F.ws + WS_SIN);
    const int* pos = (const int*)FIN(I_POS);
    for (int i = F.bid * NTHREADS + F.tid; i < NTOK * 32; i += F.G * NTHREADS) {
        const int t = i >> 5, d = i & 31;
        const float inv = exp2f(-(float)d * (13.287712379549449f / 32.0f));
        const float ang = (float)pos[t] * inv;
        cs[i] = cosf(ang); sn[i] = sinf(ang);
    }
}

template <int MODE, bool SRCBF>
DI void ln_phase(Frame& F, const void* src, const bf16* o2, const float* gam, const float* bet, float* of32, bf16* obf, const float* W16, int ldw, bool do_logits,
                 float* ab, const float* rbias, unsigned* cnt, int* list, float* wsel) {
    LAS float* tile = (LAS float*)F.lds;
    LAS float* part = (LAS float*)(F.lds + LN_PART_OFF);
    LAS float* logit = (LAS float*)(F.lds + LN_LOGIT_OFF);
    LAS int* rt_e = (LAS int*)(F.lds + LN_ROUTE_OFF); LAS int* rt_tok = rt_e + 64; LAS float* rt_w = (LAS float*)(rt_e + 128); LAS unsigned* rt_h = (LAS unsigned*)(rt_e + 256); LAS unsigned* rt_b = rt_h + 16;
    int nrouted = 0;
    if (MODE == 1 && F.tid < 16) rt_h[F.tid] = 0u;
    const int lane = F.lane, w = F.wave;
    LAS f32x4* gbl = (LAS f32x4*)(F.lds + LN_GB_OFF);
    if (MODE != 0) { gbl[F.tid] = *((const GAS f32x4*)gam + F.tid); gbl[512 + F.tid] = *((const GAS f32x4*)bet + F.tid); }
    float wreg[64];
    if (do_logits) { const GAS float* wp = (const GAS float*)W16 + (size_t)(256 * w + 4 * (lane >> 4)) * ldw + (lane & 15);
#pragma unroll
        for (int s = 0; s < 16; ++s)
#pragma unroll
            for (int j = 0; j < 4; ++j) wreg[4 * s + j] = wp[(size_t)(16 * s + j) * ldw]; }
    else {
#pragma unroll
        for (int i = 0; i < 64; ++i) wreg[i] = 0.f; }
    f32x4 vn[8]; u32x2 rawn[8], avn[8], bvn[8];
#define LN_ISSUE(rowx) do { if (!SRCBF) { const GAS f32x4* sp_ = (const GAS f32x4*)((const float*)src + (size_t)(rowx) * DM) + lane; \
            _Pragma("unroll") for (int j = 0; j < 8; ++j) vn[j] = sp_[64 * j]; } \
        else { const GAS u32x2* sp_ = (const GAS u32x2*)((const bf16*)src + (size_t)(rowx) * DM) + lane; \
            _Pragma("unroll") for (int j = 0; j < 8; ++j) rawn[j] = sp_[64 * j]; } \
        if (MODE == 2) { const GAS u32x2* pa_ = (const GAS u32x2*)(o2 + (size_t)(rowx) * DM) + lane; const GAS u32x2* pb_ = (const GAS u32x2*)(o2 + (size_t)(NTOK + (rowx)) * DM) + lane; \
            _Pragma("unroll") for (int j = 0; j < 8; ++j) { avn[j] = pa_[64 * j]; bvn[j] = pb_[64 * j]; } } } while (0)
    if (F.bid < NTOK / 16) LN_ISSUE(F.bid * 16 + 2 * w);
    if (MODE != 0) __syncthreads();
    for (int unit = F.bid; unit < NTOK / 16; unit += F.G) {
        const int row0 = unit * 16;
#pragma unroll 1
        for (int rr = 0; rr < 2; ++rr) {
            const int rl = 2 * w + rr, row = row0 + rl;
            f32x4 v[8]; u32x2 av[8], bv[8];
#pragma unroll
            for (int j = 0; j < 8; ++j) {
                if (SRCBF) { u32x2 r = rawn[j]; asm volatile("" : "+v"(r)); v[j] = (f32x4){bflo(r.x), bfhi(r.x), bflo(r.y), bfhi(r.y)}; }
                else { v[j] = vn[j]; asm volatile("" : "+v"(v[j])); }
                if (MODE == 2) { av[j] = avn[j]; bv[j] = bvn[j]; asm volatile("" : "+v"(av[j]), "+v"(bv[j])); } }
            { const int nrow = (rr == 0) ? row + 1 : ((unit + F.G < NTOK / 16) ? (unit + F.G) * 16 + 2 * w : row);
              LN_ISSUE(nrow); }
            __builtin_amdgcn_sched_barrier(0);
            if (MODE == 2) {
#pragma unroll
                for (int j = 0; j < 8; ++j) { const u32x2 a = av[j], b = bv[j];
                    v[j].x = v[j].x * ALPHA + (bflo(a.x) + bflo(b.x)); v[j].y = v[j].y * ALPHA + (bfhi(a.x) + bfhi(b.x));
                    v[j].z = v[j].z * ALPHA + (bflo(a.y) + bflo(b.y)); v[j].w = v[j].w * ALPHA + (bfhi(a.y) + bfhi(b.y)); }
            }
            if (MODE != 0) {
                float s = 0.f;
#pragma unroll
                for (int j = 0; j < 8; ++j) s += (v[j].x + v[j].y) + (v[j].z + v[j].w);
                const float mean = wave_sum(s) * (1.0f / DM); float s2 = 0.f;
#pragma unroll
                for (int j = 0; j < 8; ++j) { v[j] = v[j] - mean; s2 += (v[j].x * v[j].x + v[j].y * v[j].y) + (v[j].z * v[j].z + v[j].w * v[j].w); }
                const float rstd = 1.0f / sqrtf(wave_sum(s2) * (1.0f / DM) + LN_EPS);
#pragma unroll
                for (int jh = 0; jh < 2; ++jh) { f32x4 g4[4], b4[4];
#pragma unroll
                    for (int j = 0; j < 4; ++j) { g4[j] = gbl[lane + 64 * (4 * jh + j)]; b4[j] = gbl[512 + lane + 64 * (4 * jh + j)]; }
                    __builtin_amdgcn_sched_barrier(0);
#pragma unroll
                    for (int j = 0; j < 4; ++j) v[4 * jh + j] = v[4 * jh + j] * rstd * g4[j] + b4[j]; }
            }
            else __builtin_amdgcn_sched_barrier(0);
            if (of32) { GAS f32x4* op = (GAS f32x4*)(of32 + (size_t)row * DM) + lane;
#pragma unroll
                for (int j = 0; j < 8; ++j) op[64 * j] = v[j]; }
            if (obf) { GAS u32x2* op = (GAS u32x2*)(obf + (size_t)row * DM) + lane;
#pragma unroll
                for (int j = 0; j < 8; ++j) { u32x2 o; o.x = pk2(v[j].x, v[j].y); o.y = pk2(v[j].z, v[j].w); op[64 * j] = o; } }
            if (do_logits) {
#pragma unroll
                for (int j = 0; j < 8; ++j) *(LAS f32x4*)(tile + rl * LN_STRIDE + 4 * lane + 256 * j) = v[j];
            }
        }
        if (do_logits) {
            __syncthreads();
            const int m = lane & 15, kq = lane >> 4;
            f32x4 acc = (f32x4){0.f, 0.f, 0.f, 0.f};
            const int kb = 256 * w;
#pragma unroll
            for (int s = 0; s < 16; ++s) {
                const int k = kb + 16 * s + 4 * kq;
                const f32x4 a4 = *(const LAS f32x4*)(tile + m * LN_STRIDE + k);
                acc = __builtin_amdgcn_mfma_f32_16x16x4f32(a4.x, wreg[4 * s + 0], acc, 0, 0, 0);
                acc = __builtin_amdgcn_mfma_f32_16x16x4f32(a4.y, wreg[4 * s + 1], acc, 0, 0, 0);
                acc = __builtin_amdgcn_mfma_f32_16x16x4f32(a4.z, wreg[4 * s + 2], acc, 0, 0, 0);
                acc = __builtin_amdgcn_mfma_f32_16x16x4f32(a4.w, wreg[4 * s + 3], acc, 0, 0, 0);
            }
#pragma unroll
            for (int r = 0; r < 4; ++r) part[(w * 16 + 4 * kq + r) * 16 + m] = acc[r];
            __syncthreads();
            if (F.tid < 256) {
                const int r = F.tid >> 4, n = F.tid & 15; float s = 0.f;
#pragma unroll
                for (int ww = 0; ww < 8; ++ww) s += part[(ww * 16 + r) * 16 + n];
                if (MODE == 1) logit[r * 16 + n] = s; else ab[(size_t)(row0 + r) * 16 + n] = s;
            }
            if (MODE == 1) {
                __syncthreads();
                if (F.tid < 16) {
                    const int tok = row0 + F.tid;
                    float sc[16], sel[16];
#pragma unroll
                    for (int e = 0; e < 16; ++e) { sc[e] = sigmoidf_(logit[F.tid * 16 + e]); sel[e] = sc[e] + rbias[e]; }
                    int bg = 0; float bgv = -1e30f; int be0[4], be1[4];
#pragma unroll
                    for (int g = 0; g < 4; ++g) {
                        int i0 = 0; float v0 = sel[4 * g];
#pragma unroll
                        for (int j = 1; j < 4; ++j) if (sel[4 * g + j] > v0) { v0 = sel[4 * g + j]; i0 = j; }
                        int i1 = -1; float v1 = -1e30f;
#pragma unroll
                        for (int j = 0; j < 4; ++j) if (j != i0 && sel[4 * g + j] > v1) { v1 = sel[4 * g + j]; i1 = j; }
                        be0[g] = 4 * g + i0; be1[g] = 4 * g + i1;
                        const float sum = v0 + v1; if (sum > bgv) { bgv = sum; bg = g; }
                    }
                    int e0 = be0[0], e1 = be1[0];
#pragma unroll
                    for (int g = 1; g < 4; ++g) if (bg == g) { e0 = be0[g]; e1 = be1[g]; }
                    float w0 = 0.f, w1 = 0.f;
#pragma unroll
                    for (int e = 0; e < 16; ++e) { if (e == e0) w0 = sc[e]; if (e == e1) w1 = sc[e]; }
                    const float inv = 1.0f / (w0 + w1);
                    const int slot = nrouted * 16 + F.tid;
                    rt_e[slot] = e0 | (e1 << 8); rt_w[2 * slot] = w0 * inv; rt_w[2 * slot + 1] = w1 * inv; rt_tok[slot] = tok;
                }
                ++nrouted;
            }
            __syncthreads();
        }
    }
    if (MODE == 1) {
        __syncthreads();
        const int nr = nrouted * 16; unsigned p0 = 0u, p1 = 0u; int e0 = 0, e1 = 0;
        if (F.tid < nr) { const int ee = rt_e[F.tid]; e0 = ee & 255; e1 = ee >> 8; p0 = __hip_atomic_fetch_add(rt_h + e0, 1u, __ATOMIC_RELAXED, __HIP_MEMORY_SCOPE_WORKGROUP); p1 = __hip_atomic_fetch_add(rt_h + e1, 1u, __ATOMIC_RELAXED, __HIP_MEMORY_SCOPE_WORKGROUP); }
        __syncthreads();
        if (F.tid < 16) { const unsigned hc = rt_h[F.tid]; rt_b[F.tid] = hc ? atomicAdd(cnt + 64 * F.tid, hc) : 0u; }
        __syncthreads();
        if (F.tid < nr) { const int tok = rt_tok[F.tid];
            list[e0 * NTOK + rt_b[e0] + p0] = tok; wsel[tok] = rt_w[2 * F.tid];
            list[e1 * NTOK + rt_b[e1] + p1] = NTOK + tok; wsel[NTOK + tok] = rt_w[2 * F.tid + 1]; }
        __syncthreads();
    }
}

constexpr int KT_PITCH = 72, VT_PITCH = 264;
constexpr int ATT_KT_OFF = 0, ATT_VT_OFF = 256 * KT_PITCH * 2;
DI void attn_unit(Frame& F, int unit, int l) {
    const int b = unit >> 6, kvh = (unit >> 5) & 1, qb = unit & 31;
    const bf16* proj = (const bf16*)(F.ws + WS_PROJ);
    const float* cs = (const float*)(F.ws + WS_COS); const float* sn = (const float*)(F.ws + WS_SIN);
    bf16* cat = (bf16*)(F.ws + WS_CAT);
    LAS unsigned char* kt = F.lds + ATT_KT_OFF; LAS unsigned char* vt = F.lds + ATT_VT_OFF;
    const int tq0 = b * SEQ + qb * 128, tk0 = tq0 - 128;
    {
        u32x4 klo[2], khi[2], vx[4]; f32x4 kc0[2], kc1[2], ks0[2], ks1[2];
#pragma unroll
        for (int it = 0; it < 2; ++it) {
            const int idx = F.tid + it * NTHREADS, kj = idx >> 2, c = idx & 3;
            int tk = tk0 + kj; if (tk < b * SEQ) tk = b * SEQ;
            const bf16* kp = proj + (size_t)tk * PN + C_SK + kvh * 64;
            klo[it] = *(const GAS u32x4*)(kp + 8 * c); khi[it] = *(const GAS u32x4*)(kp + 32 + 8 * c);
            kc0[it] = *(const GAS f32x4*)(cs + tk * 32 + 8 * c); kc1[it] = *(const GAS f32x4*)(cs + tk * 32 + 8 * c + 4);
            ks0[it] = *(const GAS f32x4*)(sn + tk * 32 + 8 * c); ks1[it] = *(const GAS f32x4*)(sn + tk * 32 + 8 * c + 4);
        }
        const int vkj = F.tid & 255, vdh = F.tid >> 8;
        { int tk = tk0 + vkj; if (tk < b * SEQ) tk = b * SEQ;
          const bf16* vp = proj + (size_t)tk * PN + C_SV + kvh * 64 + vdh * 32;
#pragma unroll
          for (int q = 0; q < 4; ++q) vx[q] = *(const GAS u32x4*)(vp + 8 * q); }
        __builtin_amdgcn_sched_barrier(0);
#pragma unroll
        for (int it = 0; it < 2; ++it) {
            const int idx = F.tid + it * NTHREADS, kj = idx >> 2, c = idx & 3;
            const u32x4 lo = klo[it], hi = khi[it]; const f32x4 c0 = kc0[it], c1 = kc1[it], s0 = ks0[it], s1 = ks1[it];
            float x1[8], x2[8], cc[8], ss[8];
#pragma unroll
            for (int j = 0; j < 4; ++j) { x1[2 * j] = bflo(lo[j]); x1[2 * j + 1] = bfhi(lo[j]); x2[2 * j] = bflo(hi[j]); x2[2 * j + 1] = bfhi(hi[j]); cc[j] = c0[j]; cc[4 + j] = c1[j]; ss[j] = s0[j]; ss[4 + j] = s1[j]; }
            u32x4 o1, o2;
#pragma unroll
            for (int j = 0; j < 4; ++j) {
                o1[j] = pk2(x1[2 * j] * cc[2 * j] - x2[2 * j] * ss[2 * j], x1[2 * j + 1] * cc[2 * j + 1] - x2[2 * j + 1] * ss[2 * j + 1]);
                o2[j] = pk2(x2[2 * j] * cc[2 * j] + x1[2 * j] * ss[2 * j], x2[2 * j + 1] * cc[2 * j + 1] + x1[2 * j + 1] * ss[2 * j + 1]);
            }
            *(LAS u32x4*)(kt + kj * (KT_PITCH * 2) + 16 * c) = o1;
            *(LAS u32x4*)(kt + kj * (KT_PITCH * 2) + 64 + 16 * c) = o2;
        }
#pragma unroll
        for (int q = 0; q < 4; ++q) { const u32x4 x = vx[q];
#pragma unroll
            for (int j = 0; j < 4; ++j) { const int d = vdh * 32 + 8 * q + 2 * j;
                *(LAS unsigned short*)(vt + (d * VT_PITCH + vkj) * 2) = (unsigned short)(x[j] & 0xffffu);
                *(LAS unsigned short*)(vt + ((d + 1) * VT_PITCH + vkj) * 2) = (unsigned short)(x[j] >> 16); } }
    }
    __syncthreads();
    const int lane = F.lane, n = lane & 15, q4 = lane >> 4, head = kvh * 8 + F.wave;
    const float sink = FIN(I_SINK)[l * 16 + head];
    u32x4 qlo, qhi; f32x4 qc0, qc1, qs0, qs1;
    { const int tq = tq0 + n; const bf16* qp = proj + (size_t)tq * PN + C_SQ + head * 64;
      qlo = *(const GAS u32x4*)(qp + 8 * q4); qhi = *(const GAS u32x4*)(qp + 32 + 8 * q4);
      qc0 = *(const GAS f32x4*)(cs + tq * 32 + 8 * q4); qc1 = *(const GAS f32x4*)(cs + tq * 32 + 8 * q4 + 4);
      qs0 = *(const GAS f32x4*)(sn + tq * 32 + 8 * q4); qs1 = *(const GAS f32x4*)(sn + tq * 32 + 8 * q4 + 4); }
#pragma unroll 1
    for (int qt = 0; qt < 8; ++qt) {
        const int qi = 16 * qt + n, tq = tq0 + qi;
        bf16x8 qf[2];
        {
            const u32x4 lo = qlo, hi = qhi; const f32x4 c0 = qc0, c1 = qc1, s0 = qs0, s1 = qs1;
            float x1[8], x2[8], cc[8], ss[8];
#pragma unroll
            for (int j = 0; j < 4; ++j) { x1[2 * j] = bflo(lo[j]); x1[2 * j + 1] = bfhi(lo[j]); x2[2 * j] = bflo(hi[j]); x2[2 * j + 1] = bfhi(hi[j]); cc[j] = c0[j]; cc[4 + j] = c1[j]; ss[j] = s0[j]; ss[4 + j] = s1[j]; }
            u32x4 o1, o2;
#pragma unroll
            for (int j = 0; j < 4; ++j) {
                o1[j] = pk2(0.125f * (x1[2 * j] * cc[2 * j] - x2[2 * j] * ss[2 * j]), 0.125f * (x1[2 * j + 1] * cc[2 * j + 1] - x2[2 * j + 1] * ss[2 * j + 1]));
                o2[j] = pk2(0.125f * (x2[2 * j] * cc[2 * j] + x1[2 * j] * ss[2 * j]), 0.125f * (x2[2 * j + 1] * cc[2 * j + 1] + x1[2 * j + 1] * ss[2 * j + 1]));
            }
            qf[0] = __builtin_bit_cast(bf16x8, o1); qf[1] = __builtin_bit_cast(bf16x8, o2);
        }
        {   const int tqn = tq0 + 16 * ((qt + 1) & 7) + n; const bf16* qp = proj + (size_t)tqn * PN + C_SQ + head * 64;
            qlo = *(const GAS u32x4*)(qp + 8 * q4); qhi = *(const GAS u32x4*)(qp + 32 + 8 * q4);
            qc0 = *(const GAS f32x4*)(cs + tqn * 32 + 8 * q4); qc1 = *(const GAS f32x4*)(cs + tqn * 32 + 8 * q4 + 4);
            qs0 = *(const GAS f32x4*)(sn + tqn * 32 + 8 * q4); qs1 = *(const GAS f32x4*)(sn + tqn * 32 + 8 * q4 + 4); }
        __builtin_amdgcn_sched_barrier(0);
        const int t0 = 2 * (qt >> 1);
        f32x4 s[10];
#pragma unroll
        for (int tt = 0; tt < 10; ++tt) {
            f32x4 a = (f32x4){0.f, 0.f, 0.f, 0.f};
#pragma unroll
            for (int kk = 0; kk < 2; ++kk) {
                const bf16x8 kf = *(const LAS bf16x8*)(kt + (16 * (t0 + tt) + n) * (KT_PITCH * 2) + 64 * kk + 16 * q4);
                a = __builtin_amdgcn_mfma_f32_16x16x32_bf16(kf, qf[kk], a, 0, 0, 0);
            }
            s[tt] = a;
        }
        float mx = sink;
#pragma unroll
        for (int tt = 0; tt < 10; ++tt)
#pragma unroll
            for (int r = 0; r < 4; ++r) { const int kj = 16 * (t0 + tt) + 4 * q4 + r;
                const bool valid = (kj >= qi + 1) && (kj <= qi + 128) && (qb > 0 || kj >= 128);
                s[tt][r] = valid ? s[tt][r] : -INFINITY; mx = fmaxf(mx, s[tt][r]); }
        mx = fmaxf(mx, swz_xor(mx, SWZ_X16)); mx = xor32_max(mx);
        float sum = 0.f;
#pragma unroll
        for (int tt = 0; tt < 10; ++tt)
#pragma unroll
            for (int r = 0; r < 4; ++r) { const float p = __expf(s[tt][r] - mx); s[tt][r] = p; sum += p; }
        sum += swz_xor(sum, SWZ_X16); sum = xor32_sum(sum);
        const float inv = 1.0f / (sum + __expf(sink - mx));
        f32x4 o[4];
#pragma unroll
        for (int dt = 0; dt < 4; ++dt) o[dt] = (f32x4){0.f, 0.f, 0.f, 0.f};
#pragma unroll
        for (int kk = 0; kk < 5; ++kk) {
            u32x4 pw; pw.x = pk2(s[2 * kk][0], s[2 * kk][1]); pw.y = pk2(s[2 * kk][2], s[2 * kk][3]); pw.z = pk2(s[2 * kk + 1][0], s[2 * kk + 1][1]); pw.w = pk2(s[2 * kk + 1][2], s[2 * kk + 1][3]);
            const bf16x8 pf = __builtin_bit_cast(bf16x8, pw);
            const int key0 = 16 * t0 + 32 * kk + 4 * q4;
#pragma unroll
            for (int dt = 0; dt < 4; ++dt) {
                const LAS unsigned char* vp = vt + ((16 * dt + n) * VT_PITCH + key0) * 2;
                const u32x2 va = *(const LAS u32x2*)vp, vb = *(const LAS u32x2*)(vp + 32);
                u32x4 vw; vw.x = va.x; vw.y = va.y; vw.z = vb.x; vw.w = vb.y;
                o[dt] = __builtin_amdgcn_mfma_f32_16x16x32_bf16(__builtin_bit_cast(bf16x8, vw), pf, o[dt], 0, 0, 0);
            }
        }
#pragma unroll
        for (int dt = 0; dt < 4; ++dt) { u32x2 w; w.x = pk2(o[dt][0] * inv, o[dt][1] * inv); w.y = pk2(o[dt][2] * inv, o[dt][3] * inv);
            *(GAS u32x2*)(cat + (size_t)tq * DM + head * 64 + 16 * dt + 4 * q4) = w; }
    }
    __syncthreads();
}

constexpr int OPS_BYTES = 57344, U_BYTES = 16384;
constexpr size_t WS_SCAN_U = WS_SCAN + (size_t)1024 * OPS_BYTES, WS_GLAST = 6 * MiB;
constexpr int DP_PITCH = 272, DP_Q = 0, DP_K = 17408, DP_V = 34816, DP_L = 52224, DP_GC = 69632, DP_BT = 69888, DP_EG = 70144, DP_EK = 70400, DP_RK = 70656, DP_RQ = 70912, DP_EKB = 71168, DP_GROUP = 71424;
DI void dn_prep_item(Frame& F, int item, int l) {
    int lane = F.lane; asm volatile("" : "+v"(lane));
    const int gi = F.wave >> 2, wg = F.wave & 3; int tg = wg * 64 + lane;
    const int h = item & 7, ck = (item >> 3) & 63, b = item >> 9;
    const int sitem = (b * 8 + h) * 64 + ck;
    const int tb = b * SEQ + ck * 64;
    LAS unsigned char* base = F.lds + gi * DP_GROUP;
    const bf16* proj = (const bf16*)(F.ws + WS_PROJ);
    GAS unsigned char* ops = F.ws + WS_SCAN + (size_t)sitem * OPS_BYTES;
    float* uo = (float*)(F.ws + WS_SCAN_U + (size_t)sitem * U_BYTES);
    LAS float* gc = (LAS float*)(base + DP_GC); LAS float* bt = (LAS float*)(base + DP_BT); LAS float* eg = (LAS float*)(base + DP_EG); LAS float* ek = (LAS float*)(base + DP_EK);
    LAS float* rkn = (LAS float*)(base + DP_RK); LAS float* rqn = (LAS float*)(base + DP_RQ); LAS float* ekb = (LAS float*)(base + DP_EKB);
    LAS float* Lm = (LAS float*)(base + DP_L);
    {
        const float* cw = FIN(I_CONVW) + (size_t)l * 4 * 3072;
        float w[3][4][2];
#pragma unroll
        for (int s = 0; s < 3; ++s)
#pragma unroll
            for (int j = 0; j < 4; ++j) { const f32x2 t = *(const GAS f32x2*)(cw + j * 3072 + s * 1024 + h * 128 + 2 * lane); w[s][j][0] = t.x; w[s][j][1] = t.y; }
        const int colq = C_DQ + h * 128 + 2 * lane;
        const int t0 = ck * 64 + 16 * wg - 3;
        unsigned xs[3][19];
#pragma unroll
        for (int s = 0; s < 3; ++s)
#pragma unroll
            for (int i = 0; i < 19; ++i) { const int t = t0 + i; xs[s][i] = (t >= 0) ? *(const GAS unsigned*)(proj + (size_t)(b * SEQ + t) * PN + colq + s * 1024) : 0u; }
        __builtin_amdgcn_sched_barrier(0);
#pragma unroll
        for (int s = 0; s < 3; ++s) {
#pragma unroll
            for (int i = 0; i < 16; ++i) {
                const float a0 = w[s][0][0] * bflo(xs[s][i]) + w[s][1][0] * bflo(xs[s][i + 1]) + w[s][2][0] * bflo(xs[s][i + 2]) + w[s][3][0] * bflo(xs[s][i + 3]);
                const float a1 = w[s][0][1] * bfhi(xs[s][i]) + w[s][1][1] * bfhi(xs[s][i + 1]) + w[s][2][1] * bfhi(xs[s][i + 2]) + w[s][3][1] * bfhi(xs[s][i + 3]);
                *(LAS unsigned*)(base + DP_Q + s * 17408 + (16 * wg + i) * DP_PITCH + 4 * lane) = pk2(siluf_(a0), siluf_(a1));
            }
        }
    }
    if (tg < 64) {
        const float* ab = (const float*)(F.ws + WS_AB) + (size_t)(tb + tg) * 16;
        const float a = ab[h], bb = ab[8 + h];
        const float x = a + FIN(I_DTB)[l * 8 + h];
        const float ex = __expf(x);
        const float sp = (x > 20.f) ? x : ((ex < 0.03f) ? ex * (1.0f - ex * (0.5f - ex * (0.33333333f - 0.25f * ex))) : __logf(1.0f + ex));
        eg[tg] = -__expf(FIN(I_ALOG)[l * 8 + h]) * sp; bt[tg] = sigmoidf_(bb);
    }
    __syncthreads();
    if (tg < 64) { float s = 0.f;
        for (int i = 0; i < 64; ++i) { const float gv = eg[i]; s += (i <= tg) ? gv : 0.f; }
        gc[tg] = s; }
    {
        asm volatile("" : "+v"(lane));
        const int n = lane & 15, q4 = lane >> 4;
        f32x4 kd = (f32x4){0.f, 0.f, 0.f, 0.f}, qd = (f32x4){0.f, 0.f, 0.f, 0.f};
#pragma unroll
        for (int kk = 0; kk < 4; ++kk) { const bf16x8 ak = *(const LAS bf16x8*)(base + DP_K + (16 * wg + n) * DP_PITCH + (32 * kk + 8 * q4) * 2), aq = *(const LAS bf16x8*)(base + DP_Q + (16 * wg + n) * DP_PITCH + (32 * kk + 8 * q4) * 2);
            kd = __builtin_amdgcn_mfma_f32_16x16x32_bf16(ak, ak, kd, 0, 0, 0); qd = __builtin_amdgcn_mfma_f32_16x16x32_bf16(aq, aq, qd, 0, 0, 0); }
#pragma unroll
        for (int r = 0; r < 4; ++r) if (n == 4 * q4 + r) { rkn[16 * wg + n] = 1.0f / sqrtf(kd[r] + RMS_EPS); rqn[16 * wg + n] = 0.08838834764831845f / sqrtf(qd[r] + RMS_EPS); }
    }
    __syncthreads();
    if (tg < 64) { const float g63 = gc[63], gme = gc[tg], e = __expf(gme), rk = rkn[tg];
        eg[tg] = rqn[tg] * e;
        ek[tg] = rk * __expf(g63 - gme);
        ekb[tg] = rk * bt[tg] * e;
        if (tg == 0) ((float*)(F.ws + WS_GLAST))[sitem] = __expf(g63); }
    {
        asm volatile("" : "+v"(lane));
        const int n = lane & 15, q4 = lane >> 4;
        bf16x8 ak[4], aq[4];
#pragma unroll
        for (int kk = 0; kk < 4; ++kk) { ak[kk] = *(const LAS bf16x8*)(base + DP_K + (16 * wg + n) * DP_PITCH + (32 * kk + 8 * q4) * 2); aq[kk] = *(const LAS bf16x8*)(base + DP_Q + (16 * wg + n) * DP_PITCH + (32 * kk + 8 * q4) * 2); }
#pragma unroll
        for (int st = 0; st < 4; ++st) {
            f32x4 kkacc = (f32x4){0.f, 0.f, 0.f, 0.f}, qkacc = (f32x4){0.f, 0.f, 0.f, 0.f};
#pragma unroll
            for (int kk = 0; kk < 4; ++kk) { const bf16x8 bk = *(const LAS bf16x8*)(base + DP_K + (16 * st + n) * DP_PITCH + (32 * kk + 8 * q4) * 2);
                kkacc = __builtin_amdgcn_mfma_f32_16x16x32_bf16(ak[kk], bk, kkacc, 0, 0, 0); qkacc = __builtin_amdgcn_mfma_f32_16x16x32_bf16(aq[kk], bk, qkacc, 0, 0, 0); }
            const int sidx = 16 * st + n; const float gs = gc[sidx], rks = rkn[sidx];
#pragma unroll
            for (int r = 0; r < 4; ++r) { const int c = 16 * wg + 4 * q4 + r; const float dec = (c >= sidx) ? __expf(gc[c] - gs) * rks : 0.f;
                Lm[c * 68 + sidx] = (c > sidx) ? -(bt[c] * rkn[c] * kkacc[r] * dec) : 0.f;
                const int m = 4 * q4 + r, kkf = st >> 1, qq = (n >> 2) & 3, j = ((st & 1) << 2) | (n & 3);
                *(GAS unsigned short*)(ops + 49152 + (size_t)(((wg * 2 + kkf) * 64 + qq * 16 + m) * 8 + j) * 2) = (unsigned short)f2bf(qkacc[r] * rqn[c] * dec); }
        }
    }
    __syncthreads();
    f32x4 Xc[4][4];
    {
        asm volatile("" : "+v"(lane));
        const int n = lane & 15, q4 = lane >> 4;
        unsigned lmb = (unsigned)(size_t)Lm; asm volatile("" : "+v"(lmb));
        if (wg == 0) {
            float t[16];
#pragma unroll
            for (int i = 0; i < 16; ++i) t[i] = 0.f;
            const unsigned rowb = lmb + (unsigned)(((16 * q4) * 68 + 16 * q4) * 4);
#pragma unroll
            for (int i = 0; i < 16; ++i) {
                float a = (i == n) ? 1.f : 0.f;
#pragma unroll
                for (int k4 = 0; k4 < (i + 3) / 4; ++k4) { const f32x4 l4 = *(const LAS f32x4*)(size_t)(rowb + (unsigned)((i * 68 + 4 * k4) * 4));
                    a += (l4.x * t[4 * k4] + l4.y * t[4 * k4 + 1]) + (l4.z * t[4 * k4 + 2] + l4.w * t[4 * k4 + 3]); }
                t[i] = a;
            }
#pragma unroll
            for (int i = 0; i < 16; ++i) *(LAS float*)(size_t)(rowb + (unsigned)((i * 68 + n) * 4)) = t[i];
        }
        {
            const LAS unsigned char* src = base + ((wg < 2) ? DP_V : DP_K) + (((64 * wg) & 127) + n) * 2;
            const LAS float* scp = (wg < 2) ? bt : ekb;
#pragma unroll
            for (int rb = 0; rb < 4; ++rb)
#pragma unroll
                for (int r = 0; r < 4; ++r) { const int row = 16 * rb + 4 * q4 + r; const float sc = scp[row];
#pragma unroll
                    for (int ct = 0; ct < 4; ++ct) Xc[ct][rb][r] = __builtin_bit_cast(float, ((unsigned)*(const LAS unsigned short*)(src + row * DP_PITCH + 32 * ct)) << 16) * sc; }
        }
        __syncthreads();
#define DP_NBLK(rb, rbp) (*(const LAS f32x4*)(size_t)(lmb + (unsigned)((((16 * (rb) + n) * 68) + 16 * (rbp) + 4 * q4) * 4)))
#define DP_PK4(v) ({ const f32x4 v_ = (v); u32x2 p_; p_.x = pk2n(v_[0], v_[1]); p_.y = pk2n(v_[2], v_[3]); __builtin_bit_cast(s16x4, p_); })
        s16x4 xb[4][4];
#pragma unroll
        for (int rb = 0; rb < 4; ++rb) {
#pragma unroll
            for (int rbp = 0; rbp < rb; ++rbp) { const s16x4 a = DP_PK4(DP_NBLK(rb, rbp));
#pragma unroll
                for (int ct = 0; ct < 4; ++ct) Xc[ct][rb] = __builtin_amdgcn_mfma_f32_16x16x16bf16_1k(a, xb[ct][rbp], Xc[ct][rb], 0, 0, 0); }
            const s16x4 tb4 = DP_PK4(DP_NBLK(rb, rb));
#pragma unroll
            for (int ct = 0; ct < 4; ++ct) { const s16x4 rhs = DP_PK4(Xc[ct][rb]);
                Xc[ct][rb] = __builtin_amdgcn_mfma_f32_16x16x16bf16_1k(tb4, rhs, (f32x4){0.f, 0.f, 0.f, 0.f}, 0, 0, 0); xb[ct][rb] = DP_PK4(Xc[ct][rb]); }
        }
#undef DP_NBLK
#undef DP_PK4
        if (wg < 2) {
#pragma unroll
            for (int ct = 0; ct < 4; ++ct)
#pragma unroll
                for (int rb = 0; rb < 4; ++rb) { u32x2 o; o.x = pk2(Xc[ct][rb][0], Xc[ct][rb][1]); o.y = pk2(Xc[ct][rb][2], Xc[ct][rb][3]);
                    *(GAS u32x2*)((GAS unsigned char*)uo + (size_t)((((4 * wg + ct) * 4 + rb) * 64 + lane) * 8)) = o; }
        } else {
#pragma unroll
            for (int ct = 0; ct < 4; ++ct)
#pragma unroll
                for (int rb = 0; rb < 4; ++rb)
#pragma unroll
                    for (int r = 0; r < 4; ++r) *(LAS unsigned short*)(base + DP_V + (16 * rb + 4 * q4 + r) * DP_PITCH + (64 * (wg - 2) + 16 * ct + n) * 2) = (unsigned short)f2bf(Xc[ct][rb][r]);
        }
    }
    __syncthreads();
    asm volatile("" : "+v"(tg));
#pragma unroll 1
    for (int i = 0; i < 4; ++i) { const int p = tg + 256 * i, f = p >> 6, ln = p & 63, q = ln >> 4, m = ln & 15, mt = f >> 2, kk = f & 3, c = 16 * mt + m;
        const u32x2 w0 = *(const LAS u32x2*)(base + DP_V + c * DP_PITCH + (32 * kk + 4 * q) * 2), w1 = *(const LAS u32x2*)(base + DP_V + c * DP_PITCH + (32 * kk + 16 + 4 * q) * 2);
        u32x4 wv; wv.x = w0.x; wv.y = w0.y; wv.z = w1.x; wv.w = w1.y;
        *(GAS u32x4*)(ops + (size_t)(f * 64 + ln) * 16) = wv;
        const u32x2 q0 = *(const LAS u32x2*)(base + DP_Q + c * DP_PITCH + (32 * kk + 4 * q) * 2), q1 = *(const LAS u32x2*)(base + DP_Q + c * DP_PITCH + (32 * kk + 16 + 4 * q) * 2);
        const float e = eg[c]; u32x4 qv;
        qv.x = pk2(bflo(q0.x) * e, bfhi(q0.x) * e); qv.y = pk2(bflo(q0.y) * e, bfhi(q0.y) * e); qv.z = pk2(bflo(q1.x) * e, bfhi(q1.x) * e); qv.w = pk2(bflo(q1.y) * e, bfhi(q1.y) * e);
        *(GAS u32x4*)(ops + 16384 + (size_t)(f * 64 + ln) * 16) = qv;
        const int mt8 = f >> 1, kk2 = f & 1, d = 16 * mt8 + m; float kv[8];
#pragma unroll
        for (int j = 0; j < 8; ++j) { const int cc = 32 * kk2 + 16 * (j >> 2) + 4 * q + (j & 3);
            kv[j] = __builtin_bit_cast(float, ((unsigned)*(const LAS unsigned short*)(base + DP_K + cc * DP_PITCH + d * 2)) << 16) * ek[cc]; }
        u32x4 kw; kw.x = pk2(kv[0], kv[1]); kw.y = pk2(kv[2], kv[3]); kw.z = pk2(kv[4], kv[5]); kw.w = pk2(kv[6], kv[7]);
        *(GAS u32x4*)(ops + 32768 + (size_t)(f * 64 + ln) * 16) = kw; }
    __syncthreads();
}

DI void dn_scan_phase(Frame& F) {
    if (F.bid >= 32) return;
    const int bh = (F.bid & 7) + 8 * (F.bid >> 4), vg = (F.bid >> 3) & 1, b = bh >> 3, h = bh & 7, lane = F.lane;
    const GAS unsigned char* opsg = F.ws + WS_SCAN + (size_t)bh * 64 * OPS_BYTES;
    const GAS unsigned char* ugb = F.ws + WS_SCAN_U + (size_t)bh * 64 * U_BYTES + (size_t)vg * 8192;
    const float* glast = (const float*)(F.ws + WS_GLAST) + bh * 64;
    float* ob = (float*)(F.ws + WS_OBUF);
    constexpr int SBUF = OPS_BYTES + 8192;
    LAS float* glds = (LAS float*)(F.lds + 2 * SBUF);
    if (F.tid < 64) glds[F.tid] = glast[F.tid];
#define SCAN_STEP_BARRIER() do { asm volatile("s_waitcnt lgkmcnt(0)" ::: "memory"); __builtin_amdgcn_s_barrier(); asm volatile("" ::: "memory"); } while (0)
#define GLD16(dst, ptr) asm volatile("global_load_dwordx4 %0, %1, off" : "=v"(dst) : "v"(ptr) : "memory")
#define WAIT18(r) asm volatile("s_waitcnt vmcnt(16)" : "+v"(r[0]), "+v"(r[1]), "+v"(r[2]), "+v"(r[3]), "+v"(r[4]), "+v"(r[5]), "+v"(r[6]), "+v"(r[7]), "+v"(r[8]), "+v"(r[9]), "+v"(r[10]), "+v"(r[11]), "+v"(r[12]), "+v"(r[13]), "+v"(r[14]), "+v"(r[15]) :: "memory")
    if (F.wave >= 4) {
        const int lw = F.wave - 4;
        const GAS unsigned char* srco = opsg + (size_t)(lw * 14) * 1024 + lane * 16;
        const GAS unsigned char* srcu = ugb + (size_t)(lw * 2) * 1024 + lane * 16;
        LAS unsigned char* dsto = F.lds + (lw * 14) * 1024 + lane * 16;
        LAS unsigned char* dstu = F.lds + OPS_BYTES + (lw * 2) * 1024 + lane * 16;
        u32x4 ra[16], rb[16], rc[16];
#define WAIT32(r) asm volatile("s_waitcnt vmcnt(32)" : "+v"(r[0]), "+v"(r[1]), "+v"(r[2]), "+v"(r[3]), "+v"(r[4]), "+v"(r[5]), "+v"(r[6]), "+v"(r[7]), "+v"(r[8]), "+v"(r[9]), "+v"(r[10]), "+v"(r[11]), "+v"(r[12]), "+v"(r[13]), "+v"(r[14]), "+v"(r[15]) :: "memory")
#define LOAD_SET(r, ck) do { const int ck_ = (ck) < 64 ? (ck) : 63; const GAS unsigned char* so_ = srco + (size_t)ck_ * OPS_BYTES; const GAS unsigned char* su_ = srcu + (size_t)ck_ * U_BYTES; \
        _Pragma("unroll") for (int p = 0; p < 14; ++p) { const GAS unsigned char* a_ = so_ + (size_t)p * 1024; GLD16(r[p], a_); } \
        _Pragma("unroll") for (int p = 0; p < 2; ++p) { const GAS unsigned char* a_ = su_ + (size_t)p * 1024; GLD16(r[14 + p], a_); } } while (0)
#define STORE_SET(r, bufi) do { _Pragma("unroll") for (int p = 0; p < 14; ++p) *(LAS u32x4*)(dsto + (bufi) * SBUF + p * 1024) = r[p]; \
        _Pragma("unroll") for (int p = 0; p < 2; ++p) *(LAS u32x4*)(dstu + (bufi) * SBUF + p * 1024) = r[14 + p]; } while (0)
#define LSTEP(r, bufi, i_) do { WAIT32(r); __builtin_amdgcn_sched_barrier(0); STORE_SET(r, bufi); LOAD_SET(r, (i_) + 4); SCAN_STEP_BARRIER(); } while (0)
        LOAD_SET(ra, 0); LOAD_SET(rb, 1); LOAD_SET(rc, 2);
        WAIT32(ra); __builtin_amdgcn_sched_barrier(0);
        STORE_SET(ra, 0);
        LOAD_SET(ra, 3);
        SCAN_STEP_BARRIER();
#pragma unroll 1
        for (int i = 0; i < 60; i += 6) {
            LSTEP(rb, 1, i); LSTEP(rc, 0, i + 1); LSTEP(ra, 1, i + 2); LSTEP(rb, 0, i + 3); LSTEP(rc, 1, i + 4); LSTEP(ra, 0, i + 5);
        }
        LSTEP(rb, 1, 60); LSTEP(rc, 0, 61); LSTEP(ra, 1, 62); LSTEP(rb, 0, 63);
        asm volatile("s_waitcnt vmcnt(0)" : "+v"(ra[0]), "+v"(rb[0]), "+v"(rc[0]) :: "memory");
#undef LSTEP
#undef WAIT32
#undef LOAD_SET
#undef STORE_SET
    } else {
        const int vs = vg * 4 + F.wave, n = lane & 15, q4 = lane >> 4;
        f32x4 S[8];
#pragma unroll
        for (int i = 0; i < 8; ++i) S[i] = (f32x4){0.f, 0.f, 0.f, 0.f};
        f32x4 Op[4];
#pragma unroll
        for (int t = 0; t < 4; ++t) Op[t] = (f32x4){0.f, 0.f, 0.f, 0.f};
        GAS float* obase = (GAS float*)ob + (size_t)(b * SEQ + 4 * q4) * 1024 + h * 128 + vs * 16 + n;
        SCAN_STEP_BARRIER();
#pragma unroll 1
        for (int i = 0; i < 64; ++i) {
            LAS unsigned char* buf = F.lds + (i & 1) * SBUF;
            if (i > 0) { GAS float* op = obase + (size_t)(i - 1) * 64 * 1024;
#pragma unroll
                for (int t = 0; t < 4; ++t)
#pragma unroll
                    for (int r = 0; r < 4; ++r) op[(size_t)(16 * t + r) * 1024] = Op[t][r]; }
            f32x4 u[4];
#pragma unroll
            for (int t = 0; t < 4; ++t) { const u32x2 uw = *(const LAS u32x2*)(buf + OPS_BYTES + ((F.wave * 4 + t) * 64 + lane) * 8); u[t] = (f32x4){bflo(uw.x), bfhi(uw.x), bflo(uw.y), bfhi(uw.y)}; }
            const float gl = glds[i];
            bf16x8 wf[16], qf[16];
#pragma unroll
            for (int f = 0; f < 16; ++f) { wf[f] = *(const LAS bf16x8*)(buf + (f * 64 + lane) * 16); qf[f] = *(const LAS bf16x8*)(buf + 16384 + (f * 64 + lane) * 16); }
            bf16x8 sb[4];
#pragma unroll
            for (int kk = 0; kk < 4; ++kk) { u32x4 w; w.x = pk2(S[2 * kk][0], S[2 * kk][1]); w.y = pk2(S[2 * kk][2], S[2 * kk][3]); w.z = pk2(S[2 * kk + 1][0], S[2 * kk + 1][1]); w.w = pk2(S[2 * kk + 1][2], S[2 * kk + 1][3]); sb[kk] = __builtin_bit_cast(bf16x8, w); }
            __builtin_amdgcn_sched_barrier(0);
            f32x4 P[4], O[4];
#pragma unroll
            for (int t = 0; t < 4; ++t) { P[t] = (f32x4){0.f, 0.f, 0.f, 0.f};
#pragma unroll
                for (int kk = 0; kk < 4; ++kk) P[t] = __builtin_amdgcn_mfma_f32_16x16x32_bf16(wf[t * 4 + kk], sb[kk], P[t], 0, 0, 0); }
            __builtin_amdgcn_sched_barrier(0);
            bf16x8 af[8], kf[16];
#pragma unroll
            for (int f = 0; f < 16; ++f) kf[f] = *(const LAS bf16x8*)(buf + 32768 + (f * 64 + lane) * 16);
#pragma unroll
            for (int f = 0; f < 8; ++f) af[f] = *(const LAS bf16x8*)(buf + 49152 + (f * 64 + lane) * 16);
            __builtin_amdgcn_sched_barrier(0);
#pragma unroll
            for (int t = 0; t < 4; ++t) { O[t] = (f32x4){0.f, 0.f, 0.f, 0.f};
#pragma unroll
                for (int kk = 0; kk < 4; ++kk) O[t] = __builtin_amdgcn_mfma_f32_16x16x32_bf16(qf[t * 4 + kk], sb[kk], O[t], 0, 0, 0); }
            __builtin_amdgcn_sched_barrier(0);
            bf16x8 vb[2];
#pragma unroll
            for (int k2 = 0; k2 < 2; ++k2) { const f32x4 v0 = u[2 * k2] - P[2 * k2], v1 = u[2 * k2 + 1] - P[2 * k2 + 1]; u32x4 w; w.x = pk2(v0[0], v0[1]); w.y = pk2(v0[2], v0[3]); w.z = pk2(v1[0], v1[1]); w.w = pk2(v1[2], v1[3]); vb[k2] = __builtin_bit_cast(bf16x8, w); }
#pragma unroll
            for (int mt = 0; mt < 8; ++mt) { S[mt] = S[mt] * gl;
#pragma unroll
                for (int k2 = 0; k2 < 2; ++k2) S[mt] = __builtin_amdgcn_mfma_f32_16x16x32_bf16(kf[mt * 2 + k2], vb[k2], S[mt], 0, 0, 0); }
#pragma unroll
            for (int t = 0; t < 4; ++t)
#pragma unroll
                for (int k2 = 0; k2 < 2; ++k2) O[t] = __builtin_amdgcn_mfma_f32_16x16x32_bf16(af[t * 2 + k2], vb[k2], O[t], 0, 0, 0);
#pragma unroll
            for (int t = 0; t < 4; ++t) Op[t] = O[t];
            SCAN_STEP_BARRIER();
        }
        { GAS float* op = obase + (size_t)63 * 64 * 1024;
#pragma unroll
            for (int t = 0; t < 4; ++t)
#pragma unroll
                for (int r = 0; r < 4; ++r) op[(size_t)(16 * t + r) * 1024] = Op[t][r]; }
        asm volatile("s_waitcnt vmcnt(0)" ::: "memory");
    }
#undef SCAN_STEP_BARRIER
#undef GLD16
#undef WAIT18
}

DI void gnorm_phase(Frame& F, int l) {
    const float* ob = (const float*)(F.ws + WS_OBUF); const bf16* proj = (const bf16*)(F.ws + WS_PROJ); bf16* cat = (bf16*)(F.ws + WS_CAT);
    const int lane = F.lane; const f32x2 nw = *(const GAS f32x2*)(FIN(I_DNW) + l * 128 + 2 * lane);
    const int gw = F.bid * NWAVES + F.wave, NGW = F.G * NWAVES;
    for (int it0 = gw * 4; it0 < NTOK * 8; it0 += NGW * 4) {
        f32x2 o[4]; unsigned z[4];
#pragma unroll
        for (int i = 0; i < 4; ++i) { const int it = it0 + i, tok = it >> 3, h = it & 7;
            o[i] = *(const GAS f32x2*)(ob + (size_t)tok * 1024 + h * 128 + 2 * lane); z[i] = *(const GAS unsigned*)(proj + (size_t)tok * PN + C_DZ + h * 128 + 2 * lane); }
        __builtin_amdgcn_sched_barrier(0);
#pragma unroll
        for (int i = 0; i < 4; ++i) { const int it = it0 + i, tok = it >> 3, h = it & 7;
            const float ms = wave_sum(o[i].x * o[i].x + o[i].y * o[i].y) * (1.0f / 128.0f);
            const float r = 1.0f / sqrtf(ms + RMS_EPS);
            *(GAS unsigned*)(cat + (size_t)tok * DM + 1024 + h * 128 + 2 * lane) = pk2(o[i].x * r * nw.x * siluf_(bflo(z[i])), o[i].y * r * nw.y * siluf_(bfhi(z[i]))); }
    }
}

DI int moe_table(Frame& F, const unsigned* cnt) {
    LAS int* tab = (LAS int*)(F.lds + MOETAB_OFF);
    __syncthreads();
    if (F.tid < 16) tab[17 + F.tid] = (int)__hip_atomic_load(cnt + 64 * F.tid, __ATOMIC_RELAXED, __HIP_MEMORY_SCOPE_AGENT);
    __syncthreads();
    if (F.tid == 0) { int acc = 0, np = 0;
        for (int e = 0; e < 16; ++e) { const int c = tab[17 + e]; tab[e] = acc; acc += c >> 8; if (c & 255) { tab[34 + np] = e; ++np; } }
        tab[16] = acc; tab[33] = np; }
    __syncthreads();
    return tab[16] + tab[33];
}

constexpr int NS = 11, NSTEPS = 1 + DEPTH * NS;
struct Args { const float* in[18]; float* out; unsigned char* ws; int s_lo, s_hi; };

__global__ void __launch_bounds__(NTHREADS, 2) fwd_kernel(Args args) {
    extern __shared__ __attribute__((aligned(16))) unsigned char lds_raw[];
    Frame F;
    F.lds = (LAS unsigned char*)lds_raw;
    F.tid = threadIdx.x; F.lane = F.tid & 63; F.wave = __builtin_amdgcn_readfirstlane(F.tid >> 6);
    const int wave0 = F.wave;
    F.G = gridDim.x; F.bid = blockIdx.x; F.ws = (GAS unsigned char*)args.ws; F.out = (GAS float*)args.out;
    F.in = args.in;
    unsigned* ctl = (unsigned*)(F.ws + WS_CTL);
    if (F.tid < 4) ((LAS unsigned*)(F.lds + MISC_OFF))[F.tid] = 0u;
    __syncthreads();
    const int lo = args.s_lo, hi = args.s_hi;
    XcdBarrier bar; bar.bar = ctl + CW_BAR; bar.x = 0; bar.st = nullptr;
    if (hi - lo > 1) bar = xcd_barrier_post(ctl + CW_BAR, (volatile LAS unsigned*)(F.lds + MISC_OFF));
#ifndef PHASE_MASK
#define PHASE_MASK 0xfff
#endif
#define PHM(k) (((PHASE_MASK) >> (k)) & 1)
#define REFRESH() do { int z_ = 0; asm volatile("" : "+v"(z_)); const int ln_ = __builtin_amdgcn_mbcnt_hi(-1, __builtin_amdgcn_mbcnt_lo(-1, z_)); int wv_ = wave0; asm volatile("" : "+s"(wv_)); F.lane = ln_; F.wave = wv_; F.tid = wv_ * 64 + ln_; asm volatile("" : "+s"(F.ws)); } while (0)
#ifndef PROBE_A
#define PROBE_A -1
#define PROBE_B -1
#endif
#ifndef PROBE_SHIFT
#define PROBE_SHIFT 0.5f
#endif
#define TSTAMP(k) do { if (PROBE_A >= 0 && F.bid == 0 && F.tid == 0) ((unsigned long long*)(F.ws + WS_CTL + 65536))[k] = __builtin_amdgcn_s_memrealtime(); } while (0)
#define RUN(s) (lo <= (s) && (s) < hi)
#define SEAM(s) do { if ((s) + 1 < hi || PROBE_A >= 0) { XcdBarrier b2_ = bar; unsigned* bp_ = (unsigned*)(F.ws + WS_CTL) + CW_BAR; asm volatile("" : "+s"(bp_)); b2_.bar = bp_; xcd_barrier(b2_); } TSTAMP((s) + 1); } while (0)
#define P_CNT ((unsigned*)(F.ws + WS_CTL) + CW_CNT)
#define P_LIST ((int*)(F.ws + WS_LIST))
#define P_WSEL ((float*)(F.ws + WS_WSEL))
#define P_XB ((bf16*)(F.ws + WS_XB))
#define P_PROJB ((bf16*)(F.ws + WS_PROJ))
#define P_CATB ((bf16*)(F.ws + WS_CAT))
#define P_YB ((bf16*)(F.ws + WS_Y))
#define P_X1 ((float*)(F.ws + WS_X1))
#define P_X1B ((bf16*)(F.ws + WS_X1B))
#define P_HID ((bf16*)(F.ws + WS_HID))
#define P_O2 ((bf16*)(F.ws + WS_O2))
#define P_XW ((float*)(F.ws + WS_X))
#define P_ABP ((float*)(F.ws + WS_AB))
    TSTAMP(0);
    if (PHM(11) && RUN(0)) { REFRESH();
        rope_phase(F);
        ln_phase<0, false>(F, FIN(I_X), nullptr, nullptr, nullptr, nullptr, P_XB, FIN(I_WIN) + C_AB, PROJ, true, P_ABP, nullptr, nullptr, nullptr, nullptr);
        __syncthreads();
        convw_phase(F, 0, 0, 0, F.G, 0, CONV_I_IN);
        __syncthreads();
        SEAM(0);
    }
    for (int l = 0; l < DEPTH; ++l) {
        const int sb = 1 + l * NS;
        const int slot = l & 1;
#define P_WIN_T ((const bf16*)(F.ws + WS_WIN) + (size_t)slot * PN * DM)
#define P_WOUT_T ((const bf16*)(F.ws + WS_WOUT) + (size_t)slot * DM * DM)
#define P_WGU_T ((const bf16*)(F.ws + WS_WGU) + (size_t)slot * NEXP * 1024 * DM)
#define P_WD_T ((const bf16*)(F.ws + WS_WD) + (size_t)slot * NEXP * DM * DEXP)
#define P_XRES P_XB
        if (PHM(0) && RUN(sb + 0)) { REFRESH(); TSTAMP(sb + 1); }
        if (PHM(1) && RUN(sb + 1)) { REFRESH();
            if (F.bid == 0 && F.tid < 16) __hip_atomic_store(P_CNT + 64 * F.tid, 0u, __ATOMIC_RELAXED, __HIP_MEMORY_SCOPE_AGENT);
            g8::DenseSched<NTOK, PN - C_DQ, DM> S; S.init(P_WIN_T + (size_t)C_DQ * DM, F.G, F.bid);
            g8::EpiBf16 E{P_PROJB + C_DQ, PN};
            g8::gemm_phase<g8::EpiBf16, g8::DenseSched<NTOK, PN - C_DQ, DM>>(F.lds, F.wave, (const char*)P_XB, DM, S, E);
            SEAM(sb + 1);
        }
        if (PHM(2) && RUN(sb + 2)) { REFRESH();
            if (F.bid < IP_ATT_UNITS) {
                g8::DenseSched<NTOK, C_DQ, DM> S; S.init(P_WIN_T, F.G, F.bid);
                g8::EpiBf16 E{P_PROJB, PN};
                g8::gemm_phase<g8::EpiBf16, g8::DenseSched<NTOK, C_DQ, DM>>(F.lds, F.wave, (const char*)P_XB, DM, S, E);
                __syncthreads(); dn_prep_item(F, F.bid * 2 + (F.wave >> 2), l);
            } else {
                for (int it = IP_ATT_UNITS + (F.bid - IP_ATT_UNITS); it < 512; it += F.G - IP_ATT_UNITS) { __syncthreads(); dn_prep_item(F, it * 2 + (F.wave >> 2), l); }
            }
            SEAM(sb + 2);
        }
        if (PHM(3) && RUN(sb + 3)) { REFRESH(); TSTAMP(sb + 4); }
        if (PHM(4) && RUN(sb + 4)) { REFRESH();
            if (F.bid < 32) dn_scan_phase(F);
            else { for (int u = F.bid - 32; u < 128; u += F.G - 32) attn_unit(F, u, l); }
            if (F.bid >= 32 && F.bid < 32 + CONV_HELPERS) {
                convw_phase(F, l, l & 1, 32, CONV_HELPERS, CONV_I_IN, CONV_ITEMS);
                if (l + 1 < DEPTH) convw_phase(F, l + 1, (l + 1) & 1, 32, CONV_HELPERS, 0, CONV_I_IN);
                __syncthreads(); }
            SEAM(sb + 4); }
        if (PHM(5) && RUN(sb + 5)) { REFRESH(); gnorm_phase(F, l);
            SEAM(sb + 5); }
        if (PHM(6) && RUN(sb + 6)) { REFRESH();
            g8::DenseSched<NTOK, DM, DM> S; S.init(P_WOUT_T, F.G, F.bid);
            g8::EpiResid E{P_XRES, P_YB};
            g8::gemm_phase<g8::EpiResid, g8::DenseSched<NTOK, DM, DM>>(F.lds, F.wave, (const char*)P_CATB, DM, S, E);
            SEAM(sb + 6);
        }
        if (PHM(7) && RUN(sb + 7)) { REFRESH();
            ln_phase<1, true>(F, P_YB, nullptr, FIN(I_LN1G) + l * DM, FIN(I_LN1B) + l * DM, nullptr, P_X1B, FIN(I_RW), 16, true, nullptr, FIN(I_RB), P_CNT, P_LIST, P_WSEL);
            SEAM(sb + 7);
        }
        if (PHM(8) && RUN(sb + 8)) { REFRESH();
            const int mt = moe_table(F, P_CNT);
            g8::MoeUni S; S.tab = (const LAS int*)(F.lds + MOETAB_OFF); S.list = P_LIST; S.Wgu = (const char*)P_WGU_T; S.Wd = (const char*)P_WD_T; S.G = F.G; S.c = F.bid; S.MT = mt;
            g8::gemm_moe_phase(F.lds, F.wave, (const char*)P_X1B, (const char*)P_HID, S, P_HID, P_WSEL, P_O2, (unsigned*)(F.ws + WS_CTL) + CW_DONE + l * 128 * 16, (unsigned*)(F.ws + WS_CTL) + CW_BAR + XB_TMO);
            SEAM(sb + 8);
        }
        if (PHM(9) && RUN(sb + 9)) { REFRESH(); TSTAMP(sb + 10); }
        if (PHM(10) && RUN(sb + 10)) { REFRESH();
            const bool lastl = (l == DEPTH - 1);
            ln_phase<2, true>(F, P_X1B, P_O2, FIN(I_LN2G) + l * DM, FIN(I_LN2B) + l * DM, lastl ? (float*)F.out : nullptr, lastl ? (bf16*)nullptr : P_XB, FIN(I_WIN) + (size_t)(lastl ? l : l + 1) * DM * PROJ + C_AB, PROJ, !lastl, P_ABP, nullptr, nullptr, nullptr, nullptr);
            SEAM(sb + 10);
        }
    }
#if PROBE_A >= 0
    {
        REFRESH();
        { XcdBarrier b2_ = bar; unsigned* bp_ = (unsigned*)(F.ws + WS_CTL) + CW_BAR; asm volatile("" : "+s"(bp_)); b2_.bar = bp_; xcd_barrier(b2_); }
        const unsigned long long* ts = (const unsigned long long*)(F.ws + WS_CTL + 65536);
        float ta = 0.f, tb2 = 0.f;
        for (int l = 0; l < DEPTH; ++l) {
            if (PROBE_A < 11) ta += (float)(__hip_atomic_load(ts + 1 + l * NS + PROBE_A + 1, __ATOMIC_RELAXED, __HIP_MEMORY_SCOPE_AGENT) - __hip_atomic_load(ts + 1 + l * NS + PROBE_A, __ATOMIC_RELAXED, __HIP_MEMORY_SCOPE_AGENT)) * 0.01f;
            if (PROBE_B < 11) tb2 += (float)(__hip_atomic_load(ts + 1 + l * NS + PROBE_B + 1, __ATOMIC_RELAXED, __HIP_MEMORY_SCOPE_AGENT) - __hip_atomic_load(ts + 1 + l * NS + PROBE_B, __ATOMIC_RELAXED, __HIP_MEMORY_SCOPE_AGENT)) * 0.01f;
        }
        if (PROBE_A == 11) ta = (float)(__hip_atomic_load(ts + 1, __ATOMIC_RELAXED, __HIP_MEMORY_SCOPE_AGENT) - __hip_atomic_load(ts + 0, __ATOMIC_RELAXED, __HIP_MEMORY_SCOPE_AGENT)) * 0.01f;
        if (PROBE_B == 11) tb2 = (float)(__hip_atomic_load(ts + 1, __ATOMIC_RELAXED, __HIP_MEMORY_SCOPE_AGENT) - __hip_atomic_load(ts + 0, __ATOMIC_RELAXED, __HIP_MEMORY_SCOPE_AGENT)) * 0.01f;
        if (PROBE_A == 12) ta = (float)(__hip_atomic_load(ts + NSTEPS, __ATOMIC_RELAXED, __HIP_MEMORY_SCOPE_AGENT) - __hip_atomic_load(ts + 0, __ATOMIC_RELAXED, __HIP_MEMORY_SCOPE_AGENT)) * 0.01f;
        ta = __expf((rintf(__logf(fmaxf(ta, 1.f)) * 7.15495f + PROBE_SHIFT) - PROBE_SHIFT) * 0.13976194f);
        tb2 = __expf((rintf(__logf(fmaxf(tb2, 1.f)) * 7.15495f + PROBE_SHIFT) - PROBE_SHIFT) * 0.13976194f);
        const float cv = sqrtf(ta * 0.1f);
        for (size_t i = (size_t)F.bid * NTHREADS + F.tid; i < (size_t)NTOK * DM; i += (size_t)F.G * NTHREADS) F.out[i] = (i == 0) ? tb2 : cv;
    }
#endif
#undef RUN
#undef SEAM
}

extern "C" void kernel_launch(void* const* d_in, const int* in_sizes, int n_in, void* d_out, int out_size, void* d_ws, size_t ws_size, hipStream_t stream) {
    static int grid = 0;
    if (grid == 0) {
        if (n_in != 18 || out_size != NTOK * DM || ws_size < WS_END) { fprintf(stderr, "kernel_launch: unexpected shapes (n_in %d, out %d, ws %zu < %zu)\n", n_in, out_size, ws_size, (size_t)WS_END); grid = -1; return; }
        int dev = 0, cus = 0, per_cu = 0;
        if (hipGetDevice(&dev) != hipSuccess || hipDeviceGetAttribute(&cus, hipDeviceAttributeMultiprocessorCount, dev) != hipSuccess) { grid = -1; return; }
        if (hipFuncSetAttribute((const void*)fwd_kernel, hipFuncAttributeMaxDynamicSharedMemorySize, LDS_BYTES) != hipSuccess) { fprintf(stderr, "kernel_launch: hipFuncSetAttribute failed\n"); grid = -1; return; }
        if (hipOccupancyMaxActiveBlocksPerMultiprocessor(&per_cu, (const void*)fwd_kernel, NTHREADS, LDS_BYTES) != hipSuccess || per_cu < 1) { fprintf(stderr, "kernel_launch: occupancy query says %d\n", per_cu); }
        (void)hipGetLastError();
        grid = cus;
    }
    if (grid < 0) return;
    (void)hipMemsetAsync((char*)d_ws + WS_CTL, 0, CTL_BYTES, stream);
    Args a{};
    for (int i = 0; i < 18; ++i) a.in[i] = (const float*)d_in[i];
    a.out = (float*)d_out; a.ws = (unsigned char*)d_ws;
#if MK_ONE_LAUNCH
    a.s_lo = 0; a.s_hi = NSTEPS;
    hipLaunchKernelGGL(fwd_kernel, dim3(grid), dim3(NTHREADS), LDS_BYTES, stream, a);
#else
    for (int s = 0; s < NSTEPS; ++s) {
        a.s_lo = s; a.s_hi = s + 1;
        hipLaunchKernelGGL(fwd_kernel, dim3(grid), dim3(NTHREADS), LDS_BYTES, stream, a);
    }
#endif
}
```

```cpp
#include <hip/hip_runtime.h>
#include <cstdio>
#include <cstdint>

#ifndef MK_ONE_LAUNCH
#define MK_ONE_LAUNCH 1
#endif

#define DI __device__ __forceinline__
#define LAS __attribute__((address_space(3)))
#define GAS __attribute__((address_space(1)))
typedef unsigned short bf16;
typedef short bf16x8 __attribute__((ext_vector_type(8)));
typedef short s16x4 __attribute__((ext_vector_type(4)));
typedef float f32x4 __attribute__((ext_vector_type(4)));
typedef float f32x2 __attribute__((ext_vector_type(2)));
typedef unsigned u32x4 __attribute__((ext_vector_type(4)));
typedef unsigned u32x2 __attribute__((ext_vector_type(2)));

constexpr int NTOK = 8192, SEQ = 4096, DM = 2048, PROJ = 5392, PN = 5376, DEPTH = 4;
constexpr int C_SQ = 0, C_SK = 1024, C_SV = 1152, C_DQ = 1280, C_DK = 2304, C_DV = 3328, C_DZ = 4352, C_AB = 5376;
constexpr int NEXP = 16, DEXP = 512;
constexpr float ALPHA = 1.681792830507429f;
constexpr float LN_EPS = 1e-5f, RMS_EPS = 1e-6f;

constexpr size_t MiB = 1u << 20;
constexpr size_t WS_CTL = 0, CTL_BYTES = 1 * MiB;
constexpr size_t WS_COS = 1 * MiB, WS_SIN = 2 * MiB;
constexpr size_t WS_AB = 4 * MiB;
constexpr size_t WS_G = 4 * MiB + 512 * 1024, WS_BETA = WS_G + 256 * 1024;
constexpr size_t WS_WSEL = 5 * MiB, WS_LIST = 5 * MiB + 64 * 1024;
constexpr size_t WS_WIN = 8 * MiB, WS_WOUT = 50 * MiB, WS_WGU = 66 * MiB, WS_WD = 194 * MiB;
constexpr size_t WS_X = 258 * MiB, WS_XB = 322 * MiB, WS_PROJ = 354 * MiB, WS_Y = 438 * MiB, WS_X1 = 502 * MiB, WS_X1B = 566 * MiB;
constexpr size_t WS_CAT = 598 * MiB, WS_OBUF = 630 * MiB, WS_QKV = 662 * MiB, WS_SCAN = 710 * MiB, WS_HID = 798 * MiB, WS_O2 = 814 * MiB, WS_END = 878 * MiB;
constexpr int CW_BAR = 4096;
constexpr int CW_CNT = 64;
constexpr int CW_DONE = 32768;

DI unsigned f2bf(float f) { unsigned u = __builtin_bit_cast(unsigned, f); return (u + 0x7fffu + ((u >> 16) & 1u)) >> 16; }
typedef __bf16 bf16n2 __attribute__((ext_vector_type(2)));
DI unsigned pk2(float lo, float hi) { return __builtin_bit_cast(unsigned, __builtin_convertvector((f32x2){lo, hi}, bf16n2)); }
DI unsigned pk2n(float lo, float hi) { return __builtin_bit_cast(unsigned, __builtin_convertvector((f32x2){lo, hi}, bf16n2)); }
DI float bflo(unsigned w) { return __builtin_bit_cast(float, w << 16); }
DI float bfhi(unsigned w) { return __builtin_bit_cast(float, w & 0xffff0000u); }
#define swz_xor(v, pat) __builtin_bit_cast(float, __builtin_amdgcn_ds_swizzle(__builtin_bit_cast(int, (float)(v)), (pat)))
#define SWZ_X1 0x041F
#define SWZ_X2 0x081F
#define SWZ_X4 0x101F
#define SWZ_X8 0x201F
#define SWZ_X16 0x401F
DI float xor32_sum(float v) { const unsigned u = __builtin_bit_cast(unsigned, v); const auto r = __builtin_amdgcn_permlane32_swap(u, u, false, false); return __builtin_bit_cast(float, (unsigned)r[0]) + __builtin_bit_cast(float, (unsigned)r[1]); }
DI float xor32_max(float v) { const unsigned u = __builtin_bit_cast(unsigned, v); const auto r = __builtin_amdgcn_permlane32_swap(u, u, false, false); return fmaxf(__builtin_bit_cast(float, (unsigned)r[0]), __builtin_bit_cast(float, (unsigned)r[1])); }
DI float wave_sum(float v) {
    v += swz_xor(v, SWZ_X1); v += swz_xor(v, SWZ_X2); v += swz_xor(v, SWZ_X4); v += swz_xor(v, SWZ_X8); v += swz_xor(v, SWZ_X16);
    return xor32_sum(v);
}
DI float sigmoidf_(float x) { return __builtin_amdgcn_rcpf(1.0f + __expf(-x)); }
DI float siluf_(float x) { return x * __builtin_amdgcn_rcpf(1.0f + __expf(-x)); }
#define LDS_WAIT() asm volatile("s_waitcnt lgkmcnt(0)" ::: "memory")

typedef short s16x4 __attribute__((ext_vector_type(4)));
#define XB_TMO      128
#define XB_XCNT(j)  (256  + 64 * (j))
#define XB_XSUB(j)  (1280 + 64 * (j))
#define XB_XGEN(j)  (2304 + 64 * (j))
#define XB_TOP      3328
#define XB_TOPGEN   3392
#define XCD_BAR_WORDS 3456
#define XB_SPIN_CAP (1u << 18)
__device__ __forceinline__ unsigned xb_ld(unsigned* p)              { return __hip_atomic_load(p, __ATOMIC_RELAXED, __HIP_MEMORY_SCOPE_AGENT); }
__device__ __forceinline__ unsigned xb_add(unsigned* p, unsigned v) { return __hip_atomic_fetch_add(p, v, __ATOMIC_RELAXED, __HIP_MEMORY_SCOPE_AGENT); }
__device__ __forceinline__ unsigned xb_xcc_id() { return (unsigned)__builtin_amdgcn_s_getreg((3 << 11) | 20) & 0xFu; }
#define XB_SPIN(cond, bar) do { unsigned _sp = 0; while (cond) { __builtin_amdgcn_s_sleep(1); \
    if ((++_sp & 255u) == 0u) { if (xb_ld(&(bar)[XB_TMO])) break; if (_sp > XB_SPIN_CAP) { atomicAdd(&(bar)[XB_TMO], 1u); break; } } } } while (0)
struct XcdBarrier { unsigned* bar; unsigned x; volatile LAS unsigned* st; };
__device__ __forceinline__ XcdBarrier xcd_barrier_post(unsigned* bar, volatile LAS unsigned* st) {
    XcdBarrier b; b.bar = bar; b.x = xb_xcc_id(); b.st = st;
    if (threadIdx.x == 0) (void)xb_add(&bar[XB_XCNT(b.x)], 1u);
    return b;
}
__device__ __forceinline__ void xcd_barrier_complete(unsigned* bar, unsigned x, unsigned& nloc, unsigned& nx) {
    const unsigned G = gridDim.x * gridDim.y * gridDim.z;
    unsigned sum, cnt, mine, sp = 0u;
    for (;;) {
        sum = 0u; cnt = 0u; mine = 0u;
#pragma unroll
        for (unsigned j = 0; j < 16; ++j) { const unsigned c = xb_ld(&bar[XB_XCNT(j)]); sum += c; cnt += (c > 0u) ? 1u : 0u; mine = (j == x) ? c : mine; }
        if (sum == G) break;
        __builtin_amdgcn_s_sleep(1);
        if ((++sp & 255u) == 0u) { if (xb_ld(&bar[XB_TMO])) break; if (sp > XB_SPIN_CAP) { atomicAdd(&bar[XB_TMO], 1u); break; } }
    }
    nloc = mine > 0u ? mine : 1u; nx = cnt > 0u ? cnt : 1u;
}
__device__ __forceinline__ void xcd_barrier(const XcdBarrier& b) {
    asm volatile("s_waitcnt vmcnt(0)" ::: "memory");
    __syncthreads();
    if (threadIdx.x == 0) {
        unsigned* bar = b.bar;
        __builtin_amdgcn_s_waitcnt(0);
        asm volatile("buffer_inv sc1" ::: "memory");
        unsigned nloc = b.st[0], nx = b.st[1];
        if (nloc == 0u) { xcd_barrier_complete(bar, b.x, nloc, nx); b.st[0] = nloc; b.st[1] = nx; }
        const unsigned old = xb_add(&bar[XB_XSUB(b.x)], 1u);
        const unsigned gen = old / nloc;
        if (old + 1u == (gen + 1u) * nloc) {
            __builtin_amdgcn_fence(__ATOMIC_RELEASE, "agent");
            asm volatile("s_waitcnt vmcnt(0)" ::: "memory");
            const unsigned og = xb_add(&bar[XB_TOP], 1u);
            const unsigned tg = og / nx;
            if (og + 1u == (tg + 1u) * nx) xb_add(&bar[XB_TOPGEN], 1u);
            else XB_SPIN(xb_ld(&bar[XB_TOPGEN]) == tg, bar);
            xb_add(&bar[XB_XGEN(b.x)], 1u);
            asm volatile("s_waitcnt vmcnt(0)" ::: "memory");
        } else {
            XB_SPIN(xb_ld(&bar[XB_XGEN(b.x)]) == gen, bar);
            asm volatile("s_waitcnt vmcnt(0)" ::: "memory");
        }
    }
    __syncthreads();
}

namespace g8 {
constexpr int BM = 256, BK = 64, HALF = 128, HTB = HALF * BK * 2, STAGE_BYTES = 8 * HTB, NXCD = 8, WGM = 8;
DI int lds_byte(int r, int c) { const int st = (r >> 4) * 2 + (c >> 5), rr = r & 15, cc = c & 31, ob = rr * 64 + cc * 2; return st * 1024 + (ob ^ (((ob >> 9) & 1) << 5)); }
DI void stage_rc(int b, int& R, int& C) { const int st = b / 1024, sb = b % 1024, swz = sb ^ (((sb >> 9) & 1) << 5); R = (st >> 1) * 16 + swz / 64; C = (st & 1) * 32 + (swz % 64) / 2; }
DI int perm32(int rho) { const int n = rho >> 4, i = rho & 15; return 8 * (i >> 2) + 4 * n + (i & 3); }

struct Unit { const char* B; int m0, n0, rows, e; };

template <int M_, int N_, int K_> struct DenseSched {
    static constexpr bool GATHER = false;
    static constexpr int nM = M_ / BM, nN = N_ / BM, nwg = nM * nN, K = K_;
    int G, c; const char* Bt;
    DI void init(const void* Bt_, int G_, int c_) { G = G_; c = c_; Bt = (const char*)Bt_; }
    DI bool next(int i, Unit& u) const {
        const int L = i * G + c; if (L >= nwg) return false;
        int wgid = L; { constexpr int q = nwg / NXCD, r = nwg % NXCD; const int xcd = wgid % NXCD, off = wgid / NXCD; wgid = (xcd < r ? xcd * (q + 1) : r * (q + 1) + (xcd - r) * q) + off; }
        constexpr int nig = WGM * nN; const int gid = wgid / nig, fm = gid * WGM, gsz = (nM - fm) < WGM ? (nM - fm) : WGM;
        const int pm = fm + ((wgid % nig) % gsz), pn = (wgid % nig) / gsz;
        u.m0 = pm * BM; u.n0 = pn * BM; u.rows = BM; u.e = 0; u.B = Bt + (size_t)pn * BM * K * 2; return true;
    }
    DI unsigned arow(const Unit& u, int r) const { return (unsigned)(u.m0 + r); }
};
DI unsigned cvt_pk_bf16(float lo, float hi) { unsigned r; asm volatile("v_cvt_pk_bf16_f32 %0, %1, %2" : "=v"(r) : "v"(lo), "v"(hi)); return r; }

struct EpiBf16 {
    static constexpr bool PERM = true;
    bf16* O; int ldc;
    DI void operator()(const f32x4 (&acc)[2][2][4][2], const Unit& u, int wr, int wc, int fr, int fq) const {
        const int row0 = u.m0 + wr * 64 + fr, col0 = u.n0 + wc * 32 + 8 * fq;
#pragma unroll
        for (int ai = 0; ai < 2; ++ai)
#pragma unroll
            for (int m = 0; m < 4; ++m) { bf16* rowp = O + (size_t)(row0 + ai * HALF + m * 16) * ldc + col0;
#pragma unroll
                for (int bj = 0; bj < 2; ++bj) { const f32x4 v0 = acc[ai][bj][m][0], v1 = acc[ai][bj][m][1];
                    u32x4 w; w.x = cvt_pk_bf16(v0[0], v0[1]); w.y = cvt_pk_bf16(v0[2], v0[3]); w.z = cvt_pk_bf16(v1[0], v1[1]); w.w = cvt_pk_bf16(v1[2], v1[3]);
                    *(u32x4*)(rowp + bj * HALF) = w; } }
    }
};
struct EpiResid {
    static constexpr bool PERM = false;
    const bf16* X; bf16* Y;
    DI void operator()(const f32x4 (&acc)[2][2][4][2], const Unit& u, int wr, int wc, int fr, int fq) const {
        const int row0 = u.m0 + wr * 64 + fr, col0 = u.n0 + wc * 32 + 4 * fq;
#pragma unroll
        for (int ai = 0; ai < 2; ++ai) {
            u32x2 xr[4][2][2];
#pragma unroll
            for (int m = 0; m < 4; ++m) { const size_t off = (size_t)(row0 + ai * HALF + m * 16) * DM + col0;
#pragma unroll
                for (int bj = 0; bj < 2; ++bj)
#pragma unroll
                    for (int n = 0; n < 2; ++n) xr[m][bj][n] = *(const GAS u32x2*)(X + off + bj * HALF + n * 16); }
            __builtin_amdgcn_sched_barrier(0);
#pragma unroll
            for (int m = 0; m < 4; ++m) { const size_t off = (size_t)(row0 + ai * HALF + m * 16) * DM + col0;
#pragma unroll
                for (int bj = 0; bj < 2; ++bj)
#pragma unroll
                    for (int n = 0; n < 2; ++n) { const u32x2 x = xr[m][bj][n]; const f32x4 a = acc[ai][bj][m][n];
                        u32x2 o; o.x = cvt_pk_bf16(bflo(x.x) * ALPHA + a[0], bfhi(x.x) * ALPHA + a[1]); o.y = cvt_pk_bf16(bflo(x.y) * ALPHA + a[2], bfhi(x.y) * ALPHA + a[3]);
                        *(GAS u32x2*)(Y + off + bj * HALF + n * 16) = o; } }
        }
    }
};
template <class Epi, class Sched>
DI void gemm_phase(LAS unsigned char* lds, const int wave_id, const char* Abase, const int K, const Sched& S, const Epi& E) {
    int z_ = 0; asm volatile("" : "+v"(z_));
    const int lane = __builtin_amdgcn_mbcnt_hi(-1, __builtin_amdgcn_mbcnt_lo(-1, z_)), wid = wave_id, tid = wid * 64 + lane, wr = wid >> 2, wc = wid & 3, fr = lane & 15, fq = lane >> 4;
    const int nt = K / BK;
    constexpr bool GATHER = Sched::GATHER;
    int Rr[2]; unsigned C2[2], voffB[2], voffA[2];
#pragma unroll
    for (int i = 0; i < 2; ++i) { int R, C; stage_rc(tid * 16 + i * 8192, R, C); const int Rb = Epi::PERM ? ((R & ~31) + perm32(R & 31)) : R;
        Rr[i] = R; C2[i] = (unsigned)C * 2u; voffB[i] = (unsigned)(Rb * K + C) * 2u; voffA[i] = (unsigned)(R * K + C) * 2u; }
    const size_t kstep = (size_t)(BK * 2);
    const size_t hstepB = (size_t)HALF * K * 2;
    const size_t tstepA = (size_t)K * 2;
    const unsigned ldsw = (unsigned)wid * 1024u;
    const int aoff = lds_byte(wr * 64 + fr, fq * 8), boff = lds_byte(wc * 32 + fr, fq * 8);
#define G8_SA(b, h) (((b) * 2 + (h)) * HTB)
#define G8_SB(b, h) ((4 + (b) * 2 + (h)) * HTB)
#define G8_STAGE(bufoff, gbase, voff) do { _Pragma("unroll") for (int _i = 0; _i < 2; ++_i) \
        __builtin_amdgcn_global_load_lds((const unsigned*)((const char*)(gbase) + (voff)[_i]), (LAS unsigned*)(lds + (bufoff) + ldsw + _i * 8192), 16, 0, 0); } while (0)
#define G8_LDA(dst, b, h) do { _Pragma("unroll") for (int m = 0; m < 4; ++m) _Pragma("unroll") for (int k = 0; k < 2; ++k) dst[m][k] = *(const LAS bf16x8*)(lds + G8_SA(b, h) + aoff + m * 2048 + k * 1024); } while (0)
#define G8_LDB(dst, b, h) do { _Pragma("unroll") for (int n = 0; n < 2; ++n) _Pragma("unroll") for (int k = 0; k < 2; ++k) dst[n][k] = *(const LAS bf16x8*)(lds + G8_SB(b, h) + boff + n * 2048 + k * 1024); } while (0)
#define G8_MMA(ai, bj, At, Bt) do { __builtin_amdgcn_s_setprio(1); _Pragma("unroll") for (int m = 0; m < 4; ++m) _Pragma("unroll") for (int n = 0; n < 2; ++n) _Pragma("unroll") for (int k = 0; k < 2; ++k) \
        acc[ai][bj][m][n] = __builtin_amdgcn_mfma_f32_16x16x32_bf16(Bt[n][k], At[m][k], acc[ai][bj][m][n], 0, 0, 0); __builtin_amdgcn_s_setprio(0); } while (0)
#define G8_WAIT_V(n) asm volatile("s_waitcnt vmcnt(" #n ")" ::: "memory")
#define G8_WAIT_L(n) asm volatile("s_waitcnt lgkmcnt(" #n ")" ::: "memory")
#define G8_BAR __builtin_amdgcn_s_barrier()
#define G8_SCHED __builtin_amdgcn_sched_barrier(0)
    Unit cur, nxt; int ui = 0;
    if (!S.next(0, cur)) return;
    f32x4 acc[2][2][4][2];
#pragma unroll
    for (int a = 0; a < 2; ++a)
#pragma unroll
        for (int b = 0; b < 2; ++b)
#pragma unroll
            for (int m = 0; m < 4; ++m)
#pragma unroll
                for (int n = 0; n < 2; ++n) acc[a][b][m][n] = (f32x4){0.f, 0.f, 0.f, 0.f};
    bf16x8 At[4][2], B0[2][2], B1[2][2];
    unsigned vAc[2][2], vAn[2][2];
    const char* cA0 = Abase; const char* cA1 = Abase;
    if constexpr (GATHER) {
#pragma unroll
        for (int h = 0; h < 2; ++h)
#pragma unroll
            for (int i = 0; i < 2; ++i) vAc[h][i] = S.arow(cur, h * HALF + Rr[i]) * (unsigned)(K * 2) + C2[i];
    } else {
        cA0 = Abase + (size_t)cur.m0 * tstepA; cA1 = cA0 + (size_t)HALF * tstepA;
#pragma unroll
        for (int h = 0; h < 2; ++h)
#pragma unroll
            for (int i = 0; i < 2; ++i) vAc[h][i] = voffA[i];
    }
    const char* cB = cur.B;
    G8_STAGE(G8_SB(0, 0), cB, voffB); G8_STAGE(G8_SB(0, 1), cB + hstepB, voffB); G8_STAGE(G8_SA(0, 0), cA0, vAc[0]); G8_STAGE(G8_SA(0, 1), cA1, vAc[1]);
    if (wr == 1) G8_BAR;
    G8_WAIT_V(2); G8_BAR;
    G8_STAGE(G8_SB(1, 0), cB + kstep, voffB); G8_STAGE(G8_SA(1, 0), cA0 + kstep, vAc[0]); G8_STAGE(G8_SB(1, 1), cB + hstepB + kstep, voffB);
    G8_WAIT_V(6); G8_BAR;
    for (;;) {
        const bool has_next = S.next(ui + 1, nxt);
        const char* nB = has_next ? nxt.B : cB;
        const char* nA0 = cA0; const char* nA1 = cA1;
        if constexpr (GATHER) {
#pragma unroll
            for (int h = 0; h < 2; ++h)
#pragma unroll
                for (int i = 0; i < 2; ++i) vAn[h][i] = has_next ? (S.arow(nxt, h * HALF + Rr[i]) * (unsigned)(K * 2) + C2[i]) : vAc[h][i];
        } else {
            if (has_next) { nA0 = Abase + (size_t)nxt.m0 * tstepA; nA1 = nA0 + (size_t)HALF * tstepA; }
        }
        for (int t = 0; t < nt; t += 2) {
            const bool last = (t == nt - 2);
            const char* a1h1 = cA1 + (size_t)(t + 1) * kstep;
            const char* a2h0 = last ? nA0 : cA0 + (size_t)(t + 2) * kstep; const char* a2h1 = last ? nA1 : cA1 + (size_t)(t + 2) * kstep;
            const char* b2 = last ? nB : cB + (size_t)(t + 2) * kstep;
            const char* a3h0 = a2h0 + kstep; const char* b3 = b2 + kstep;
            unsigned va2[2][2];
#pragma unroll
            for (int h = 0; h < 2; ++h)
#pragma unroll
                for (int i = 0; i < 2; ++i) va2[h][i] = (GATHER && last) ? vAn[h][i] : vAc[h][i];
            G8_LDB(B0, 0, 0); G8_LDB(B1, 0, 1); G8_SCHED; G8_LDA(At, 0, 0); G8_STAGE(G8_SA(1, 1), a1h1, vAc[1]);
            G8_WAIT_V(8); G8_WAIT_L(0); G8_BAR; G8_MMA(0, 0, At, B0); G8_MMA(0, 1, At, B1); G8_BAR; G8_SCHED;
            G8_LDA(At, 0, 1); G8_STAGE(G8_SB(0, 0), b2, voffB); G8_STAGE(G8_SB(0, 1), b2 + hstepB, voffB); G8_STAGE(G8_SA(0, 0), a2h0, va2[0]);
            G8_WAIT_V(8); G8_WAIT_L(0); G8_BAR; G8_MMA(1, 0, At, B0); G8_MMA(1, 1, At, B1); G8_BAR; G8_SCHED;
            G8_LDB(B0, 1, 0); G8_LDB(B1, 1, 1); G8_SCHED; G8_LDA(At, 1, 0); G8_STAGE(G8_SA(0, 1), a2h1, va2[1]);
            G8_WAIT_V(8); G8_WAIT_L(0); G8_BAR; G8_MMA(0, 0, At, B0); G8_MMA(0, 1, At, B1); G8_BAR; G8_SCHED;
            G8_LDA(At, 1, 1); G8_STAGE(G8_SB(1, 0), b3, voffB); G8_STAGE(G8_SB(1, 1), b3 + hstepB, voffB); G8_STAGE(G8_SA(1, 0), a3h0, va2[0]);
            G8_WAIT_V(8); G8_WAIT_L(0); G8_BAR; G8_MMA(1, 0, At, B0); G8_MMA(1, 1, At, B1); G8_BAR; G8_SCHED;
        }
        if (wr == 0) G8_BAR;
        E(acc, cur, wr, wc, fr, fq);
        if (!has_next) break;
#pragma unroll
        for (int a = 0; a < 2; ++a)
#pragma unroll
            for (int b = 0; b < 2; ++b)
#pragma unroll
                for (int m = 0; m < 4; ++m)
#pragma unroll
                    for (int n = 0; n < 2; ++n) acc[a][b][m][n] = (f32x4){0.f, 0.f, 0.f, 0.f};
        cur = nxt; cB = nB; cA0 = nA0; cA1 = nA1; ++ui;
        if (wr == 1) G8_BAR;
        if constexpr (GATHER) {
#pragma unroll
            for (int h = 0; h < 2; ++h)
#pragma unroll
                for (int i = 0; i < 2; ++i) vAc[h][i] = vAn[h][i];
        }
    }
    G8_WAIT_V(0);
    G8_BAR;
#undef G8_SA
#undef G8_SB
#undef G8_STAGE
#undef G8_LDA
#undef G8_LDB
#undef G8_MMA
#undef G8_WAIT_V
#undef G8_WAIT_L
#undef G8_BAR
#undef G8_SCHED
}

struct MUnit { const char* B; int m0, n0, rows, e, kind, mt; };
struct MoeUni {
    const LAS int* tab; const int* list; const char* Wgu; const char* Wd; int G, c, MT;
    DI bool next(int i, MUnit& u) const {
        const int nA = 4 * MT, nB = 8 * MT, x = nA > G ? nA - G : 0;
        const int mineA = (c < nA ? 1 : 0) + (c + G < nA ? 1 : 0);
        int kind, L;
        if (i < mineA) { kind = 0; L = c + i * G; }
        else { const int k = i - mineA;
            if (x > 0) { if (c < x) return false; L = (c - x) + k * (G - x); } else L = c + k * G;
            if (L >= nB) return false; kind = 1; }
        const int NB = kind ? 8 : 4, mt = L / NB, nb = L - mt * NB, nfull = tab[16];
        int e, ti;
        if (mt < nfull) { e = 0;
#pragma unroll
            for (int j = 1; j < 16; ++j) e += (tab[j] <= mt) ? 1 : 0;
            ti = mt - tab[e]; }
        else { e = tab[34 + (mt - nfull)]; ti = tab[17 + e] >> 8; }
        const int cnt = tab[17 + e];
        u.e = e; u.m0 = e * NTOK + ti * BM; u.rows = (cnt - ti * BM) < BM ? (cnt - ti * BM) : BM; u.n0 = nb * BM; u.kind = kind; u.mt = mt;
        u.B = kind ? (Wd + (size_t)e * ((size_t)DM * DEXP * 2) + (size_t)nb * BM * DEXP * 2) : (Wgu + (size_t)e * ((size_t)1024 * DM * 2) + (size_t)nb * BM * DM * 2);
        return true;
    }
    DI unsigned arow(const MUnit& u, int r) const { const int rr = r < u.rows ? r : 0; const unsigned en = (unsigned)list[u.m0 + rr]; return u.kind ? en : (en & (NTOK - 1)); }
};
DI void st16_sc1(void* p, u32x4 v) { asm volatile("global_store_dwordx4 %0, %1, off sc1\n\ts_nop 1" :: "v"((GAS void*)p), "v"(v) : "memory"); }

DI void gemm_moe_phase(LAS unsigned char* lds, const int wave_id, const char* A0  , const char* A1  , const MoeUni& S,
                       bf16* H, const float* wsel, bf16* O2, unsigned* done  , unsigned* tmo) {
    int z_ = 0; asm volatile("" : "+v"(z_));
    const int lane = __builtin_amdgcn_mbcnt_hi(-1, __builtin_amdgcn_mbcnt_lo(-1, z_)), wid = wave_id, tid = wid * 64 + lane, wr = wid >> 2, wc = wid & 3, fr = lane & 15, fq = lane >> 4;
    LAS int* ent = (LAS int*)(lds + STAGE_BYTES); LAS float* wsl = (LAS float*)(lds + STAGE_BYTES + 3 * 1024);
#define MOE_FETCH(u, slot) do { if (tid < 256) { const int e_ = S.list[(u).m0 + (tid < (u).rows ? tid : 0)]; float w_ = 0.f; if ((u).kind == 0) w_ = wsel[e_]; \
            ent[(slot) * 256 + tid] = e_; wsl[(slot) * 256 + tid] = w_; } } while (0)
#define MOE_OFFS(u, slot, vA, vB) do { int tz_ = tid; asm volatile("" : "+v"(tz_)); const int Kk_ = (u).kind ? DEXP : DM; \
        _Pragma("unroll") for (int i = 0; i < 2; ++i) { int R_, C_; stage_rc(tz_ * 16 + i * 8192, R_, C_); const int Rb_ = (R_ & ~31) + perm32(R_ & 31); \
            vB[i] = (unsigned)(Rb_ * Kk_ + C_) * 2u; \
            _Pragma("unroll") for (int h = 0; h < 2; ++h) { const unsigned en_ = (unsigned)ent[(slot) * 256 + h * HALF + R_]; \
                vA[h][i] = ((u).kind ? en_ : (en_ & (NTOK - 1))) * (unsigned)(Kk_ * 2) + (unsigned)C_ * 2u; } } } while (0)
    const size_t kstep = (size_t)(BK * 2);
    const unsigned ldsw = (unsigned)wid * 1024u;
    const int aoff = lds_byte(wr * 64 + fr, fq * 8), boff = lds_byte(wc * 32 + fr, fq * 8);
#define G8_SA(b, h) (((b) * 2 + (h)) * HTB)
#define G8_SB(b, h) ((4 + (b) * 2 + (h)) * HTB)
#define G8_STAGE(bufoff, gbase, voff) do { _Pragma("unroll") for (int _i = 0; _i < 2; ++_i) \
        __builtin_amdgcn_global_load_lds((const unsigned*)((const char*)(gbase) + (voff)[_i]), (LAS unsigned*)(lds + (bufoff) + ldsw + _i * 8192), 16, 0, 0); } while (0)
#define G8_LDA(dst, b, h) do { _Pragma("unroll") for (int m = 0; m < 4; ++m) _Pragma("unroll") for (int k = 0; k < 2; ++k) dst[m][k] = *(const LAS bf16x8*)(lds + G8_SA(b, h) + aoff + m * 2048 + k * 1024); } while (0)
#define G8_LDB(dst, b, h) do { _Pragma("unroll") for (int n = 0; n < 2; ++n) _Pragma("unroll") for (int k = 0; k < 2; ++k) dst[n][k] = *(const LAS bf16x8*)(lds + G8_SB(b, h) + boff + n * 2048 + k * 1024); } while (0)
#define G8_MMA(ai, bj, At, Bt) do { __builtin_amdgcn_s_setprio(1); _Pragma("unroll") for (int m = 0; m < 4; ++m) _Pragma("unroll") for (int n = 0; n < 2; ++n) _Pragma("unroll") for (int k = 0; k < 2; ++k) \
        acc[ai][bj][m][n] = __builtin_amdgcn_mfma_f32_16x16x32_bf16(Bt[n][k], At[m][k], acc[ai][bj][m][n], 0, 0, 0); __builtin_amdgcn_s_setprio(0); } while (0)
#define G8_WAIT_V(n) asm volatile("s_waitcnt vmcnt(" #n ")" ::: "memory")
#define G8_WAIT_L(n) asm volatile("s_waitcnt lgkmcnt(" #n ")" ::: "memory")
#define G8_BAR __builtin_amdgcn_s_barrier()
#define G8_SCHED __builtin_amdgcn_sched_barrier(0)
#define MOE_A_READY(u) do { if ((u).kind) { \
        if (wid == 0 && !ackd) { unsigned sp_ = 0u; \
            while ((unsigned)__builtin_amdgcn_readfirstlane(__hip_atomic_load(done + 16 * (u).mt, __ATOMIC_RELAXED, __HIP_MEMORY_SCOPE_AGENT)) < 32u) { \
                __builtin_amdgcn_s_sleep(2); if (++sp_ > (1u << 20)) { if (lane == 0) __hip_atomic_store(tmo, 1u, __ATOMIC_RELAXED, __HIP_MEMORY_SCOPE_AGENT); break; } } \
            __builtin_amdgcn_fence(__ATOMIC_ACQUIRE, "agent"); asm volatile("s_waitcnt vmcnt(0)" ::: "memory"); } \
        asm volatile("" ::: "memory"); G8_BAR; asm volatile("" ::: "memory"); } } while (0)
    MUnit cur, nxt; int ui = 0; int ackd = 0;
    LAS unsigned* pollw = (LAS unsigned*)(lds + 143360);
    if (!S.next(0, cur)) return;
    f32x4 acc[2][2][4][2];
#pragma unroll
    for (int a = 0; a < 2; ++a)
#pragma unroll
        for (int b = 0; b < 2; ++b)
#pragma unroll
            for (int m = 0; m < 4; ++m)
#pragma unroll
                for (int n = 0; n < 2; ++n) acc[a][b][m][n] = (f32x4){0.f, 0.f, 0.f, 0.f};
    bf16x8 At[4][2], B0[2][2], B1[2][2];
    unsigned vAc[2][2], vAn[2][2], vBc[2], vBn[2];
    int slc = 0, sln = 0;
    MOE_FETCH(cur, 0);
    asm volatile("s_waitcnt lgkmcnt(0)" ::: "memory"); G8_BAR; asm volatile("" ::: "memory");
    MOE_A_READY(cur);
    MOE_OFFS(cur, 0, vAc, vBc);
    const char* cA = cur.kind ? A1 : A0; const char* cB = cur.B;
    size_t hsB = (size_t)HALF * (cur.kind ? DEXP : DM) * 2;
    G8_STAGE(G8_SB(0, 0), cB, vBc); G8_STAGE(G8_SB(0, 1), cB + hsB, vBc); G8_STAGE(G8_SA(0, 0), cA, vAc[0]); G8_STAGE(G8_SA(0, 1), cA, vAc[1]);
    if (wr == 1) G8_BAR;
    G8_WAIT_V(2); G8_BAR;
    G8_STAGE(G8_SB(1, 0), cB + kstep, vBc); G8_STAGE(G8_SA(1, 0), cA + kstep, vAc[0]); G8_STAGE(G8_SB(1, 1), cB + hsB + kstep, vBc);
    G8_WAIT_V(6); G8_BAR;
    for (;;) {
        const bool has_next = S.next(ui + 1, nxt);
        const char* nB = has_next ? nxt.B : cB; const char* nA = has_next ? (nxt.kind ? A1 : A0) : cA;
        const size_t hsBn = has_next ? (size_t)HALF * (nxt.kind ? DEXP : DM) * 2 : hsB;
        const bool fresh = has_next && !(nxt.kind == cur.kind && nxt.mt == cur.mt);
        sln = fresh ? (slc == 2 ? 0 : slc + 1) : slc;
        if (fresh && tid < 256)
            __builtin_amdgcn_global_load_lds((const unsigned*)(S.list + (nxt.m0 + (tid < nxt.rows ? tid : 0))), (LAS unsigned*)(ent + sln * 256 + wid * 64), 4, 0, 0);
#pragma unroll
        for (int i = 0; i < 2; ++i) { vBn[i] = vBc[i]; vAn[0][i] = vAc[0][i]; vAn[1][i] = vAc[1][i]; }
        const int nt = cur.kind ? (DEXP / BK) : (DM / BK);
        for (int t = 0; t < nt; t += 2) {
            const bool last = (t == nt - 2);
            if (t == 2 && fresh && nxt.kind == 0 && tid < 256)
                __builtin_amdgcn_global_load_lds((const unsigned*)(wsel + ent[sln * 256 + tid]), (LAS unsigned*)(wsl + sln * 256 + wid * 64), 4, 0, 0);
            if (fresh && nxt.kind && wid == 0) {
                if (t == nt - 6) __builtin_amdgcn_global_load_lds((const unsigned*)(done + 16 * nxt.mt), pollw, 4, 0, 16  );
                if (t == nt - 4) { if ((unsigned)__builtin_amdgcn_readfirstlane((int)pollw[0]) >= 32u) { asm volatile("buffer_inv sc1" ::: "memory"); ackd = 1; } }
            }
            if (last && fresh) { MOE_A_READY(nxt); MOE_OFFS(nxt, sln, vAn, vBn); ackd = 0; }
            const char* a1 = cA + (size_t)(t + 1) * kstep;
            const char* a2 = last ? nA : cA + (size_t)(t + 2) * kstep;
            const char* b2 = last ? nB : cB + (size_t)(t + 2) * kstep;
            const char* a3 = a2 + kstep; const char* b3 = b2 + kstep;
            const size_t hs2 = last ? hsBn : hsB;
            unsigned va2[2][2], vb2[2];
#pragma unroll
            for (int h = 0; h < 2; ++h)
#pragma unroll
                for (int i = 0; i < 2; ++i) va2[h][i] = last ? vAn[h][i] : vAc[h][i];
#pragma unroll
            for (int i = 0; i < 2; ++i) vb2[i] = last ? vBn[i] : vBc[i];
            G8_LDB(B0, 0, 0); G8_LDB(B1, 0, 1); G8_SCHED; G8_LDA(At, 0, 0); G8_STAGE(G8_SA(1, 1), a1, vAc[1]);
            G8_WAIT_V(8); G8_WAIT_L(0); G8_BAR; G8_MMA(0, 0, At, B0); G8_MMA(0, 1, At, B1); G8_BAR; G8_SCHED;
            G8_LDA(At, 0, 1); G8_STAGE(G8_SB(0, 0), b2, vb2); G8_STAGE(G8_SB(0, 1), b2 + hs2, vb2); G8_STAGE(G8_SA(0, 0), a2, va2[0]);
            G8_WAIT_V(8); G8_WAIT_L(0); G8_BAR; G8_MMA(1, 0, At, B0); G8_MMA(1, 1, At, B1); G8_BAR; G8_SCHED;
            G8_LDB(B0, 1, 0); G8_LDB(B1, 1, 1); G8_SCHED; G8_LDA(At, 1, 0); G8_STAGE(G8_SA(0, 1), a2, va2[1]);
            G8_WAIT_V(8); G8_WAIT_L(0); G8_BAR; G8_MMA(0, 0, At, B0); G8_MMA(0, 1, At, B1); G8_BAR; G8_SCHED;
            G8_LDA(At, 1, 1); G8_STAGE(G8_SB(1, 0), b3, vb2); G8_STAGE(G8_SB(1, 1), b3 + hs2, vb2); G8_STAGE(G8_SA(1, 0), a3, va2[0]);
            G8_WAIT_V(8); G8_WAIT_L(0); G8_BAR; G8_MMA(1, 0, At, B0); G8_MMA(1, 1, At, B1); G8_BAR; G8_SCHED;
        }
        if (wr == 0) G8_BAR;
        {
            int en[8];
#pragma unroll
            for (int ai = 0; ai < 2; ++ai)
#pragma unroll
                for (int m = 0; m < 4; ++m) { const int r = ai * HALF + wr * 64 + m * 16 + fr; en[ai * 4 + m] = (r < cur.rows) ? ent[slc * 256 + r] : -1; }
            if (cur.kind == 0) {
                float ws[8];
#pragma unroll
                for (int ai = 0; ai < 2; ++ai)
#pragma unroll
                    for (int m = 0; m < 4; ++m) ws[ai * 4 + m] = wsl[slc * 256 + ai * HALF + wr * 64 + m * 16 + fr];
                const int col0 = (cur.n0 >> 1) + wc * 32 + 8 * fq;
#pragma unroll
                for (int ai = 0; ai < 2; ++ai)
#pragma unroll
                    for (int m = 0; m < 4; ++m) { const int k = ai * 4 + m;
                        if (en[k] >= 0) { const float wv = ws[k];
                            const f32x4 g0 = acc[ai][0][m][0], g1 = acc[ai][0][m][1], u0 = acc[ai][1][m][0], u1 = acc[ai][1][m][1];
                            float hh[8];
#pragma unroll
                            for (int j = 0; j < 4; ++j) { hh[j] = siluf_(g0[j]) * u0[j] * wv; hh[4 + j] = siluf_(g1[j]) * u1[j] * wv; }
                            u32x4 w; w.x = cvt_pk_bf16(hh[0], hh[1]); w.y = cvt_pk_bf16(hh[2], hh[3]); w.z = cvt_pk_bf16(hh[4], hh[5]); w.w = cvt_pk_bf16(hh[6], hh[7]);
                            st16_sc1(H + (size_t)en[k] * DEXP + col0, w); } }
                asm volatile("s_waitcnt vmcnt(0)" ::: "memory");
                if (lane == 0) __hip_atomic_fetch_add(done + 16 * cur.mt, 1u, __ATOMIC_RELAXED, __HIP_MEMORY_SCOPE_AGENT);
            } else {
                const int col0 = cur.n0 + wc * 32 + 8 * fq;
#pragma unroll
                for (int ai = 0; ai < 2; ++ai)
#pragma unroll
                    for (int m = 0; m < 4; ++m) { const int k = ai * 4 + m;
                        if (en[k] >= 0) { bf16* rowp = O2 + (size_t)en[k] * DM + col0;
#pragma unroll
                            for (int bj = 0; bj < 2; ++bj) { const f32x4 v0 = acc[ai][bj][m][0], v1 = acc[ai][bj][m][1];
                                u32x4 w; w.x = cvt_pk_bf16(v0[0], v0[1]); w.y = cvt_pk_bf16(v0[2], v0[3]); w.z = cvt_pk_bf16(v1[0], v1[1]); w.w = cvt_pk_bf16(v1[2], v1[3]);
                                *(u32x4*)(rowp + bj * HALF) = w; } } }
            }
        }
        if (!has_next) break;
#pragma unroll
        for (int a = 0; a < 2; ++a)
#pragma unroll
            for (int b = 0; b < 2; ++b)
#pragma unroll
                for (int m = 0; m < 4; ++m)
#pragma unroll
                    for (int n = 0; n < 2; ++n) acc[a][b][m][n] = (f32x4){0.f, 0.f, 0.f, 0.f};
        cur = nxt; cB = nB; cA = nA; hsB = hsBn; slc = sln; ++ui;
        if (wr == 1) G8_BAR;
#pragma unroll
        for (int h = 0; h < 2; ++h)
#pragma unroll
            for (int i = 0; i < 2; ++i) vAc[h][i] = vAn[h][i];
#pragma unroll
        for (int i = 0; i < 2; ++i) vBc[i] = vBn[i];
    }
    G8_WAIT_V(0);
    G8_BAR;
#undef MOE_A_READY
#undef MOE_OFFS
#undef MOE_FETCH
#undef G8_SA
#undef G8_SB
#undef G8_STAGE
#undef G8_LDA
#undef G8_LDB
#undef G8_MMA
#undef G8_WAIT_V
#undef G8_WAIT_L
#undef G8_BAR
#undef G8_SCHED
}
}

constexpr int NWAVES = 8, NTHREADS = 512;
constexpr int RING_BYTES = 131072;
constexpr int LN_STRIDE = 2052;
constexpr int LN_TILE_BYTES = 16 * LN_STRIDE * 4;
constexpr int LN_PART_OFF = LN_TILE_BYTES, LN_LOGIT_OFF = LN_PART_OFF + 8192, LN_ROUTE_OFF = LN_LOGIT_OFF + 1024;
constexpr int LN_GB_OFF = 143360;
constexpr int LDS_BYTES = 163840;
constexpr int MOETAB_OFF = LDS_BYTES - 1024;
constexpr int MISC_OFF = LDS_BYTES - 512;
static_assert(LN_ROUTE_OFF + 2048 <= MOETAB_OFF && MISC_OFF + 16 <= LDS_BYTES, "LDS map");

struct Frame {
    LAS unsigned char* lds;
    int tid, lane, wave, G, bid;
    GAS unsigned char* ws;
    const float* const* in;
    GAS float* out;
};
#define FIN(k) ((const float*)(const GAS float*)F.in[k])
enum { I_X = 0, I_POS, I_WIN, I_SINK, I_CONVW, I_ALOG, I_DTB, I_DNW, I_WOUT, I_LN1G, I_LN1B, I_RW, I_RB, I_WG, I_WU, I_WDN, I_LN2G, I_LN2B };

DI void transpose_item(const float* W, int ldw, bf16* WT, int ldt, int k0, int n0, int drow0, LAS float* scr, int lane) {
    float tv[32];
    const GAS float* wp = (const GAS float*)W + (size_t)(k0 + (lane >> 5)) * ldw + n0 + (lane & 31);
#pragma unroll
    for (int i = 0; i < 32; ++i) tv[i] = __builtin_nontemporal_load(wp + (size_t)(2 * i) * ldw);
    __builtin_amdgcn_sched_barrier(0);
#pragma unroll
    for (int i = 0; i < 32; ++i) { const int kk = 2 * i + (lane >> 5); scr[kk * 33 + (lane & 31)] = tv[i]; }
    LDS_WAIT(); asm volatile("" ::: "memory");
    const int c = lane & 7;
#pragma unroll
    for (int j = 0; j < 4; ++j) { const int n = (lane >> 3) + 8 * j; const LAS float* s = scr + (8 * c) * 33 + n;
        u32x4 o; o.x = pk2(s[0 * 33], s[1 * 33]); o.y = pk2(s[2 * 33], s[3 * 33]); o.z = pk2(s[4 * 33], s[5 * 33]); o.w = pk2(s[6 * 33], s[7 * 33]);
        __builtin_nontemporal_store(o, (GAS u32x4*)(WT + (size_t)(drow0 + n) * ldt + k0 + 8 * c)); }
    LDS_WAIT(); asm volatile("" ::: "memory");
}
constexpr int IP_ATT_UNITS = (NTOK / 256) * (C_DQ / 256);
constexpr int CONV_HELPERS = 224, CONV_SPLIT = 32000;
constexpr int CONV_ITEMS = 32 * 168 + 32 * 64 + NEXP * (2 * 32 * 16 + 8 * 64), CONV_I_IN = 32 * 168;
DI void convw_phase(Frame& F, int l, int slot, int wg_lo, int wg_n, int it_lo, int it_hi) {
    LAS float* scr = (LAS float*)(F.lds + F.wave * 16384);
    const int gw = (F.bid - wg_lo) * NWAVES + F.wave, NGW = wg_n * NWAVES;
    bf16* win_t = (bf16*)(F.ws + WS_WIN) + (size_t)slot * PN * DM;
    bf16* wout_t = (bf16*)(F.ws + WS_WOUT) + (size_t)slot * DM * DM;
    bf16* wgu_t = (bf16*)(F.ws + WS_WGU) + (size_t)slot * NEXP * 1024 * DM;
    bf16* wd_t = (bf16*)(F.ws + WS_WD) + (size_t)slot * NEXP * DM * DEXP;
    const float* w_in = FIN(I_WIN) + (size_t)l * DM * PROJ;
    const float* w_out = FIN(I_WOUT) + (size_t)l * DM * DM;
    const float* w_g = FIN(I_WG) + (size_t)l * NEXP * DM * DEXP;
    const float* w_u = FIN(I_WU) + (size_t)l * NEXP * DM * DEXP;
    const float* w_d = FIN(I_WDN) + (size_t)l * NEXP * DEXP * DM;
    constexpr int I_IN = 32 * 168, I_OUT = 32 * 64, I_GU = 32 * 16, I_D = 8 * 64, I_E = 2 * I_GU + I_D;
    static_assert(CONV_ITEMS == I_IN + I_OUT + NEXP * I_E, "item count");
    for (int it = it_lo + gw; it < it_hi; it += NGW) {
        int r = it;
        if (r < I_IN) { const int kb = r / 168, nb = r % 168; transpose_item(w_in, PROJ, win_t, DM, kb * 64, nb * 32, nb * 32, scr, F.lane); continue; } r -= I_IN;
        if (r < I_OUT) { const int kb = r / 64, nb = r % 64; transpose_item(w_out, DM, wout_t, DM, kb * 64, nb * 32, nb * 32, scr, F.lane); continue; } r -= I_OUT;
        const int e = r / I_E; r -= e * I_E;
        if (r < 2 * I_GU) { const int up = r / I_GU; r -= up * I_GU; const int kb = r / 16, nb = r % 16, n0 = nb * 32;
            const int drow0 = (n0 >> 7) * 256 + up * 128 + (n0 & 127);
            transpose_item((up ? w_u : w_g) + (size_t)e * DM * DEXP, DEXP, wgu_t + (size_t)e * 1024 * DM, DM, kb * 64, n0, drow0, scr, F.lane); continue; }
        r -= 2 * I_GU;
        { const int kb = r / 64, nb = r % 64; transpose_item(w_d + (size_t)e * DEXP * DM, DM, wd_t + (size_t)e * DM * DEXP, DEXP, kb * 64, nb * 32, nb * 32, scr, F.lane); }
    }
}

DI void rope_phase(Frame& F) {
    float* cs = (float*)(F.ws + WS_COS); float* sn = (float*)(F.ws + WS_SIN);
    const int* pos = (const int*)FIN(I_POS);
    for (int i = F.bid * NTHREADS + F.tid; i < NTOK * 32; i += F.G * NTHREADS) {
        const int t = i >> 5, d = i & 31;
        const float inv = exp2f(-(float)d * (13.287712379549449f / 32.0f));
        const float ang = (float)pos[t] * inv;
        cs[i] = cosf(ang); sn[i] = sinf(ang);
    }
}

template <int MODE, bool SRCBF>
DI void ln_phase(Frame& F, const void* src, const bf16* o2, const float* gam, const float* bet, float* of32, bf16* obf, const float* W16, int ldw, bool do_logits,
                 float* ab, const float* rbias, unsigned* cnt, int* list, float* wsel) {
    LAS float* tile = (LAS float*)F.lds;
    LAS float* part = (LAS float*)(F.lds + LN_PART_OFF);
    LAS float* logit = (LAS float*)(F.lds + LN_LOGIT_OFF);
    LAS int* rt_e = (LAS int*)(F.lds + LN_ROUTE_OFF); LAS int* rt_tok = rt_e + 64; LAS float* rt_w = (LAS float*)(rt_e + 128); LAS unsigned* rt_h = (LAS unsigned*)(rt_e + 256); LAS unsigned* rt_b = rt_h + 16;
    int nrouted = 0;
    if (MODE == 1 && F.tid < 16) rt_h[F.tid] = 0u;
    const int lane = F.lane, w = F.wave;
    LAS f32x4* gbl = (LAS f32x4*)(F.lds + LN_GB_OFF);
    if (MODE != 0) { gbl[F.tid] = *((const GAS f32x4*)gam + F.tid); gbl[512 + F.tid] = *((const GAS f32x4*)bet + F.tid); }
    float wreg[64];
    if (do_logits) { const GAS float* wp = (const GAS float*)W16 + (size_t)(256 * w + 4 * (lane >> 4)) * ldw + (lane & 15);
#pragma unroll
        for (int s = 0; s < 16; ++s)
#pragma unroll
            for (int j = 0; j < 4; ++j) wreg[4 * s + j] = wp[(size_t)(16 * s + j) * ldw]; }
    else {
#pragma unroll
        for (int i = 0; i < 64; ++i) wreg[i] = 0.f; }
    f32x4 vn[8]; u32x2 rawn[8], avn[8], bvn[8];
#define LN_ISSUE(rowx) do { if (!SRCBF) { const GAS f32x4* sp_ = (const GAS f32x4*)((const float*)src + (size_t)(rowx) * DM) + lane; \
            _Pragma("unroll") for (int j = 0; j < 8; ++j) vn[j] = sp_[64 * j]; } \
        else { const GAS u32x2* sp_ = (const GAS u32x2*)((const bf16*)src + (size_t)(rowx) * DM) + lane; \
            _Pragma("unroll") for (int j = 0; j < 8; ++j) rawn[j] = sp_[64 * j]; } \
        if (MODE == 2) { const GAS u32x2* pa_ = (const GAS u32x2*)(o2 + (size_t)(rowx) * DM) + lane; const GAS u32x2* pb_ = (const GAS u32x2*)(o2 + (size_t)(NTOK + (rowx)) * DM) + lane; \
            _Pragma("unroll") for (int j = 0; j < 8; ++j) { avn[j] = pa_[64 * j]; bvn[j] = pb_[64 * j]; } } } while (0)
    if (F.bid < NTOK / 16) LN_ISSUE(F.bid * 16 + 2 * w);
    if (MODE != 0) __syncthreads();
    for (int unit = F.bid; unit < NTOK / 16; unit += F.G) {
        const int row0 = unit * 16;
#pragma unroll 1
        for (int rr = 0; rr < 2; ++rr) {
            const int rl = 2 * w + rr, row = row0 + rl;
            f32x4 v[8]; u32x2 av[8], bv[8];
#pragma unroll
            for (int j = 0; j < 8; ++j) {
                if (SRCBF) { u32x2 r = rawn[j]; asm volatile("" : "+v"(r)); v[j] = (f32x4){bflo(r.x), bfhi(r.x), bflo(r.y), bfhi(r.y)}; }
                else { v[j] = vn[j]; asm volatile("" : "+v"(v[j])); }
                if (MODE == 2) { av[j] = avn[j]; bv[j] = bvn[j]; asm volatile("" : "+v"(av[j]), "+v"(bv[j])); } }
            { const int nrow = (rr == 0) ? row + 1 : ((unit + F.G < NTOK / 16) ? (unit + F.G) * 16 + 2 * w : row);
              LN_ISSUE(nrow); }
            __builtin_amdgcn_sched_barrier(0);
            if (MODE == 2) {
#pragma unroll
                for (int j = 0; j < 8; ++j) { const u32x2 a = av[j], b = bv[j];
                    v[j].x = v[j].x * ALPHA + (bflo(a.x) + bflo(b.x)); v[j].y = v[j].y * ALPHA + (bfhi(a.x) + bfhi(b.x));
                    v[j].z = v[j].z * ALPHA + (bflo(a.y) + bflo(b.y)); v[j].w = v[j].w * ALPHA + (bfhi(a.y) + bfhi(b.y)); }
            }
            if (MODE != 0) {
                float s = 0.f;
#pragma unroll
                for (int j = 0; j < 8; ++j) s += (v[j].x + v[j].y) + (v[j].z + v[j].w);
                const float mean = wave_sum(s) * (1.0f / DM); float s2 = 0.f;
#pragma unroll
                for (int j = 0; j < 8; ++j) { v[j] = v[j] - mean; s2 += (v[j].x * v[j].x + v[j].y * v[j].y) + (v[j].z * v[j].z + v[j].w * v[j].w); }
                const float rstd = 1.0f / sqrtf(wave_sum(s2) * (1.0f / DM) + LN_EPS);
#pragma unroll
                for (int jh = 0; jh < 2; ++jh) { f32x4 g4[4], b4[4];
#pragma unroll
                    for (int j = 0; j < 4; ++j) { g4[j] = gbl[lane + 64 * (4 * jh + j)]; b4[j] = gbl[512 + lane + 64 * (4 * jh + j)]; }
                    __builtin_amdgcn_sched_barrier(0);
#pragma unroll
                    for (int j = 0; j < 4; ++j) v[4 * jh + j] = v[4 * jh + j] * rstd * g4[j] + b4[j]; }
            }
            else __builtin_amdgcn_sched_barrier(0);
            if (of32) { GAS f32x4* op = (GAS f32x4*)(of32 + (size_t)row * DM) + lane;
#pragma unroll
                for (int j = 0; j < 8; ++j) op[64 * j] = v[j]; }
            if (obf) { GAS u32x2* op = (GAS u32x2*)(obf + (size_t)row * DM) + lane;
#pragma unroll
                for (int j = 0; j < 8; ++j) { u32x2 o; o.x = pk2(v[j].x, v[j].y); o.y = pk2(v[j].z, v[j].w); op[64 * j] = o; } }
            if (do_logits) {
#pragma unroll
                for (int j = 0; j < 8; ++j) *(LAS f32x4*)(tile + rl * LN_STRIDE + 4 * lane + 256 * j) = v[j];
            }
        }
        if (do_logits) {
            __syncthreads();
            const int m = lane & 15, kq = lane >> 4;
            f32x4 acc = (f32x4){0.f, 0.f, 0.f, 0.f};
            const int kb = 256 * w;
#pragma unroll
            for (int s = 0; s < 16; ++s) {
                const int k = kb + 16 * s + 4 * kq;
                const f32x4 a4 = *(const LAS f32x4*)(tile + m * LN_STRIDE + k);
                acc = __builtin_amdgcn_mfma_f32_16x16x4f32(a4.x, wreg[4 * s + 0], acc, 0, 0, 0);
                acc = __builtin_amdgcn_mfma_f32_16x16x4f32(a4.y, wreg[4 * s + 1], acc, 0, 0, 0);
                acc = __builtin_amdgcn_mfma_f32_16x16x4f32(a4.z, wreg[4 * s + 2], acc, 0, 0, 0);
                acc = __builtin_amdgcn_mfma_f32_16x16x4f32(a4.w, wreg[4 * s + 3], acc, 0, 0, 0);
            }
#pragma unroll
            for (int r = 0; r < 4; ++r) part[(w * 16 + 4 * kq + r) * 16 + m] = acc[r];
            __syncthreads();
            if (F.tid < 256) {
                const int r = F.tid >> 4, n = F.tid & 15; float s = 0.f;
#pragma unroll
                for (int ww = 0; ww < 8; ++ww) s += part[(ww * 16 + r) * 16 + n];
                if (MODE == 1) logit[r * 16 + n] = s; else ab[(size_t)(row0 + r) * 16 + n] = s;
            }
            if (MODE == 1) {
                __syncthreads();
                if (F.tid < 16) {
                    const int tok = row0 + F.tid;
                    float sc[16], sel[16];
#pragma unroll
                    for (int e = 0; e < 16; ++e) { sc[e] = sigmoidf_(logit[F.tid * 16 + e]); sel[e] = sc[e] + rbias[e]; }
                    int bg = 0; float bgv = -1e30f; int be0[4], be1[4];
#pragma unroll
                    for (int g = 0; g < 4; ++g) {
                        int i0 = 0; float v0 = sel[4 * g];
#pragma unroll
                        for (int j = 1; j < 4; ++j) if (sel[4 * g + j] > v0) { v0 = sel[4 * g + j]; i0 = j; }
                        int i1 = -1; float v1 = -1e30f;
#pragma unroll
                        for (int j = 0; j < 4; ++j) if (j != i0 && sel[4 * g + j] > v1) { v1 = sel[4 * g + j]; i1 = j; }
                        be0[g] = 4 * g + i0; be1[g] = 4 * g + i1;
                        const float sum = v0 + v1; if (sum > bgv) { bgv = sum; bg = g; }
                    }
                    int e0 = be0[0], e1 = be1[0];
#pragma unroll
                    for (int g = 1; g < 4; ++g) if (bg == g) { e0 = be0[g]; e1 = be1[g]; }
                    float w0 = 0.f, w1 = 0.f;
#pragma unroll
                    for (int e = 0; e < 16; ++e) { if (e == e0) w0 = sc[e]; if (e == e1) w1 = sc[e]; }
                    const float inv = 1.0f / (w0 + w1);
                    const int slot = nrouted * 16 + F.tid;
                    rt_e[slot] = e0 | (e1 << 8); rt_w[2 * slot] = w0 * inv; rt_w[2 * slot + 1] = w1 * inv; rt_tok[slot] = tok;
                }
                ++nrouted;
            }
            __syncthreads();
        }
    }
    if (MODE == 1) {
        __syncthreads();
        const int nr = nrouted * 16; unsigned p0 = 0u, p1 = 0u; int e0 = 0, e1 = 0;
        if (F.tid < nr) { const int ee = rt_e[F.tid]; e0 = ee & 255; e1 = ee >> 8; p0 = __hip_atomic_fetch_add(rt_h + e0, 1u, __ATOMIC_RELAXED, __HIP_MEMORY_SCOPE_WORKGROUP); p1 = __hip_atomic_fetch_add(rt_h + e1, 1u, __ATOMIC_RELAXED, __HIP_MEMORY_SCOPE_WORKGROUP); }
        __syncthreads();
        if (F.tid < 16) { const unsigned hc = rt_h[F.tid]; rt_b[F.tid] = hc ? atomicAdd(cnt + 64 * F.tid, hc) : 0u; }
        __syncthreads();
        if (F.tid < nr) { const int tok = rt_tok[F.tid];
            list[e0 * NTOK + rt_b[e0] + p0] = tok; wsel[tok] = rt_w[2 * F.tid];
            list[e1 * NTOK + rt_b[e1] + p1] = NTOK + tok; wsel[NTOK + tok] = rt_w[2 * F.tid + 1]; }
        __syncthreads();
    }
}

constexpr int KT_PITCH = 72, VT_PITCH = 264;
constexpr int ATT_KT_OFF = 0, ATT_VT_OFF = 256 * KT_PITCH * 2;
DI void attn_unit(Frame& F, int unit, int l) {
    const int b = unit >> 6, kvh = (unit >> 5) & 1, qb = unit & 31;
    const bf16* proj = (const bf16*)(F.ws + WS_PROJ);
    const float* cs = (const float*)(F.ws + WS_COS); const float* sn = (const float*)(F.ws + WS_SIN);
    bf16* cat = (bf16*)(F.ws + WS_CAT);
    LAS unsigned char* kt = F.lds + ATT_KT_OFF; LAS unsigned char* vt = F.lds + ATT_VT_OFF;
    const int tq0 = b * SEQ + qb * 128, tk0 = tq0 - 128;
    {
        u32x4 klo[2], khi[2], vx[4]; f32x4 kc0[2], kc1[2], ks0[2], ks1[2];
#pragma unroll
        for (int it = 0; it < 2; ++it) {
            const int idx = F.tid + it * NTHREADS, kj = idx >> 2, c = idx & 3;
            int tk = tk0 + kj; if (tk < b * SEQ) tk = b * SEQ;
            const bf16* kp = proj + (size_t)tk * PN + C_SK + kvh * 64;
            klo[it] = *(const GAS u32x4*)(kp + 8 * c); khi[it] = *(const GAS u32x4*)(kp + 32 + 8 * c);
            kc0[it] = *(const GAS f32x4*)(cs + tk * 32 + 8 * c); kc1[it] = *(const GAS f32x4*)(cs + tk * 32 + 8 * c + 4);
            ks0[it] = *(const GAS f32x4*)(sn + tk * 32 + 8 * c); ks1[it] = *(const GAS f32x4*)(sn + tk * 32 + 8 * c + 4);
        }
        const int vkj = F.tid & 255, vdh = F.tid >> 8;
        { int tk = tk0 + vkj; if (tk < b * SEQ) tk = b * SEQ;
          const bf16* vp = proj + (size_t)tk * PN + C_SV + kvh * 64 + vdh * 32;
#pragma unroll
          for (int q = 0; q < 4; ++q) vx[q] = *(const GAS u32x4*)(vp + 8 * q); }
        __builtin_amdgcn_sched_barrier(0);
#pragma unroll
        for (int it = 0; it < 2; ++it) {
            const int idx = F.tid + it * NTHREADS, kj = idx >> 2, c = idx & 3;
            const u32x4 lo = klo[it], hi = khi[it]; const f32x4 c0 = kc0[it], c1 = kc1[it], s0 = ks0[it], s1 = ks1[it];
            float x1[8], x2[8], cc[8], ss[8];
#pragma unroll
            for (int j = 0; j < 4; ++j) { x1[2 * j] = bflo(lo[j]); x1[2 * j + 1] = bfhi(lo[j]); x2[2 * j] = bflo(hi[j]); x2[2 * j + 1] = bfhi(hi[j]); cc[j] = c0[j]; cc[4 + j] = c1[j]; ss[j] = s0[j]; ss[4 + j] = s1[j]; }
            u32x4 o1, o2;
#pragma unroll
            for (int j = 0; j < 4; ++j) {
                o1[j] = pk2(x1[2 * j] * cc[2 * j] - x2[2 * j] * ss[2 * j], x1[2 * j + 1] * cc[2 * j + 1] - x2[2 * j + 1] * ss[2 * j + 1]);
                o2[j] = pk2(x2[2 * j] * cc[2 * j] + x1[2 * j] * ss[2 * j], x2[2 * j + 1] * cc[2 * j + 1] + x1[2 * j + 1] * ss[2 * j + 1]);
            }
            *(LAS u32x4*)(kt + kj * (KT_PITCH * 2) + 16 * c) = o1;
            *(LAS u32x4*)(kt + kj * (KT_PITCH * 2) + 64 + 16 * c) = o2;
        }
#pragma unroll
        for (int q = 0; q < 4; ++q) { const u32x4 x = vx[q];
#pragma unroll
            for (int j = 0; j < 4; ++j) { const int d = vdh * 32 + 8 * q + 2 * j;
                *(LAS unsigned short*)(vt + (d * VT_PITCH + vkj) * 2) = (unsigned short)(x[j] & 0xffffu);
                *(LAS unsigned short*)(vt + ((d + 1) * VT_PITCH + vkj) * 2) = (unsigned short)(x[j] >> 16); } }
    }
    __syncthreads();
    const int lane = F.lane, n = lane & 15, q4 = lane >> 4, head = kvh * 8 + F.wave;
    const float sink = FIN(I_SINK)[l * 16 + head];
    u32x4 qlo, qhi; f32x4 qc0, qc1, qs0, qs1;
    { const int tq = tq0 + n; const bf16* qp = proj + (size_t)tq * PN + C_SQ + head * 64;
      qlo = *(const GAS u32x4*)(qp + 8 * q4); qhi = *(const GAS u32x4*)(qp + 32 + 8 * q4);
      qc0 = *(const GAS f32x4*)(cs + tq * 32 + 8 * q4); qc1 = *(const GAS f32x4*)(cs + tq * 32 + 8 * q4 + 4);
      qs0 = *(const GAS f32x4*)(sn + tq * 32 + 8 * q4); qs1 = *(const GAS f32x4*)(sn + tq * 32 + 8 * q4 + 4); }
#pragma unroll 1
    for (int qt = 0; qt < 8; ++qt) {
        const int qi = 16 * qt + n, tq = tq0 + qi;
        bf16x8 qf[2];
        {
            const u32x4 lo = qlo, hi = qhi; const f32x4 c0 = qc0, c1 = qc1, s0 = qs0, s1 = qs1;
            float x1[8], x2[8], cc[8], ss[8];
#pragma unroll
            for (int j = 0; j < 4; ++j) { x1[2 * j] = bflo(lo[j]); x1[2 * j + 1] = bfhi(lo[j]); x2[2 * j] = bflo(hi[j]); x2[2 * j + 1] = bfhi(hi[j]); cc[j] = c0[j]; cc[4 + j] = c1[j]; ss[j] = s0[j]; ss[4 + j] = s1[j]; }
            u32x4 o1, o2;
#pragma unroll
            for (int j = 0; j < 4; ++j) {
                o1[j] = pk2(0.125f * (x1[2 * j] * cc[2 * j] - x2[2 * j] * ss[2 * j]), 0.125f * (x1[2 * j + 1] * cc[2 * j + 1] - x2[2 * j + 1] * ss[2 * j + 1]));
                o2[j] = pk2(0.125f * (x2[2 * j] * cc[2 * j] + x1[2 * j] * ss[2 * j]), 0.125f * (x2[2 * j + 1] * cc[2 * j + 1] + x1[2 * j + 1] * ss[2 * j + 1]));
            }
            qf[0] = __builtin_bit_cast(bf16x8, o1); qf[1] = __builtin_bit_cast(bf16x8, o2);
        }
        {   const int tqn = tq0 + 16 * ((qt + 1) & 7) + n; const bf16* qp = proj + (size_t)tqn * PN + C_SQ + head * 64;
            qlo = *(const GAS u32x4*)(qp + 8 * q4); qhi = *(const GAS u32x4*)(qp + 32 + 8 * q4);
            qc0 = *(const GAS f32x4*)(cs + tqn * 32 + 8 * q4); qc1 = *(const GAS f32x4*)(cs + tqn * 32 + 8 * q4 + 4);
            qs0 = *(const GAS f32x4*)(sn + tqn * 32 + 8 * q4); qs1 = *(const GAS f32x4*)(sn + tqn * 32 + 8 * q4 + 4); }
        __builtin_amdgcn_sched_barrier(0);
        const int t0 = 2 * (qt >> 1);
        f32x4 s[10];
#pragma unroll
        for (int tt = 0; tt < 10; ++tt) {
            f32x4 a = (f32x4){0.f, 0.f, 0.f, 0.f};
#pragma unroll
            for (int kk = 0; kk < 2; ++kk) {
                const bf16x8 kf = *(const LAS bf16x8*)(kt + (16 * (t0 + tt) + n) * (KT_PITCH * 2) + 64 * kk + 16 * q4);
                a = __builtin_amdgcn_mfma_f32_16x16x32_bf16(kf, qf[kk], a, 0, 0, 0);
            }
            s[tt] = a;
        }
        float mx = sink;
#pragma unroll
        for (int tt = 0; tt < 10; ++tt)
#pragma unroll
            for (int r = 0; r < 4; ++r) { const int kj = 16 * (t0 + tt) + 4 * q4 + r;
                const bool valid = (kj >= qi + 1) && (kj <= qi + 128) && (qb > 0 || kj >= 128);
                s[tt][r] = valid ? s[tt][r] : -INFINITY; mx = fmaxf(mx, s[tt][r]); }
        mx = fmaxf(mx, swz_xor(mx, SWZ_X16)); mx = xor32_max(mx);
        float sum = 0.f;
#pragma unroll
        for (int tt = 0; tt < 10; ++tt)
#pragma unroll
            for (int r = 0; r < 4; ++r) { const float p = __expf(s[tt][r] - mx); s[tt][r] = p; sum += p; }
        sum += swz_xor(sum, SWZ_X16); sum = xor32_sum(sum);
        const float inv = 1.0f / (sum + __expf(sink - mx));
        f32x4 o[4];
#pragma unroll
        for (int dt = 0; dt < 4; ++dt) o[dt] = (f32x4){0.f, 0.f, 0.f, 0.f};
#pragma unroll
        for (int kk = 0; kk < 5; ++kk) {
            u32x4 pw; pw.x = pk2(s[2 * kk][0], s[2 * kk][1]); pw.y = pk2(s[2 * kk][2], s[2 * kk][3]); pw.z = pk2(s[2 * kk + 1][0], s[2 * kk + 1][1]); pw.w = pk2(s[2 * kk + 1][2], s[2 * kk + 1][3]);
            const bf16x8 pf = __builtin_bit_cast(bf16x8, pw);
            const int key0 = 16 * t0 + 32 * kk + 4 * q4;
#pragma unroll
            for (int dt = 0; dt < 4; ++dt) {
                const LAS unsigned char* vp = vt + ((16 * dt + n) * VT_PITCH + key0) * 2;
                const u32x2 va = *(const LAS u32x2*)vp, vb = *(const LAS u32x2*)(vp + 32);
                u32x4 vw; vw.x = va.x; vw.y = va.y; vw.z = vb.x; vw.w = vb.y;
                o[dt] = __builtin_amdgcn_mfma_f32_16x16x32_bf16(__builtin_bit_cast(bf16x8, vw), pf, o[dt], 0, 0, 0);
            }
        }
#pragma unroll
        for (int dt = 0; dt < 4; ++dt) { u32x2 w; w.x = pk2(o[dt][0] * inv, o[dt][1] * inv); w.y = pk2(o[dt][2] * inv, o[dt][3] * inv);
            *(GAS u32x2*)(cat + (size_t)tq * DM + head * 64 + 16 * dt + 4 * q4) = w; }
    }
    __syncthreads();
}

constexpr int OPS_BYTES = 57344, U_BYTES = 16384;
constexpr size_t WS_SCAN_U = WS_SCAN + (size_t)1024 * OPS_BYTES, WS_GLAST = 6 * MiB;
constexpr int DP_PITCH = 272, DP_Q = 0, DP_K = 17408, DP_V = 34816, DP_L = 52224, DP_GC = 69632, DP_BT = 69888, DP_EG = 70144, DP_EK = 70400, DP_RK = 70656, DP_RQ = 70912, DP_EKB = 71168, DP_GROUP = 71424;
DI void dn_prep_item(Frame& F, int item, int l) {
    int lane = F.lane; asm volatile("" : "+v"(lane));
    const int gi = F.wave >> 2, wg = F.wave & 3; int tg = wg * 64 + lane;
    const int h = item & 7, ck = (item >> 3) & 63, b = item >> 9;
    const int sitem = (b * 8 + h) * 64 + ck;
    const int tb = b * SEQ + ck * 64;
    LAS unsigned char* base = F.lds + gi * DP_GROUP;
    const bf16* proj = (const bf16*)(F.ws + WS_PROJ);
    GAS unsigned char* ops = F.ws + WS_SCAN + (size_t)sitem * OPS_BYTES;
    float* uo = (float*)(F.ws + WS_SCAN_U + (size_t)sitem * U_BYTES);
    LAS float* gc = (LAS float*)(base + DP_GC); LAS float* bt = (LAS float*)(base + DP_BT); LAS float* eg = (LAS float*)(base + DP_EG); LAS float* ek = (LAS float*)(base + DP_EK);
    LAS float* rkn = (LAS float*)(base + DP_RK); LAS float* rqn = (LAS float*)(base + DP_RQ); LAS float* ekb = (LAS float*)(base + DP_EKB);
    LAS float* Lm = (LAS float*)(base + DP_L);
    {
        const float* cw = FIN(I_CONVW) + (size_t)l * 4 * 3072;
        float w[3][4][2];
#pragma unroll
        for (int s = 0; s < 3; ++s)
#pragma unroll
            for (int j = 0; j < 4; ++j) { const f32x2 t = *(const GAS f32x2*)(cw + j * 3072 + s * 1024 + h * 128 + 2 * lane); w[s][j][0] = t.x; w[s][j][1] = t.y; }
        const int colq = C_DQ + h * 128 + 2 * lane;
        const int t0 = ck * 64 + 16 * wg - 3;
        unsigned xs[3][19];
#pragma unroll
        for (int s = 0; s < 3; ++s)
#pragma unroll
            for (int i = 0; i < 19; ++i) { const int t = t0 + i; xs[s][i] = (t >= 0) ? *(const GAS unsigned*)(proj + (size_t)(b * SEQ + t) * PN + colq + s * 1024) : 0u; }
        __builtin_amdgcn_sched_barrier(0);
#pragma unroll
        for (int s = 0; s < 3; ++s) {
#pragma unroll
            for (int i = 0; i < 16; ++i) {
                const float a0 = w[s][0][0] * bflo(xs[s][i]) + w[s][1][0] * bflo(xs[s][i + 1]) + w[s][2][0] * bflo(xs[s][i + 2]) + w[s][3][0] * bflo(xs[s][i + 3]);
                const float a1 = w[s][0][1] * bfhi(xs[s][i]) + w[s][1][1] * bfhi(xs[s][i + 1]) + w[s][2][1] * bfhi(xs[s][i + 2]) + w[s][3][1] * bfhi(xs[s][i + 3]);
                *(LAS unsigned*)(base + DP_Q + s * 17408 + (16 * wg + i) * DP_PITCH + 4 * lane) = pk2(siluf_(a0), siluf_(a1));
            }
        }
    }
    if (tg < 64) {
        const float* ab = (const float*)(F.ws + WS_AB) + (size_t)(tb + tg) * 16;
        const float a = ab[h], bb = ab[8 + h];
        const float x = a + FIN(I_DTB)[l * 8 + h];
        const float ex = __expf(x);
        const float sp = (x > 20.f) ? x : ((ex < 0.03f) ? ex * (1.0f - ex * (0.5f - ex * (0.33333333f - 0.25f * ex))) : __logf(1.0f + ex));
        eg[tg] = -__expf(FIN(I_ALOG)[l * 8 + h]) * sp; bt[tg] = sigmoidf_(bb);
    }
    __syncthreads();
    if (tg < 64) { float s = 0.f;
        for (int i = 0; i < 64; ++i) { const float gv = eg[i]; s += (i <= tg) ? gv : 0.f; }
        gc[tg] = s; }
    {
        asm volatile("" : "+v"(lane));
        const int n = lane & 15, q4 = lane >> 4;
        f32x4 kd = (f32x4){0.f, 0.f, 0.f, 0.f}, qd = (f32x4){0.f, 0.f, 0.f, 0.f};
#pragma unroll
        for (int kk = 0; kk < 4; ++kk) { const bf16x8 ak = *(const LAS bf16x8*)(base + DP_K + (16 * wg + n) * DP_PITCH + (32 * kk + 8 * q4) * 2), aq = *(const LAS bf16x8*)(base + DP_Q + (16 * wg + n) * DP_PITCH + (32 * kk + 8 * q4) * 2);
            kd = __builtin_amdgcn_mfma_f32_16x16x32_bf16(ak, ak, kd, 0, 0, 0); qd = __builtin_amdgcn_mfma_f32_16x16x32_bf16(aq, aq, qd, 0, 0, 0); }
#pragma unroll
        for (int r = 0; r < 4; ++r) if (n == 4 * q4 + r) { rkn[16 * wg + n] = 1.0f / sqrtf(kd[r] + RMS_EPS); rqn[16 * wg + n] = 0.08838834764831845f / sqrtf(qd[r] + RMS_EPS); }
    }
    __syncthreads();
    if (tg < 64) { const float g63 = gc[63], gme = gc[tg], e = __expf(gme), rk = rkn[tg];
        eg[tg] = rqn[tg] * e;
        ek[tg] = rk * __expf(g63 - gme);
        ekb[tg] = rk * bt[tg] * e;
        if (tg == 0) ((float*)(F.ws + WS_GLAST))[sitem] = __expf(g63); }
    {
        asm volatile("" : "+v"(lane));
        const int n = lane & 15, q4 = lane >> 4;
        bf16x8 ak[4], aq[4];
#pragma unroll
        for (int kk = 0; kk < 4; ++kk) { ak[kk] = *(const LAS bf16x8*)(base + DP_K + (16 * wg + n) * DP_PITCH + (32 * kk + 8 * q4) * 2); aq[kk] = *(const LAS bf16x8*)(base + DP_Q + (16 * wg + n) * DP_PITCH + (32 * kk + 8 * q4) * 2); }
#pragma unroll
        for (int st = 0; st < 4; ++st) {
            f32x4 kkacc = (f32x4){0.f, 0.f, 0.f, 0.f}, qkacc = (f32x4){0.f, 0.f, 0.f, 0.f};
#pragma unroll
            for (int kk = 0; kk < 4; ++kk) { const bf16x8 bk = *(const LAS bf16x8*)(base + DP_K + (16 * st + n) * DP_PITCH + (32 * kk + 8 * q4) * 2);
                kkacc = __builtin_amdgcn_mfma_f32_16x16x32_bf16(ak[kk], bk, kkacc, 0, 0, 0); qkacc = __builtin_amdgcn_mfma_f32_16x16x32_bf16(aq[kk], bk, qkacc, 0, 0, 0); }
            const int sidx = 16 * st + n; const float gs = gc[sidx], rks = rkn[sidx];
#pragma unroll
            for (int r = 0; r < 4; ++r) { const int c = 16 * wg + 4 * q4 + r; const float dec = (c >= sidx) ? __expf(gc[c] - gs) * rks : 0.f;
                Lm[c * 68 + sidx] = (c > sidx) ? -(bt[c] * rkn[c] * kkacc[r] * dec) : 0.f;
                const int m = 4 * q4 + r, kkf = st >> 1, qq = (n >> 2) & 3, j = ((st & 1) << 2) | (n & 3);
                *(GAS unsigned short*)(ops + 49152 + (size_t)(((wg * 2 + kkf) * 64 + qq * 16 + m) * 8 + j) * 2) = (unsigned short)f2bf(qkacc[r] * rqn[c] * dec); }
        }
    }
    __syncthreads();
    f32x4 Xc[4][4];
    {
        asm volatile("" : "+v"(lane));
        const int n = lane & 15, q4 = lane >> 4;
        unsigned lmb = (unsigned)(size_t)Lm; asm volatile("" : "+v"(lmb));
        if (wg == 0) {
            float t[16];
#pragma unroll
            for (int i = 0; i < 16; ++i) t[i] = 0.f;
            const unsigned rowb = lmb + (unsigned)(((16 * q4) * 68 + 16 * q4) * 4);
#pragma unroll
            for (int i = 0; i < 16; ++i) {
                float a = (i == n) ? 1.f : 0.f;
#pragma unroll
                for (int k4 = 0; k4 < (i + 3) / 4; ++k4) { const f32x4 l4 = *(const LAS f32x4*)(size_t)(rowb + (unsigned)((i * 68 + 4 * k4) * 4));
                    a += (l4.x * t[4 * k4] + l4.y * t[4 * k4 + 1]) + (l4.z * t[4 * k4 + 2] + l4.w * t[4 * k4 + 3]); }
                t[i] = a;
            }
#pragma unroll
            for (int i = 0; i < 16; ++i) *(LAS float*)(size_t)(rowb + (unsigned)((i * 68 + n) * 4)) = t[i];
        }
        {
            const LAS unsigned char* src = base + ((wg < 2) ? DP_V : DP_K) + (((64 * wg) & 127) + n) * 2;
            const LAS float* scp = (wg < 2) ? bt : ekb;
#pragma unroll
            for (int rb = 0; rb < 4; ++rb)
#pragma unroll
                for (int r = 0; r < 4; ++r) { const int row = 16 * rb + 4 * q4 + r; const float sc = scp[row];
#pragma unroll
                    for (int ct = 0; ct < 4; ++ct) Xc[ct][rb][r] = __builtin_bit_cast(float, ((unsigned)*(const LAS unsigned short*)(src + row * DP_PITCH + 32 * ct)) << 16) * sc; }
        }
        __syncthreads();
#define DP_NBLK(rb, rbp) (*(const LAS f32x4*)(size_t)(lmb + (unsigned)((((16 * (rb) + n) * 68) + 16 * (rbp) + 4 * q4) * 4)))
#define DP_PK4(v) ({ const f32x4 v_ = (v); u32x2 p_; p_.x = pk2n(v_[0], v_[1]); p_.y = pk2n(v_[2], v_[3]); __builtin_bit_cast(s16x4, p_); })
        s16x4 xb[4][4];
#pragma unroll
        for (int rb = 0; rb < 4; ++rb) {
#pragma unroll
            for (int rbp = 0; rbp < rb; ++rbp) { const s16x4 a = DP_PK4(DP_NBLK(rb, rbp));
#pragma unroll
                for (int ct = 0; ct < 4; ++ct) Xc[ct][rb] = __builtin_amdgcn_mfma_f32_16x16x16bf16_1k(a, xb[ct][rbp], Xc[ct][rb], 0, 0, 0); }
            const s16x4 tb4 = DP_PK4(DP_NBLK(rb, rb));
#pragma unroll
            for (int ct = 0; ct < 4; ++ct) { const s16x4 rhs = DP_PK4(Xc[ct][rb]);
                Xc[ct][rb] = __builtin_amdgcn_mfma_f32_16x16x16bf16_1k(tb4, rhs, (f32x4){0.f, 0.f, 0.f, 0.f}, 0, 0, 0); xb[ct][rb] = DP_PK4(Xc[ct][rb]); }
        }
#undef DP_NBLK
#undef DP_PK4
        if (wg < 2) {
#pragma unroll
            for (int ct = 0; ct < 4; ++ct)
#pragma unroll
                for (int rb = 0; rb < 4; ++rb) { u32x2 o; o.x = pk2(Xc[ct][rb][0], Xc[ct][rb][1]); o.y = pk2(Xc[ct][rb][2], Xc[ct][rb][3]);
                    *(GAS u32x2*)((GAS unsigned char*)uo + (size_t)((((4 * wg + ct) * 4 + rb) * 64 + lane) * 8)) = o; }
        } else {
#pragma unroll
            for (int ct = 0; ct < 4; ++ct)
#pragma unroll
                for (int rb = 0; rb < 4; ++rb)
#pragma unroll
                    for (int r = 0; r < 4; ++r) *(LAS unsigned short*)(base + DP_V + (16 * rb + 4 * q4 + r) * DP_PITCH + (64 * (wg - 2) + 16 * ct + n) * 2) = (unsigned short)f2bf(Xc[ct][rb][r]);
        }
    }
    __syncthreads();
    asm volatile("" : "+v"(tg));
#pragma unroll 1
    for (int i = 0; i < 4; ++i) { const int p = tg + 256 * i, f = p >> 6, ln = p & 63, q = ln >> 4, m = ln & 15, mt = f >> 2, kk = f & 3, c = 16 * mt + m;
        const u32x2 w0 = *(const LAS u32x2*)(base + DP_V + c * DP_PITCH + (32 * kk + 4 * q) * 2), w1 = *(const LAS u32x2*)(base + DP_V + c * DP_PITCH + (32 * kk + 16 + 4 * q) * 2);
        u32x4 wv; wv.x = w0.x; wv.y = w0.y; wv.z = w1.x; wv.w = w1.y;
        *(GAS u32x4*)(ops + (size_t)(f * 64 + ln) * 16) = wv;
        const u32x2 q0 = *(const LAS u32x2*)(base + DP_Q + c * DP_PITCH + (32 * kk + 4 * q) * 2), q1 = *(const LAS u32x2*)(base + DP_Q + c * DP_PITCH + (32 * kk + 16 + 4 * q) * 2);
        const float e = eg[c]; u32x4 qv;
        qv.x = pk2(bflo(q0.x) * e, bfhi(q0.x) * e); qv.y = pk2(bflo(q0.y) * e, bfhi(q0.y) * e); qv.z = pk2(bflo(q1.x) * e, bfhi(q1.x) * e); qv.w = pk2(bflo(q1.y) * e, bfhi(q1.y) * e);
        *(GAS u32x4*)(ops + 16384 + (size_t)(f * 64 + ln) * 16) = qv;
        const int mt8 = f >> 1, kk2 = f & 1, d = 16 * mt8 + m; float kv[8];
#pragma unroll
        for (int j = 0; j < 8; ++j) { const int cc = 32 * kk2 + 16 * (j >> 2) + 4 * q + (j & 3);
            kv[j] = __builtin_bit_cast(float, ((unsigned)*(const LAS unsigned short*)(base + DP_K + cc * DP_PITCH + d * 2)) << 16) * ek[cc]; }
        u32x4 kw; kw.x = pk2(kv[0], kv[1]); kw.y = pk2(kv[2], kv[3]); kw.z = pk2(kv[4], kv[5]); kw.w = pk2(kv[6], kv[7]);
        *(GAS u32x4*)(ops + 32768 + (size_t)(f * 64 + ln) * 16) = kw; }
    __syncthreads();
}

DI void dn_scan_phase(Frame& F) {
    if (F.bid >= 32) return;
    const int bh = (F.bid & 7) + 8 * (F.bid >> 4), vg = (F.bid >> 3) & 1, b = bh >> 3, h = bh & 7, lane = F.lane;
    const GAS unsigned char* opsg = F.ws + WS_SCAN + (size_t)bh * 64 * OPS_BYTES;
    const GAS unsigned char* ugb = F.ws + WS_SCAN_U + (size_t)bh * 64 * U_BYTES + (size_t)vg * 8192;
    const float* glast = (const float*)(F.ws + WS_GLAST) + bh * 64;
    bf16* ob = (bf16*)(F.ws + WS_OBUF);
    constexpr int SBUF = OPS_BYTES + 8192;
    LAS float* glds = (LAS float*)(F.lds + 2 * SBUF);
    if (F.tid < 64) glds[F.tid] = glast[F.tid];
#define SCAN_STEP_BARRIER() do { asm volatile("s_waitcnt lgkmcnt(0)" ::: "memory"); __builtin_amdgcn_s_barrier(); asm volatile("" ::: "memory"); } while (0)
#define GLD16(dst, ptr) asm volatile("global_load_dwordx4 %0, %1, off" : "=v"(dst) : "v"(ptr) : "memory")
#define WAIT18(r) asm volatile("s_waitcnt vmcnt(16)" : "+v"(r[0]), "+v"(r[1]), "+v"(r[2]), "+v"(r[3]), "+v"(r[4]), "+v"(r[5]), "+v"(r[6]), "+v"(r[7]), "+v"(r[8]), "+v"(r[9]), "+v"(r[10]), "+v"(r[11]), "+v"(r[12]), "+v"(r[13]), "+v"(r[14]), "+v"(r[15]) :: "memory")
    if (F.wave >= 4) {
        const int lw = F.wave - 4;
        const GAS unsigned char* srco = opsg + (size_t)(lw * 14) * 1024 + lane * 16;
        const GAS unsigned char* srcu = ugb + (size_t)(lw * 2) * 1024 + lane * 16;
        LAS unsigned char* dsto = F.lds + (lw * 14) * 1024 + lane * 16;
        LAS unsigned char* dstu = F.lds + OPS_BYTES + (lw * 2) * 1024 + lane * 16;
        u32x4 ra[16], rb[16], rc[16];
#define WAIT32(r) asm volatile("s_waitcnt vmcnt(32)" : "+v"(r[0]), "+v"(r[1]), "+v"(r[2]), "+v"(r[3]), "+v"(r[4]), "+v"(r[5]), "+v"(r[6]), "+v"(r[7]), "+v"(r[8]), "+v"(r[9]), "+v"(r[10]), "+v"(r[11]), "+v"(r[12]), "+v"(r[13]), "+v"(r[14]), "+v"(r[15]) :: "memory")
#define LOAD_SET(r, ck) do { const int ck_ = (ck) < 64 ? (ck) : 63; const GAS unsigned char* so_ = srco + (size_t)ck_ * OPS_BYTES; const GAS unsigned char* su_ = srcu + (size_t)ck_ * U_BYTES; \
        _Pragma("unroll") for (int p = 0; p < 14; ++p) { const GAS unsigned char* a_ = so_ + (size_t)p * 1024; GLD16(r[p], a_); } \
        _Pragma("unroll") for (int p = 0; p < 2; ++p) { const GAS unsigned char* a_ = su_ + (size_t)p * 1024; GLD16(r[14 + p], a_); } } while (0)
#define STORE_SET(r, bufi) do { _Pragma("unroll") for (int p = 0; p < 14; ++p) *(LAS u32x4*)(dsto + (bufi) * SBUF + p * 1024) = r[p]; \
        _Pragma("unroll") for (int p = 0; p < 2; ++p) *(LAS u32x4*)(dstu + (bufi) * SBUF + p * 1024) = r[14 + p]; } while (0)
#define LSTEP(r, bufi, i_) do { WAIT32(r); __builtin_amdgcn_sched_barrier(0); STORE_SET(r, bufi); LOAD_SET(r, (i_) + 4); SCAN_STEP_BARRIER(); } while (0)
        LOAD_SET(ra, 0); LOAD_SET(rb, 1); LOAD_SET(rc, 2);
        WAIT32(ra); __builtin_amdgcn_sched_barrier(0);
        STORE_SET(ra, 0);
        LOAD_SET(ra, 3);
        SCAN_STEP_BARRIER();
#pragma unroll 1
        for (int i = 0; i < 60; i += 6) {
            LSTEP(rb, 1, i); LSTEP(rc, 0, i + 1); LSTEP(ra, 1, i + 2); LSTEP(rb, 0, i + 3); LSTEP(rc, 1, i + 4); LSTEP(ra, 0, i + 5);
        }
        LSTEP(rb, 1, 60); LSTEP(rc, 0, 61); LSTEP(ra, 1, 62); LSTEP(rb, 0, 63);
        asm volatile("s_waitcnt vmcnt(0)" : "+v"(ra[0]), "+v"(rb[0]), "+v"(rc[0]) :: "memory");
#undef LSTEP
#undef WAIT32
#undef LOAD_SET
#undef STORE_SET
    } else {
        const int vs = vg * 4 + F.wave, n = lane & 15, q4 = lane >> 4;
        f32x4 S[8];
#pragma unroll
        for (int i = 0; i < 8; ++i) S[i] = (f32x4){0.f, 0.f, 0.f, 0.f};
        f32x4 Op[4];
#pragma unroll
        for (int t = 0; t < 4; ++t) Op[t] = (f32x4){0.f, 0.f, 0.f, 0.f};
        GAS bf16* obase = (GAS bf16*)ob + (size_t)(b * SEQ + 4 * q4) * 1024 + h * 128 + vs * 16 + n;
        SCAN_STEP_BARRIER();
#pragma unroll 1
        for (int i = 0; i < 64; ++i) {
            LAS unsigned char* buf = F.lds + (i & 1) * SBUF;
            if (i > 0) { GAS bf16* op = obase + (size_t)(i - 1) * 64 * 1024;
#pragma unroll
                for (int t = 0; t < 4; ++t) { const unsigned p01 = pk2(Op[t][0], Op[t][1]), p23 = pk2(Op[t][2], Op[t][3]);
                    op[(size_t)(16 * t + 0) * 1024] = (bf16)p01; op[(size_t)(16 * t + 1) * 1024] = (bf16)(p01 >> 16); op[(size_t)(16 * t + 2) * 1024] = (bf16)p23; op[(size_t)(16 * t + 3) * 1024] = (bf16)(p23 >> 16); } }
            f32x4 u[4];
#pragma unroll
            for (int t = 0; t < 4; ++t) { const u32x2 uw = *(const LAS u32x2*)(buf + OPS_BYTES + ((F.wave * 4 + t) * 64 + lane) * 8); u[t] = (f32x4){bflo(uw.x), bfhi(uw.x), bflo(uw.y), bfhi(uw.y)}; }
            const float gl = glds[i];
            bf16x8 wf[16], qf[16];
#pragma unroll
            for (int f = 0; f < 16; ++f) { wf[f] = *(const LAS bf16x8*)(buf + (f * 64 + lane) * 16); qf[f] = *(const LAS bf16x8*)(buf + 16384 + (f * 64 + lane) * 16); }
            bf16x8 sb[4];
#pragma unroll
            for (int kk = 0; kk < 4; ++kk) { u32x4 w; w.x = pk2(S[2 * kk][0], S[2 * kk][1]); w.y = pk2(S[2 * kk][2], S[2 * kk][3]); w.z = pk2(S[2 * kk + 1][0], S[2 * kk + 1][1]); w.w = pk2(S[2 * kk + 1][2], S[2 * kk + 1][3]); sb[kk] = __builtin_bit_cast(bf16x8, w); }
            __builtin_amdgcn_sched_barrier(0);
            f32x4 P[4], O[4];
#pragma unroll
            for (int t = 0; t < 4; ++t) { P[t] = (f32x4){0.f, 0.f, 0.f, 0.f};
#pragma unroll
                for (int kk = 0; kk < 4; ++kk) P[t] = __builtin_amdgcn_mfma_f32_16x16x32_bf16(wf[t * 4 + kk], sb[kk], P[t], 0, 0, 0); }
            __builtin_amdgcn_sched_barrier(0);
            bf16x8 af[8], kf[16];
#pragma unroll
            for (int f = 0; f < 16; ++f) kf[f] = *(const LAS bf16x8*)(buf + 32768 + (f * 64 + lane) * 16);
#pragma unroll
            for (int f = 0; f < 8; ++f) af[f] = *(const LAS bf16x8*)(buf + 49152 + (f * 64 + lane) * 16);
            __builtin_amdgcn_sched_barrier(0);
#pragma unroll
            for (int t = 0; t < 4; ++t) { O[t] = (f32x4){0.f, 0.f, 0.f, 0.f};
#pragma unroll
                for (int kk = 0; kk < 4; ++kk) O[t] = __builtin_amdgcn_mfma_f32_16x16x32_bf16(qf[t * 4 + kk], sb[kk], O[t], 0, 0, 0); }
            __builtin_amdgcn_sched_barrier(0);
            bf16x8 vb[2];
#pragma unroll
            for (int k2 = 0; k2 < 2; ++k2) { const f32x4 v0 = u[2 * k2] - P[2 * k2], v1 = u[2 * k2 + 1] - P[2 * k2 + 1]; u32x4 w; w.x = pk2(v0[0], v0[1]); w.y = pk2(v0[2], v0[3]); w.z = pk2(v1[0], v1[1]); w.w = pk2(v1[2], v1[3]); vb[k2] = __builtin_bit_cast(bf16x8, w); }
#pragma unroll
            for (int mt = 0; mt < 8; ++mt) { S[mt] = S[mt] * gl;
#pragma unroll
                for (int k2 = 0; k2 < 2; ++k2) S[mt] = __builtin_amdgcn_mfma_f32_16x16x32_bf16(kf[mt * 2 + k2], vb[k2], S[mt], 0, 0, 0); }
#pragma unroll
            for (int t = 0; t < 4; ++t)
#pragma unroll
                for (int k2 = 0; k2 < 2; ++k2) O[t] = __builtin_amdgcn_mfma_f32_16x16x32_bf16(af[t * 2 + k2], vb[k2], O[t], 0, 0, 0);
#pragma unroll
            for (int t = 0; t < 4; ++t) Op[t] = O[t];
            SCAN_STEP_BARRIER();
        }
        { GAS bf16* op = obase + (size_t)63 * 64 * 1024;
#pragma unroll
            for (int t = 0; t < 4; ++t) { const unsigned p01 = pk2(Op[t][0], Op[t][1]), p23 = pk2(Op[t][2], Op[t][3]);
                op[(size_t)(16 * t + 0) * 1024] = (bf16)p01; op[(size_t)(16 * t + 1) * 1024] = (bf16)(p01 >> 16); op[(size_t)(16 * t + 2) * 1024] = (bf16)p23; op[(size_t)(16 * t + 3) * 1024] = (bf16)(p23 >> 16); } }
        asm volatile("s_waitcnt vmcnt(0)" ::: "memory");
    }
#undef SCAN_STEP_BARRIER
#undef GLD16
#undef WAIT18
}

DI void gnorm_phase(Frame& F, int l) {
    const bf16* ob = (const bf16*)(F.ws + WS_OBUF); const bf16* proj = (const bf16*)(F.ws + WS_PROJ); bf16* cat = (bf16*)(F.ws + WS_CAT);
    const int lane = F.lane; const f32x2 nw = *(const GAS f32x2*)(FIN(I_DNW) + l * 128 + 2 * lane);
    const int gw = F.bid * NWAVES + F.wave, NGW = F.G * NWAVES;
    for (int it0 = gw * 4; it0 < NTOK * 8; it0 += NGW * 4) {
        f32x2 o[4]; unsigned z[4], ow[4];
#pragma unroll
        for (int i = 0; i < 4; ++i) { const int it = it0 + i, tok = it >> 3, h = it & 7;
            ow[i] = *(const GAS unsigned*)(ob + (size_t)tok * 1024 + h * 128 + 2 * lane); z[i] = *(const GAS unsigned*)(proj + (size_t)tok * PN + C_DZ + h * 128 + 2 * lane); }
        __builtin_amdgcn_sched_barrier(0);
#pragma unroll
        for (int i = 0; i < 4; ++i) { const int it = it0 + i, tok = it >> 3, h = it & 7; o[i] = (f32x2){bflo(ow[i]), bfhi(ow[i])};
            const float ms = wave_sum(o[i].x * o[i].x + o[i].y * o[i].y) * (1.0f / 128.0f);
            const float r = 1.0f / sqrtf(ms + RMS_EPS);
            *(GAS unsigned*)(cat + (size_t)tok * DM + 1024 + h * 128 + 2 * lane) = pk2(o[i].x * r * nw.x * siluf_(bflo(z[i])), o[i].y * r * nw.y * siluf_(bfhi(z[i]))); }
    }
}

DI int moe_table(Frame& F, const unsigned* cnt) {
    LAS int* tab = (LAS int*)(F.lds + MOETAB_OFF);
    __syncthreads();
    if (F.tid < 16) tab[17 + F.tid] = (int)__hip_atomic_load(cnt + 64 * F.tid, __ATOMIC_RELAXED, __HIP_MEMORY_SCOPE_AGENT);
    __syncthreads();
    if (F.tid == 0) { int acc = 0, np = 0;
        for (int e = 0; e < 16; ++e) { const int c = tab[17 + e]; tab[e] = acc; acc += c >> 8; if (c & 255) { tab[34 + np] = e; ++np; } }
        tab[16] = acc; tab[33] = np; }
    __syncthreads();
    return tab[16] + tab[33];
}

constexpr int NS = 11, NSTEPS = 1 + DEPTH * NS;
struct Args { const float* in[18]; float* out; unsigned char* ws; int s_lo, s_hi; };

__global__ void __launch_bounds__(NTHREADS, 2) fwd_kernel(Args args) {
    extern __shared__ __attribute__((aligned(16))) unsigned char lds_raw[];
    Frame F;
    F.lds = (LAS unsigned char*)lds_raw;
    F.tid = threadIdx.x; F.lane = F.tid & 63; F.wave = __builtin_amdgcn_readfirstlane(F.tid >> 6);
    const int wave0 = F.wave;
    F.G = gridDim.x; F.bid = blockIdx.x; F.ws = (GAS unsigned char*)args.ws; F.out = (GAS float*)args.out;
    F.in = args.in;
    unsigned* ctl = (unsigned*)(F.ws + WS_CTL);
    if (F.tid < 4) ((LAS unsigned*)(F.lds + MISC_OFF))[F.tid] = 0u;
    __syncthreads();
    const int lo = args.s_lo, hi = args.s_hi;
    XcdBarrier bar; bar.bar = ctl + CW_BAR; bar.x = 0; bar.st = nullptr;
    if (hi - lo > 1) bar = xcd_barrier_post(ctl + CW_BAR, (volatile LAS unsigned*)(F.lds + MISC_OFF));
#ifndef PHASE_MASK
#define PHASE_MASK 0xfff
#endif
#define PHM(k) (((PHASE_MASK) >> (k)) & 1)
#define REFRESH() do { int z_ = 0; asm volatile("" : "+v"(z_)); const int ln_ = __builtin_amdgcn_mbcnt_hi(-1, __builtin_amdgcn_mbcnt_lo(-1, z_)); int wv_ = wave0; asm volatile("" : "+s"(wv_)); F.lane = ln_; F.wave = wv_; F.tid = wv_ * 64 + ln_; asm volatile("" : "+s"(F.ws)); } while (0)
#ifndef PROBE_A
#define PROBE_A -1
#define PROBE_B -1
#endif
#ifndef PROBE_SHIFT
#define PROBE_SHIFT 0.5f
#endif
#define TSTAMP(k) do { if (PROBE_A >= 0 && F.bid == 0 && F.tid == 0) ((unsigned long long*)(F.ws + WS_CTL + 65536))[k] = __builtin_amdgcn_s_memrealtime(); } while (0)
#define RUN(s) (lo <= (s) && (s) < hi)
#define SEAM(s) do { if ((s) + 1 < hi || PROBE_A >= 0) { XcdBarrier b2_ = bar; unsigned* bp_ = (unsigned*)(F.ws + WS_CTL) + CW_BAR; asm volatile("" : "+s"(bp_)); b2_.bar = bp_; xcd_barrier(b2_); } TSTAMP((s) + 1); } while (0)
#define P_CNT ((unsigned*)(F.ws + WS_CTL) + CW_CNT)
#define P_LIST ((int*)(F.ws + WS_LIST))
#define P_WSEL ((float*)(F.ws + WS_WSEL))
#define P_XB ((bf16*)(F.ws + WS_XB))
#define P_PROJB ((bf16*)(F.ws + WS_PROJ))
#define P_CATB ((bf16*)(F.ws + WS_CAT))
#define P_YB ((bf16*)(F.ws + WS_Y))
#define P_X1 ((float*)(F.ws + WS_X1))
#define P_X1B ((bf16*)(F.ws + WS_X1B))
#define P_HID ((bf16*)(F.ws + WS_HID))
#define P_O2 ((bf16*)(F.ws + WS_O2))
#define P_XW ((float*)(F.ws + WS_X))
#define P_ABP ((float*)(F.ws + WS_AB))
    TSTAMP(0);
    if (PHM(11) && RUN(0)) { REFRESH();
        rope_phase(F);
        ln_phase<0, false>(F, FIN(I_X), nullptr, nullptr, nullptr, nullptr, P_XB, FIN(I_WIN) + C_AB, PROJ, true, P_ABP, nullptr, nullptr, nullptr, nullptr);
        __syncthreads();
        convw_phase(F, 0, 0, 0, F.G, 0, CONV_I_IN);
        __syncthreads();
        SEAM(0);
    }
    for (int l = 0; l < DEPTH; ++l) {
        const int sb = 1 + l * NS;
        const int slot = l & 1;
#define P_WIN_T ((const bf16*)(F.ws + WS_WIN) + (size_t)slot * PN * DM)
#define P_WOUT_T ((const bf16*)(F.ws + WS_WOUT) + (size_t)slot * DM * DM)
#define P_WGU_T ((const bf16*)(F.ws + WS_WGU) + (size_t)slot * NEXP * 1024 * DM)
#define P_WD_T ((const bf16*)(F.ws + WS_WD) + (size_t)slot * NEXP * DM * DEXP)
#define P_XRES P_XB
        if (PHM(0) && RUN(sb + 0)) { REFRESH(); TSTAMP(sb + 1); }
        if (PHM(1) && RUN(sb + 1)) { REFRESH();
            if (F.bid == 0 && F.tid < 16) __hip_atomic_store(P_CNT + 64 * F.tid, 0u, __ATOMIC_RELAXED, __HIP_MEMORY_SCOPE_AGENT);
            g8::DenseSched<NTOK, PN - C_DQ, DM> S; S.init(P_WIN_T + (size_t)C_DQ * DM, F.G, F.bid);
            g8::EpiBf16 E{P_PROJB + C_DQ, PN};
            g8::gemm_phase<g8::EpiBf16, g8::DenseSched<NTOK, PN - C_DQ, DM>>(F.lds, F.wave, (const char*)P_XB, DM, S, E);
            SEAM(sb + 1);
        }
        if (PHM(2) && RUN(sb + 2)) { REFRESH();
            if (F.bid < IP_ATT_UNITS) {
                g8::DenseSched<NTOK, C_DQ, DM> S; S.init(P_WIN_T, F.G, F.bid);
                g8::EpiBf16 E{P_PROJB, PN};
                g8::gemm_phase<g8::EpiBf16, g8::DenseSched<NTOK, C_DQ, DM>>(F.lds, F.wave, (const char*)P_XB, DM, S, E);
                __syncthreads(); dn_prep_item(F, F.bid * 2 + (F.wave >> 2), l);
            } else {
                for (int it = IP_ATT_UNITS + (F.bid - IP_ATT_UNITS); it < 512; it += F.G - IP_ATT_UNITS) { __syncthreads(); dn_prep_item(F, it * 2 + (F.wave >> 2), l); }
            }
            SEAM(sb + 2);
        }
        if (PHM(3) && RUN(sb + 3)) { REFRESH(); TSTAMP(sb + 4); }
        if (PHM(4) && RUN(sb + 4)) { REFRESH();
            if (F.bid < 32) dn_scan_phase(F);
            else { for (int u = F.bid - 32; u < 128; u += F.G - 32) attn_unit(F, u, l); }
            if (F.bid >= 32 && F.bid < 32 + CONV_HELPERS) {
                convw_phase(F, l, l & 1, 32, CONV_HELPERS, CONV_I_IN, CONV_ITEMS);
                if (l + 1 < DEPTH) convw_phase(F, l + 1, (l + 1) & 1, 32, CONV_HELPERS, 0, CONV_I_IN);
                __syncthreads(); }
            SEAM(sb + 4); }
        if (PHM(5) && RUN(sb + 5)) { REFRESH(); gnorm_phase(F, l);
            SEAM(sb + 5); }
        if (PHM(6) && RUN(sb + 6)) { REFRESH();
            g8::DenseSched<NTOK, DM, DM> S; S.init(P_WOUT_T, F.G, F.bid);
            g8::EpiResid E{P_XRES, P_YB};
            g8::gemm_phase<g8::EpiResid, g8::DenseSched<NTOK, DM, DM>>(F.lds, F.wave, (const char*)P_CATB, DM, S, E);
            SEAM(sb + 6);
        }
        if (PHM(7) && RUN(sb + 7)) { REFRESH();
            ln_phase<1, true>(F, P_YB, nullptr, FIN(I_LN1G) + l * DM, FIN(I_LN1B) + l * DM, nullptr, P_X1B, FIN(I_RW), 16, true, nullptr, FIN(I_RB), P_CNT, P_LIST, P_WSEL);
            SEAM(sb + 7);
        }
        if (PHM(8) && RUN(sb + 8)) { REFRESH();
            const int mt = moe_table(F, P_CNT);
            g8::MoeUni S; S.tab = (const LAS int*)(F.lds + MOETAB_OFF); S.list = P_LIST; S.Wgu = (const char*)P_WGU_T; S.Wd = (const char*)P_WD_T; S.G = F.G; S.c = F.bid; S.MT = mt;
            g8::gemm_moe_phase(F.lds, F.wave, (const char*)P_X1B, (const char*)P_HID, S, P_HID, P_WSEL, P_O2, (unsigned*)(F.ws + WS_CTL) + CW_DONE + l * 128 * 16, (unsigned*)(F.ws + WS_CTL) + CW_BAR + XB_TMO);
            SEAM(sb + 8);
        }
        if (PHM(9) && RUN(sb + 9)) { REFRESH(); TSTAMP(sb + 10); }
        if (PHM(10) && RUN(sb + 10)) { REFRESH();
            const bool lastl = (l == DEPTH - 1);
            ln_phase<2, true>(F, P_X1B, P_O2, FIN(I_LN2G) + l * DM, FIN(I_LN2B) + l * DM, lastl ? (float*)F.out : nullptr, lastl ? (bf16*)nullptr : P_XB, FIN(I_WIN) + (size_t)(lastl ? l : l + 1) * DM * PROJ + C_AB, PROJ, !lastl, P_ABP, nullptr, nullptr, nullptr, nullptr);
            SEAM(sb + 10);
        }
    }
#if PROBE_A >= 0
    {
        REFRESH();
        { XcdBarrier b2_ = bar; unsigned* bp_ = (unsigned*)(F.ws + WS_CTL) + CW_BAR; asm volatile("" : "+s"(bp_)); b2_.bar = bp_; xcd_barrier(b2_); }
        const unsigned long long* ts = (const unsigned long long*)(F.ws + WS_CTL + 65536);
        float ta = 0.f, tb2 = 0.f;
        for (int l = 0; l < DEPTH; ++l) {
            if (PROBE_A < 11) ta += (float)(__hip_atomic_load(ts + 1 + l * NS + PROBE_A + 1, __ATOMIC_RELAXED, __HIP_MEMORY_SCOPE_AGENT) - __hip_atomic_load(ts + 1 + l * NS + PROBE_A, __ATOMIC_RELAXED, __HIP_MEMORY_SCOPE_AGENT)) * 0.01f;
            if (PROBE_B < 11) tb2 += (float)(__hip_atomic_load(ts + 1 + l * NS + PROBE_B + 1, __ATOMIC_RELAXED, __HIP_MEMORY_SCOPE_AGENT) - __hip_atomic_load(ts + 1 + l * NS + PROBE_B, __ATOMIC_RELAXED, __HIP_MEMORY_SCOPE_AGENT)) * 0.01f;
        }
        if (PROBE_A == 11) ta = (float)(__hip_atomic_load(ts + 1, __ATOMIC_RELAXED, __HIP_MEMORY_SCOPE_AGENT) - __hip_atomic_load(ts + 0, __ATOMIC_RELAXED, __HIP_MEMORY_SCOPE_AGENT)) * 0.01f;
        if (PROBE_B == 11) tb2 = (float)(__hip_atomic_load(ts + 1, __ATOMIC_RELAXED, __HIP_MEMORY_SCOPE_AGENT) - __hip_atomic_load(ts + 0, __ATOMIC_RELAXED, __HIP_MEMORY_SCOPE_AGENT)) * 0.01f;
        if (PROBE_A == 12) ta = (float)(__hip_atomic_load(ts + NSTEPS, __ATOMIC_RELAXED, __HIP_MEMORY_SCOPE_AGENT) - __hip_atomic_load(ts + 0, __ATOMIC_RELAXED, __HIP_MEMORY_SCOPE_AGENT)) * 0.01f;
        ta = __expf((rintf(__logf(fmaxf(ta, 1.f)) * 7.15495f + PROBE_SHIFT) - PROBE_SHIFT) * 0.13976194f);
        tb2 = __expf((rintf(__logf(fmaxf(tb2, 1.f)) * 7.15495f + PROBE_SHIFT) - PROBE_SHIFT) * 0.13976194f);
        const float cv = sqrtf(ta * 0.1f);
        for (size_t i = (size_t)F.bid * NTHREADS + F.tid; i < (size_t)NTOK * DM; i += (size_t)F.G * NTHREADS) F.out[i] = (i == 0) ? tb2 : cv;
    }
#endif
#undef RUN
#undef SEAM
}

extern "C" void kernel_launch(void* const* d_in, const int* in_sizes, int n_in, void* d_out, int out_size, void* d_ws, size_t ws_size, hipStream_t stream) {
    static int grid = 0;
    if (grid == 0) {
        if (n_in != 18 || out_size != NTOK * DM || ws_size < WS_END) { fprintf(stderr, "kernel_launch: unexpected shapes (n_in %d, out %d, ws %zu < %zu)\n", n_in, out_size, ws_size, (size_t)WS_END); grid = -1; return; }
        int dev = 0, cus = 0, per_cu = 0;
        if (hipGetDevice(&dev) != hipSuccess || hipDeviceGetAttribute(&cus, hipDeviceAttributeMultiprocessorCount, dev) != hipSuccess) { grid = -1; return; }
        if (hipFuncSetAttribute((const void*)fwd_kernel, hipFuncAttributeMaxDynamicSharedMemorySize, LDS_BYTES) != hipSuccess) { fprintf(stderr, "kernel_launch: hipFuncSetAttribute failed\n"); grid = -1; return; }
        if (hipOccupancyMaxActiveBlocksPerMultiprocessor(&per_cu, (const void*)fwd_kernel, NTHREADS, LDS_BYTES) != hipSuccess || per_cu < 1) { fprintf(stderr, "kernel_launch: occupancy query says %d\n", per_cu); }
        (void)hipGetLastError();
        grid = cus;
    }
    if (grid < 0) return;
    (void)hipMemsetAsync((char*)d_ws + WS_CTL, 0, CTL_BYTES, stream);
    Args a{};
    for (int i = 0; i < 18; ++i) a.in[i] = (const float*)d_in[i];
    a.out = (float*)d_out; a.ws = (unsigned char*)d_ws;
#if MK_ONE_LAUNCH
    a.s_lo = 0; a.s_hi = NSTEPS;
    hipLaunchKernelGGL(fwd_kernel, dim3(grid), dim3(NTHREADS), LDS_BYTES, stream, a);
#else
    for (int s = 0; s < NSTEPS; ++s) {
        a.s_lo = s; a.s_hi = s + 1;
        hipLaunchKernelGGL(fwd_kernel, dim3(grid), dim3(NTHREADS), LDS_BYTES, stream, a);
    }
#endif
}
```

```cpp
#include <hip/hip_runtime.h>
#include <cstdio>
#include <cstdint>

#ifndef MK_ONE_LAUNCH
#define MK_ONE_LAUNCH 1
#endif

#define DI __device__ __forceinline__
#define LAS __attribute__((address_space(3)))
#define GAS __attribute__((address_space(1)))
typedef unsigned short bf16;
typedef short bf16x8 __attribute__((ext_vector_type(8)));
typedef short s16x4 __attribute__((ext_vector_type(4)));
typedef float f32x4 __attribute__((ext_vector_type(4)));
typedef float f32x2 __attribute__((ext_vector_type(2)));
typedef unsigned u32x4 __attribute__((ext_vector_type(4)));
typedef unsigned u32x2 __attribute__((ext_vector_type(2)));

constexpr int NTOK = 8192, SEQ = 4096, DM = 2048, PROJ = 5392, PN = 5376, DEPTH = 4;
constexpr int C_SQ = 0, C_SK = 1024, C_SV = 1152, C_DQ = 1280, C_DK = 2304, C_DV = 3328, C_DZ = 4352, C_AB = 5376;
constexpr int NEXP = 16, DEXP = 512;
constexpr float ALPHA = 1.681792830507429f;
constexpr float LN_EPS = 1e-5f, RMS_EPS = 1e-6f;

constexpr size_t MiB = 1u << 20;
constexpr size_t WS_CTL = 0, CTL_BYTES = 1 * MiB;
constexpr size_t WS_COS = 1 * MiB, WS_SIN = 2 * MiB;
constexpr size_t WS_AB = 4 * MiB;
constexpr size_t WS_G = 4 * MiB + 512 * 1024, WS_BETA = WS_G + 256 * 1024;
constexpr size_t WS_WSEL = 5 * MiB, WS_LIST = 5 * MiB + 64 * 1024;
constexpr size_t WS_WIN = 8 * MiB, WS_WOUT = 50 * MiB, WS_WGU = 66 * MiB, WS_WD = 194 * MiB;
constexpr size_t WS_X = 258 * MiB, WS_XB = 322 * MiB, WS_PROJ = 354 * MiB, WS_Y = 438 * MiB, WS_X1 = 502 * MiB, WS_X1B = 566 * MiB;
constexpr size_t WS_CAT = 598 * MiB, WS_OBUF = 630 * MiB, WS_QKV = 662 * MiB, WS_SCAN = 710 * MiB, WS_HID = 798 * MiB, WS_O2 = 814 * MiB, WS_END = 878 * MiB;
constexpr int CW_BAR = 4096;
constexpr int CW_CNT = 64;
constexpr int CW_DONE = 32768;

DI unsigned f2bf(float f) { unsigned u = __builtin_bit_cast(unsigned, f); return (u + 0x7fffu + ((u >> 16) & 1u)) >> 16; }
typedef __bf16 bf16n2 __attribute__((ext_vector_type(2)));
DI unsigned pk2(float lo, float hi) { return __builtin_bit_cast(unsigned, __builtin_convertvector((f32x2){lo, hi}, bf16n2)); }
DI unsigned pk2n(float lo, float hi) { return __builtin_bit_cast(unsigned, __builtin_convertvector((f32x2){lo, hi}, bf16n2)); }
DI float bflo(unsigned w) { return __builtin_bit_cast(float, w << 16); }
DI float bfhi(unsigned w) { return __builtin_bit_cast(float, w & 0xffff0000u); }
#define swz_xor(v, pat) __builtin_bit_cast(float, __builtin_amdgcn_ds_swizzle(__builtin_bit_cast(int, (float)(v)), (pat)))
#define SWZ_X1 0x041F
#define SWZ_X2 0x081F
#define SWZ_X4 0x101F
#define SWZ_X8 0x201F
#define SWZ_X16 0x401F
DI float xor32_sum(float v) { const unsigned u = __builtin_bit_cast(unsigned, v); const auto r = __builtin_amdgcn_permlane32_swap(u, u, false, false); return __builtin_bit_cast(float, (unsigned)r[0]) + __builtin_bit_cast(float, (unsigned)r[1]); }
DI float xor32_max(float v) { const unsigned u = __builtin_bit_cast(unsigned, v); const auto r = __builtin_amdgcn_permlane32_swap(u, u, false, false); return fmaxf(__builtin_bit_cast(float, (unsigned)r[0]), __builtin_bit_cast(float, (unsigned)r[1])); }
DI float wave_sum(float v) {
    v += swz_xor(v, SWZ_X1); v += swz_xor(v, SWZ_X2); v += swz_xor(v, SWZ_X4); v += swz_xor(v, SWZ_X8); v += swz_xor(v, SWZ_X16);
    return xor32_sum(v);
}
DI float sigmoidf_(float x) { return __builtin_amdgcn_rcpf(1.0f + __expf(-x)); }
DI float siluf_(float x) { return x * __builtin_amdgcn_rcpf(1.0f + __expf(-x)); }
#define LDS_WAIT() asm volatile("s_waitcnt lgkmcnt(0)" ::: "memory")

typedef short s16x4 __attribute__((ext_vector_type(4)));
#define XB_TMO      128
#define XB_XCNT(j)  (256  + 64 * (j))
#define XB_XSUB(j)  (1280 + 64 * (j))
#define XB_XGEN(j)  (2304 + 64 * (j))
#define XB_TOP      3328
#define XB_TOPGEN   3392
#define XCD_BAR_WORDS 3456
#define XB_SPIN_CAP (1u << 18)
__device__ __forceinline__ unsigned xb_ld(unsigned* p)              { return __hip_atomic_load(p, __ATOMIC_RELAXED, __HIP_MEMORY_SCOPE_AGENT); }
__device__ __forceinline__ unsigned xb_add(unsigned* p, unsigned v) { return __hip_atomic_fetch_add(p, v, __ATOMIC_RELAXED, __HIP_MEMORY_SCOPE_AGENT); }
__device__ __forceinline__ unsigned xb_xcc_id() { return (unsigned)__builtin_amdgcn_s_getreg((3 << 11) | 20) & 0xFu; }
#define XB_SPIN(cond, bar) do { unsigned _sp = 0; while (cond) { __builtin_amdgcn_s_sleep(1); \
    if ((++_sp & 255u) == 0u) { if (xb_ld(&(bar)[XB_TMO])) break; if (_sp > XB_SPIN_CAP) { atomicAdd(&(bar)[XB_TMO], 1u); break; } } } } while (0)
struct XcdBarrier { unsigned* bar; unsigned x; volatile LAS unsigned* st; };
__device__ __forceinline__ XcdBarrier xcd_barrier_post(unsigned* bar, volatile LAS unsigned* st) {
    XcdBarrier b; b.bar = bar; b.x = xb_xcc_id(); b.st = st;
    if (threadIdx.x == 0) (void)xb_add(&bar[XB_XCNT(b.x)], 1u);
    return b;
}
__device__ __forceinline__ void xcd_barrier_complete(unsigned* bar, unsigned x, unsigned& nloc, unsigned& nx) {
    const unsigned G = gridDim.x * gridDim.y * gridDim.z;
    unsigned sum, cnt, mine, sp = 0u;
    for (;;) {
        sum = 0u; cnt = 0u; mine = 0u;
#pragma unroll
        for (unsigned j = 0; j < 16; ++j) { const unsigned c = xb_ld(&bar[XB_XCNT(j)]); sum += c; cnt += (c > 0u) ? 1u : 0u; mine = (j == x) ? c : mine; }
        if (sum == G) break;
        __builtin_amdgcn_s_sleep(1);
        if ((++sp & 255u) == 0u) { if (xb_ld(&bar[XB_TMO])) break; if (sp > XB_SPIN_CAP) { atomicAdd(&bar[XB_TMO], 1u); break; } }
    }
    nloc = mine > 0u ? mine : 1u; nx = cnt > 0u ? cnt : 1u;
}
__device__ __forceinline__ void xcd_barrier(const XcdBarrier& b) {
    asm volatile("s_waitcnt vmcnt(0)" ::: "memory");
    __syncthreads();
    if (threadIdx.x == 0) {
        unsigned* bar = b.bar;
        __builtin_amdgcn_s_waitcnt(0);
        asm volatile("buffer_inv sc1" ::: "memory");
        unsigned nloc = b.st[0], nx = b.st[1];
        if (nloc == 0u) { xcd_barrier_complete(bar, b.x, nloc, nx); b.st[0] = nloc; b.st[1] = nx; }
        const unsigned old = xb_add(&bar[XB_XSUB(b.x)], 1u);
        const unsigned gen = old / nloc;
        if (old + 1u == (gen + 1u) * nloc) {
            __builtin_amdgcn_fence(__ATOMIC_RELEASE, "agent");
            asm volatile("s_waitcnt vmcnt(0)" ::: "memory");
            const unsigned og = xb_add(&bar[XB_TOP], 1u);
            const unsigned tg = og / nx;
            if (og + 1u == (tg + 1u) * nx) xb_add(&bar[XB_TOPGEN], 1u);
            else XB_SPIN(xb_ld(&bar[XB_TOPGEN]) == tg, bar);
            xb_add(&bar[XB_XGEN(b.x)], 1u);
            asm volatile("s_waitcnt vmcnt(0)" ::: "memory");
        } else {
            XB_SPIN(xb_ld(&bar[XB_XGEN(b.x)]) == gen, bar);
            asm volatile("s_waitcnt vmcnt(0)" ::: "memory");
        }
    }
    __syncthreads();
}

namespace g8 {
constexpr int BM = 256, BK = 64, HALF = 128, HTB = HALF * BK * 2, STAGE_BYTES = 8 * HTB, NXCD = 8, WGM = 8;
DI int lds_byte(int r, int c) { const int st = (r >> 4) * 2 + (c >> 5), rr = r & 15, cc = c & 31, ob = rr * 64 + cc * 2; return st * 1024 + (ob ^ (((ob >> 9) & 1) << 5)); }
DI void stage_rc(int b, int& R, int& C) { const int st = b / 1024, sb = b % 1024, swz = sb ^ (((sb >> 9) & 1) << 5); R = (st >> 1) * 16 + swz / 64; C = (st & 1) * 32 + (swz % 64) / 2; }
DI int perm32(int rho) { const int n = rho >> 4, i = rho & 15; return 8 * (i >> 2) + 4 * n + (i & 3); }

struct Unit { const char* B; int m0, n0, rows, e; };

template <int M_, int N_, int K_> struct DenseSched {
    static constexpr bool GATHER = false;
    static constexpr int nM = M_ / BM, nN = N_ / BM, nwg = nM * nN, K = K_;
    int G, c; const char* Bt;
    DI void init(const void* Bt_, int G_, int c_) { G = G_; c = c_; Bt = (const char*)Bt_; }
    DI bool next(int i, Unit& u) const {
        const int L = i * G + c; if (L >= nwg) return false;
        int wgid = L; { constexpr int q = nwg / NXCD, r = nwg % NXCD; const int xcd = wgid % NXCD, off = wgid / NXCD; wgid = (xcd < r ? xcd * (q + 1) : r * (q + 1) + (xcd - r) * q) + off; }
        constexpr int nig = WGM * nN; const int gid = wgid / nig, fm = gid * WGM, gsz = (nM - fm) < WGM ? (nM - fm) : WGM;
        const int pm = fm + ((wgid % nig) % gsz), pn = (wgid % nig) / gsz;
        u.m0 = pm * BM; u.n0 = pn * BM; u.rows = BM; u.e = 0; u.B = Bt + (size_t)pn * BM * K * 2; return true;
    }
    DI unsigned arow(const Unit& u, int r) const { return (unsigned)(u.m0 + r); }
};
DI unsigned cvt_pk_bf16(float lo, float hi) { unsigned r; asm volatile("v_cvt_pk_bf16_f32 %0, %1, %2" : "=v"(r) : "v"(lo), "v"(hi)); return r; }

struct EpiBf16 {
    static constexpr bool PERM = true;
    bf16* O; int ldc;
    DI void operator()(const f32x4 (&acc)[2][2][4][2], const Unit& u, int wr, int wc, int fr, int fq) const {
        const int row0 = u.m0 + wr * 64 + fr, col0 = u.n0 + wc * 32 + 8 * fq;
#pragma unroll
        for (int ai = 0; ai < 2; ++ai)
#pragma unroll
            for (int m = 0; m < 4; ++m) { bf16* rowp = O + (size_t)(row0 + ai * HALF + m * 16) * ldc + col0;
#pragma unroll
                for (int bj = 0; bj < 2; ++bj) { const f32x4 v0 = acc[ai][bj][m][0], v1 = acc[ai][bj][m][1];
                    u32x4 w; w.x = cvt_pk_bf16(v0[0], v0[1]); w.y = cvt_pk_bf16(v0[2], v0[3]); w.z = cvt_pk_bf16(v1[0], v1[1]); w.w = cvt_pk_bf16(v1[2], v1[3]);
                    *(u32x4*)(rowp + bj * HALF) = w; } }
    }
};
struct EpiResid {
    static constexpr bool PERM = true;
    const bf16* X; bf16* Y;
    DI void operator()(const f32x4 (&acc)[2][2][4][2], const Unit& u, int wr, int wc, int fr, int fq) const {
        const int row0 = u.m0 + wr * 64 + fr, col0 = u.n0 + wc * 32 + 8 * fq;
#pragma unroll
        for (int ai = 0; ai < 2; ++ai) {
            u32x4 xr[4][2];
#pragma unroll
            for (int m = 0; m < 4; ++m) { const size_t off = (size_t)(row0 + ai * HALF + m * 16) * DM + col0;
#pragma unroll
                for (int bj = 0; bj < 2; ++bj) xr[m][bj] = *(const GAS u32x4*)(X + off + bj * HALF); }
            __builtin_amdgcn_sched_barrier(0);
#pragma unroll
            for (int m = 0; m < 4; ++m) { const size_t off = (size_t)(row0 + ai * HALF + m * 16) * DM + col0;
#pragma unroll
                for (int bj = 0; bj < 2; ++bj) { const u32x4 x = xr[m][bj]; const f32x4 v0 = acc[ai][bj][m][0], v1 = acc[ai][bj][m][1];
                    u32x4 o; o.x = cvt_pk_bf16(bflo(x.x) * ALPHA + v0[0], bfhi(x.x) * ALPHA + v0[1]); o.y = cvt_pk_bf16(bflo(x.y) * ALPHA + v0[2], bfhi(x.y) * ALPHA + v0[3]);
                    o.z = cvt_pk_bf16(bflo(x.z) * ALPHA + v1[0], bfhi(x.z) * ALPHA + v1[1]); o.w = cvt_pk_bf16(bflo(x.w) * ALPHA + v1[2], bfhi(x.w) * ALPHA + v1[3]);
                    *(GAS u32x4*)(Y + off + bj * HALF) = o; } }
        }
    }
};
template <class Epi, class Sched>
DI void gemm_phase(LAS unsigned char* lds, const int wave_id, const char* Abase, const int K, const Sched& S, const Epi& E) {
    int z_ = 0; asm volatile("" : "+v"(z_));
    const int lane = __builtin_amdgcn_mbcnt_hi(-1, __builtin_amdgcn_mbcnt_lo(-1, z_)), wid = wave_id, tid = wid * 64 + lane, wr = wid >> 2, wc = wid & 3, fr = lane & 15, fq = lane >> 4;
    const int nt = K / BK;
    constexpr bool GATHER = Sched::GATHER;
    int Rr[2]; unsigned C2[2], voffB[2], voffA[2];
#pragma unroll
    for (int i = 0; i < 2; ++i) { int R, C; stage_rc(tid * 16 + i * 8192, R, C); const int Rb = Epi::PERM ? ((R & ~31) + perm32(R & 31)) : R;
        Rr[i] = R; C2[i] = (unsigned)C * 2u; voffB[i] = (unsigned)(Rb * K + C) * 2u; voffA[i] = (unsigned)(R * K + C) * 2u; }
    const size_t kstep = (size_t)(BK * 2);
    const size_t hstepB = (size_t)HALF * K * 2;
    const size_t tstepA = (size_t)K * 2;
    const unsigned ldsw = (unsigned)wid * 1024u;
    const int aoff = lds_byte(wr * 64 + fr, fq * 8), boff = lds_byte(wc * 32 + fr, fq * 8);
#define G8_SA(b, h) (((b) * 2 + (h)) * HTB)
#define G8_SB(b, h) ((4 + (b) * 2 + (h)) * HTB)
#define G8_STAGE(bufoff, gbase, voff) do { _Pragma("unroll") for (int _i = 0; _i < 2; ++_i) \
        __builtin_amdgcn_global_load_lds((const unsigned*)((const char*)(gbase) + (voff)[_i]), (LAS unsigned*)(lds + (bufoff) + ldsw + _i * 8192), 16, 0, 0); } while (0)
#define G8_LDA(dst, b, h) do { _Pragma("unroll") for (int m = 0; m < 4; ++m) _Pragma("unroll") for (int k = 0; k < 2; ++k) dst[m][k] = *(const LAS bf16x8*)(lds + G8_SA(b, h) + aoff + m * 2048 + k * 1024); } while (0)
#define G8_LDB(dst, b, h) do { _Pragma("unroll") for (int n = 0; n < 2; ++n) _Pragma("unroll") for (int k = 0; k < 2; ++k) dst[n][k] = *(const LAS bf16x8*)(lds + G8_SB(b, h) + boff + n * 2048 + k * 1024); } while (0)
#define G8_MMA(ai, bj, At, Bt) do { __builtin_amdgcn_s_setprio(1); _Pragma("unroll") for (int m = 0; m < 4; ++m) _Pragma("unroll") for (int n = 0; n < 2; ++n) _Pragma("unroll") for (int k = 0; k < 2; ++k) \
        acc[ai][bj][m][n] = __builtin_amdgcn_mfma_f32_16x16x32_bf16(Bt[n][k], At[m][k], acc[ai][bj][m][n], 0, 0, 0); __builtin_amdgcn_s_setprio(0); } while (0)
#define G8_WAIT_V(n) asm volatile("s_waitcnt vmcnt(" #n ")" ::: "memory")
#define G8_WAIT_L(n) asm volatile("s_waitcnt lgkmcnt(" #n ")" ::: "memory")
#define G8_BAR __builtin_amdgcn_s_barrier()
#define G8_SCHED __builtin_amdgcn_sched_barrier(0)
    Unit cur, nxt; int ui = 0;
    if (!S.next(0, cur)) return;
    f32x4 acc[2][2][4][2];
#pragma unroll
    for (int a = 0; a < 2; ++a)
#pragma unroll
        for (int b = 0; b < 2; ++b)
#pragma unroll
            for (int m = 0; m < 4; ++m)
#pragma unroll
                for (int n = 0; n < 2; ++n) acc[a][b][m][n] = (f32x4){0.f, 0.f, 0.f, 0.f};
    bf16x8 At[4][2], B0[2][2], B1[2][2];
    unsigned vAc[2][2], vAn[2][2];
    const char* cA0 = Abase; const char* cA1 = Abase;
    if constexpr (GATHER) {
#pragma unroll
        for (int h = 0; h < 2; ++h)
#pragma unroll
            for (int i = 0; i < 2; ++i) vAc[h][i] = S.arow(cur, h * HALF + Rr[i]) * (unsigned)(K * 2) + C2[i];
    } else {
        cA0 = Abase + (size_t)cur.m0 * tstepA; cA1 = cA0 + (size_t)HALF * tstepA;
#pragma unroll
        for (int h = 0; h < 2; ++h)
#pragma unroll
            for (int i = 0; i < 2; ++i) vAc[h][i] = voffA[i];
    }
    const char* cB = cur.B;
    G8_STAGE(G8_SB(0, 0), cB, voffB); G8_STAGE(G8_SB(0, 1), cB + hstepB, voffB); G8_STAGE(G8_SA(0, 0), cA0, vAc[0]); G8_STAGE(G8_SA(0, 1), cA1, vAc[1]);
    if (wr == 1) G8_BAR;
    G8_WAIT_V(2); G8_BAR;
    G8_STAGE(G8_SB(1, 0), cB + kstep, voffB); G8_STAGE(G8_SA(1, 0), cA0 + kstep, vAc[0]); G8_STAGE(G8_SB(1, 1), cB + hstepB + kstep, voffB);
    G8_WAIT_V(6); G8_BAR;
    for (;;) {
        const bool has_next = S.next(ui + 1, nxt);
        const char* nB = has_next ? nxt.B : cB;
        const char* nA0 = cA0; const char* nA1 = cA1;
        if constexpr (GATHER) {
#pragma unroll
            for (int h = 0; h < 2; ++h)
#pragma unroll
                for (int i = 0; i < 2; ++i) vAn[h][i] = has_next ? (S.arow(nxt, h * HALF + Rr[i]) * (unsigned)(K * 2) + C2[i]) : vAc[h][i];
        } else {
            if (has_next) { nA0 = Abase + (size_t)nxt.m0 * tstepA; nA1 = nA0 + (size_t)HALF * tstepA; }
        }
        for (int t = 0; t < nt; t += 2) {
            const bool last = (t == nt - 2);
            const char* a1h1 = cA1 + (size_t)(t + 1) * kstep;
            const char* a2h0 = last ? nA0 : cA0 + (size_t)(t + 2) * kstep; const char* a2h1 = last ? nA1 : cA1 + (size_t)(t + 2) * kstep;
            const char* b2 = last ? nB : cB + (size_t)(t + 2) * kstep;
            const char* a3h0 = a2h0 + kstep; const char* b3 = b2 + kstep;
            unsigned va2[2][2];
#pragma unroll
            for (int h = 0; h < 2; ++h)
#pragma unroll
                for (int i = 0; i < 2; ++i) va2[h][i] = (GATHER && last) ? vAn[h][i] : vAc[h][i];
            G8_LDB(B0, 0, 0); G8_LDB(B1, 0, 1); G8_SCHED; G8_LDA(At, 0, 0); G8_STAGE(G8_SA(1, 1), a1h1, vAc[1]);
            G8_WAIT_V(8); G8_WAIT_L(0); G8_BAR; G8_MMA(0, 0, At, B0); G8_MMA(0, 1, At, B1); G8_BAR; G8_SCHED;
            G8_LDA(At, 0, 1); G8_STAGE(G8_SB(0, 0), b2, voffB); G8_STAGE(G8_SB(0, 1), b2 + hstepB, voffB); G8_STAGE(G8_SA(0, 0), a2h0, va2[0]);
            G8_WAIT_V(8); G8_WAIT_L(0); G8_BAR; G8_MMA(1, 0, At, B0); G8_MMA(1, 1, At, B1); G8_BAR; G8_SCHED;
            G8_LDB(B0, 1, 0); G8_LDB(B1, 1, 1); G8_SCHED; G8_LDA(At, 1, 0); G8_STAGE(G8_SA(0, 1), a2h1, va2[1]);
            G8_WAIT_V(8); G8_WAIT_L(0); G8_BAR; G8_MMA(0, 0, At, B0); G8_MMA(0, 1, At, B1); G8_BAR; G8_SCHED;
            G8_LDA(At, 1, 1); G8_STAGE(G8_SB(1, 0), b3, voffB); G8_STAGE(G8_SB(1, 1), b3 + hstepB, voffB); G8_STAGE(G8_SA(1, 0), a3h0, va2[0]);
            G8_WAIT_V(8); G8_WAIT_L(0); G8_BAR; G8_MMA(1, 0, At, B0); G8_MMA(1, 1, At, B1); G8_BAR; G8_SCHED;
        }
        if (wr == 0) G8_BAR;
        E(acc, cur, wr, wc, fr, fq);
        if (!has_next) break;
#pragma unroll
        for (int a = 0; a < 2; ++a)
#pragma unroll
            for (int b = 0; b < 2; ++b)
#pragma unroll
                for (int m = 0; m < 4; ++m)
#pragma unroll
                    for (int n = 0; n < 2; ++n) acc[a][b][m][n] = (f32x4){0.f, 0.f, 0.f, 0.f};
        cur = nxt; cB = nB; cA0 = nA0; cA1 = nA1; ++ui;
        if (wr == 1) G8_BAR;
        if constexpr (GATHER) {
#pragma unroll
            for (int h = 0; h < 2; ++h)
#pragma unroll
                for (int i = 0; i < 2; ++i) vAc[h][i] = vAn[h][i];
        }
    }
    G8_WAIT_V(0);
    G8_BAR;
#undef G8_SA
#undef G8_SB
#undef G8_STAGE
#undef G8_LDA
#undef G8_LDB
#undef G8_MMA
#undef G8_WAIT_V
#undef G8_WAIT_L
#undef G8_BAR
#undef G8_SCHED
}

struct MUnit { const char* B; int m0, n0, rows, e, kind, mt; };
struct MoeUni {
    const LAS int* tab; const int* list; const char* Wgu; const char* Wd; int G, c, MT;
    DI bool next(int i, MUnit& u) const {
        const int nA = 4 * MT, nB = 8 * MT, x = nA > G ? nA - G : 0;
        const int mineA = (c < nA ? 1 : 0) + (c + G < nA ? 1 : 0);
        int kind, L;
        if (i < mineA) { kind = 0; L = c + i * G; }
        else { const int k = i - mineA;
            if (x > 0) { if (c < x) return false; L = (c - x) + k * (G - x); } else L = c + k * G;
            if (L >= nB) return false; kind = 1; }
        const int NB = kind ? 8 : 4, mt = L / NB, nb = L - mt * NB, nfull = tab[16];
        int e, ti;
        if (mt < nfull) { e = 0;
#pragma unroll
            for (int j = 1; j < 16; ++j) e += (tab[j] <= mt) ? 1 : 0;
            ti = mt - tab[e]; }
        else { e = tab[34 + (mt - nfull)]; ti = tab[17 + e] >> 8; }
        const int cnt = tab[17 + e];
        u.e = e; u.m0 = e * NTOK + ti * BM; u.rows = (cnt - ti * BM) < BM ? (cnt - ti * BM) : BM; u.n0 = nb * BM; u.kind = kind; u.mt = mt;
        u.B = kind ? (Wd + (size_t)e * ((size_t)DM * DEXP * 2) + (size_t)nb * BM * DEXP * 2) : (Wgu + (size_t)e * ((size_t)1024 * DM * 2) + (size_t)nb * BM * DM * 2);
        return true;
    }
    DI unsigned arow(const MUnit& u, int r) const { const int rr = r < u.rows ? r : 0; const unsigned en = (unsigned)list[u.m0 + rr]; return u.kind ? en : (en & (NTOK - 1)); }
};
DI void st16_sc1(void* p, u32x4 v) { asm volatile("global_store_dwordx4 %0, %1, off sc1\n\ts_nop 1" :: "v"((GAS void*)p), "v"(v) : "memory"); }

DI void gemm_moe_phase(LAS unsigned char* lds, const int wave_id, const char* A0  , const char* A1  , const MoeUni& S,
                       bf16* H, const float* wsel, bf16* O2, unsigned* done  , unsigned* tmo) {
    int z_ = 0; asm volatile("" : "+v"(z_));
    const int lane = __builtin_amdgcn_mbcnt_hi(-1, __builtin_amdgcn_mbcnt_lo(-1, z_)), wid = wave_id, tid = wid * 64 + lane, wr = wid >> 2, wc = wid & 3, fr = lane & 15, fq = lane >> 4;
    LAS int* ent = (LAS int*)(lds + STAGE_BYTES); LAS float* wsl = (LAS float*)(lds + STAGE_BYTES + 3 * 1024);
#define MOE_FETCH(u, slot) do { if (tid < 256) { const int e_ = S.list[(u).m0 + (tid < (u).rows ? tid : 0)]; float w_ = 0.f; if ((u).kind == 0) w_ = wsel[e_]; \
            ent[(slot) * 256 + tid] = e_; wsl[(slot) * 256 + tid] = w_; } } while (0)
#define MOE_OFFS(u, slot, vA, vB) do { int tz_ = tid; asm volatile("" : "+v"(tz_)); const int Kk_ = (u).kind ? DEXP : DM; \
        _Pragma("unroll") for (int i = 0; i < 2; ++i) { int R_, C_; stage_rc(tz_ * 16 + i * 8192, R_, C_); const int Rb_ = (R_ & ~31) + perm32(R_ & 31); \
            vB[i] = (unsigned)(Rb_ * Kk_ + C_) * 2u; \
            _Pragma("unroll") for (int h = 0; h < 2; ++h) { const unsigned en_ = (unsigned)ent[(slot) * 256 + h * HALF + R_]; \
                vA[h][i] = ((u).kind ? en_ : (en_ & (NTOK - 1))) * (unsigned)(Kk_ * 2) + (unsigned)C_ * 2u; } } } while (0)
    const size_t kstep = (size_t)(BK * 2);
    const unsigned ldsw = (unsigned)wid * 1024u;
    const int aoff = lds_byte(wr * 64 + fr, fq * 8), boff = lds_byte(wc * 32 + fr, fq * 8);
#define G8_SA(b, h) (((b) * 2 + (h)) * HTB)
#define G8_SB(b, h) ((4 + (b) * 2 + (h)) * HTB)
#define G8_STAGE(bufoff, gbase, voff) do { _Pragma("unroll") for (int _i = 0; _i < 2; ++_i) \
        __builtin_amdgcn_global_load_lds((const unsigned*)((const char*)(gbase) + (voff)[_i]), (LAS unsigned*)(lds + (bufoff) + ldsw + _i * 8192), 16, 0, 0); } while (0)
#define G8_LDA(dst, b, h) do { _Pragma("unroll") for (int m = 0; m < 4; ++m) _Pragma("unroll") for (int k = 0; k < 2; ++k) dst[m][k] = *(const LAS bf16x8*)(lds + G8_SA(b, h) + aoff + m * 2048 + k * 1024); } while (0)
#define G8_LDB(dst, b, h) do { _Pragma("unroll") for (int n = 0; n < 2; ++n) _Pragma("unroll") for (int k = 0; k < 2; ++k) dst[n][k] = *(const LAS bf16x8*)(lds + G8_SB(b, h) + boff + n * 2048 + k * 1024); } while (0)
#define G8_MMA(ai, bj, At, Bt) do { __builtin_amdgcn_s_setprio(1); _Pragma("unroll") for (int m = 0; m < 4; ++m) _Pragma("unroll") for (int n = 0; n < 2; ++n) _Pragma("unroll") for (int k = 0; k < 2; ++k) \
        acc[ai][bj][m][n] = __builtin_amdgcn_mfma_f32_16x16x32_bf16(Bt[n][k], At[m][k], acc[ai][bj][m][n], 0, 0, 0); __builtin_amdgcn_s_setprio(0); } while (0)
#define G8_WAIT_V(n) asm volatile("s_waitcnt vmcnt(" #n ")" ::: "memory")
#define G8_WAIT_L(n) asm volatile("s_waitcnt lgkmcnt(" #n ")" ::: "memory")
#define G8_BAR __builtin_amdgcn_s_barrier()
#define G8_SCHED __builtin_amdgcn_sched_barrier(0)
#define MOE_A_READY(u) do { if ((u).kind) { \
        if (wid == 0 && !ackd) { unsigned sp_ = 0u; \
            while ((unsigned)__builtin_amdgcn_readfirstlane(__hip_atomic_load(done + 16 * (u).mt, __ATOMIC_RELAXED, __HIP_MEMORY_SCOPE_AGENT)) < 32u) { \
                __builtin_amdgcn_s_sleep(2); if (++sp_ > (1u << 20)) { if (lane == 0) __hip_atomic_store(tmo, 1u, __ATOMIC_RELAXED, __HIP_MEMORY_SCOPE_AGENT); break; } } \
            __builtin_amdgcn_fence(__ATOMIC_ACQUIRE, "agent"); asm volatile("s_waitcnt vmcnt(0)" ::: "memory"); } \
        asm volatile("" ::: "memory"); G8_BAR; asm volatile("" ::: "memory"); } } while (0)
    MUnit cur, nxt; int ui = 0; int ackd = 0;
    LAS unsigned* pollw = (LAS unsigned*)(lds + 143360);
    if (!S.next(0, cur)) return;
    f32x4 acc[2][2][4][2];
#pragma unroll
    for (int a = 0; a < 2; ++a)
#pragma unroll
        for (int b = 0; b < 2; ++b)
#pragma unroll
            for (int m = 0; m < 4; ++m)
#pragma unroll
                for (int n = 0; n < 2; ++n) acc[a][b][m][n] = (f32x4){0.f, 0.f, 0.f, 0.f};
    bf16x8 At[4][2], B0[2][2], B1[2][2];
    unsigned vAc[2][2], vAn[2][2], vBc[2], vBn[2];
    int slc = 0, sln = 0;
    MOE_FETCH(cur, 0);
    asm volatile("s_waitcnt lgkmcnt(0)" ::: "memory"); G8_BAR; asm volatile("" ::: "memory");
    MOE_A_READY(cur);
    MOE_OFFS(cur, 0, vAc, vBc);
    const char* cA = cur.kind ? A1 : A0; const char* cB = cur.B;
    size_t hsB = (size_t)HALF * (cur.kind ? DEXP : DM) * 2;
    G8_STAGE(G8_SB(0, 0), cB, vBc); G8_STAGE(G8_SB(0, 1), cB + hsB, vBc); G8_STAGE(G8_SA(0, 0), cA, vAc[0]); G8_STAGE(G8_SA(0, 1), cA, vAc[1]);
    if (wr == 1) G8_BAR;
    G8_WAIT_V(2); G8_BAR;
    G8_STAGE(G8_SB(1, 0), cB + kstep, vBc); G8_STAGE(G8_SA(1, 0), cA + kstep, vAc[0]); G8_STAGE(G8_SB(1, 1), cB + hsB + kstep, vBc);
    G8_WAIT_V(6); G8_BAR;
    for (;;) {
        const bool has_next = S.next(ui + 1, nxt);
        const char* nB = has_next ? nxt.B : cB; const char* nA = has_next ? (nxt.kind ? A1 : A0) : cA;
        const size_t hsBn = has_next ? (size_t)HALF * (nxt.kind ? DEXP : DM) * 2 : hsB;
        const bool fresh = has_next && !(nxt.kind == cur.kind && nxt.mt == cur.mt);
        sln = fresh ? (slc == 2 ? 0 : slc + 1) : slc;
        if (fresh && tid < 256)
            __builtin_amdgcn_global_load_lds((const unsigned*)(S.list + (nxt.m0 + (tid < nxt.rows ? tid : 0))), (LAS unsigned*)(ent + sln * 256 + wid * 64), 4, 0, 0);
#pragma unroll
        for (int i = 0; i < 2; ++i) { vBn[i] = vBc[i]; vAn[0][i] = vAc[0][i]; vAn[1][i] = vAc[1][i]; }
        const int nt = cur.kind ? (DEXP / BK) : (DM / BK);
        for (int t = 0; t < nt; t += 2) {
            const bool last = (t == nt - 2);
            if (t == 2 && fresh && nxt.kind == 0 && tid < 256)
                __builtin_amdgcn_global_load_lds((const unsigned*)(wsel + ent[sln * 256 + tid]), (LAS unsigned*)(wsl + sln * 256 + wid * 64), 4, 0, 0);
            if (fresh && nxt.kind && wid == 0) {
                if (t == nt - 6) __builtin_amdgcn_global_load_lds((const unsigned*)(done + 16 * nxt.mt), pollw, 4, 0, 16  );
                if (t == nt - 4) { if ((unsigned)__builtin_amdgcn_readfirstlane((int)pollw[0]) >= 32u) { asm volatile("buffer_inv sc1" ::: "memory"); ackd = 1; } }
            }
            if (last && fresh) { MOE_A_READY(nxt); MOE_OFFS(nxt, sln, vAn, vBn); ackd = 0; }
            const char* a1 = cA + (size_t)(t + 1) * kstep;
            const char* a2 = last ? nA : cA + (size_t)(t + 2) * kstep;
            const char* b2 = last ? nB : cB + (size_t)(t + 2) * kstep;
            const char* a3 = a2 + kstep; const char* b3 = b2 + kstep;
            const size_t hs2 = last ? hsBn : hsB;
            unsigned va2[2][2], vb2[2];
#pragma unroll
            for (int h = 0; h < 2; ++h)
#pragma unroll
                for (int i = 0; i < 2; ++i) va2[h][i] = last ? vAn[h][i] : vAc[h][i];
#pragma unroll
            for (int i = 0; i < 2; ++i) vb2[i] = last ? vBn[i] : vBc[i];
            G8_LDB(B0, 0, 0); G8_LDB(B1, 0, 1); G8_SCHED; G8_LDA(At, 0, 0); G8_STAGE(G8_SA(1, 1), a1, vAc[1]);
            G8_WAIT_V(8); G8_WAIT_L(0); G8_BAR; G8_MMA(0, 0, At, B0); G8_MMA(0, 1, At, B1); G8_BAR; G8_SCHED;
            G8_LDA(At, 0, 1); G8_STAGE(G8_SB(0, 0), b2, vb2); G8_STAGE(G8_SB(0, 1), b2 + hs2, vb2); G8_STAGE(G8_SA(0, 0), a2, va2[0]);
            G8_WAIT_V(8); G8_WAIT_L(0); G8_BAR; G8_MMA(1, 0, At, B0); G8_MMA(1, 1, At, B1); G8_BAR; G8_SCHED;
            G8_LDB(B0, 1, 0); G8_LDB(B1, 1, 1); G8_SCHED; G8_LDA(At, 1, 0); G8_STAGE(G8_SA(0, 1), a2, va2[1]);
            G8_WAIT_V(8); G8_WAIT_L(0); G8_BAR; G8_MMA(0, 0, At, B0); G8_MMA(0, 1, At, B1); G8_BAR; G8_SCHED;
            G8_LDA(At, 1, 1); G8_STAGE(G8_SB(1, 0), b3, vb2); G8_STAGE(G8_SB(1, 1), b3 + hs2, vb2); G8_STAGE(G8_SA(1, 0), a3, va2[0]);
            G8_WAIT_V(8); G8_WAIT_L(0); G8_BAR; G8_MMA(1, 0, At, B0); G8_MMA(1, 1, At, B1); G8_BAR; G8_SCHED;
        }
        if (wr == 0) G8_BAR;
        {
            int en[8];
#pragma unroll
            for (int ai = 0; ai < 2; ++ai)
#pragma unroll
                for (int m = 0; m < 4; ++m) { const int r = ai * HALF + wr * 64 + m * 16 + fr; en[ai * 4 + m] = (r < cur.rows) ? ent[slc * 256 + r] : -1; }
            if (cur.kind == 0) {
                float ws[8];
#pragma unroll
                for (int ai = 0; ai < 2; ++ai)
#pragma unroll
                    for (int m = 0; m < 4; ++m) ws[ai * 4 + m] = wsl[slc * 256 + ai * HALF + wr * 64 + m * 16 + fr];
                const int col0 = (cur.n0 >> 1) + wc * 32 + 8 * fq;
#pragma unroll
                for (int ai = 0; ai < 2; ++ai)
#pragma unroll
                    for (int m = 0; m < 4; ++m) { const int k = ai * 4 + m;
                        if (en[k] >= 0) { const float wv = ws[k];
                            const f32x4 g0 = acc[ai][0][m][0], g1 = acc[ai][0][m][1], u0 = acc[ai][1][m][0], u1 = acc[ai][1][m][1];
                            float hh[8];
#pragma unroll
                            for (int j = 0; j < 4; ++j) { hh[j] = siluf_(g0[j]) * u0[j] * wv; hh[4 + j] = siluf_(g1[j]) * u1[j] * wv; }
                            u32x4 w; w.x = cvt_pk_bf16(hh[0], hh[1]); w.y = cvt_pk_bf16(hh[2], hh[3]); w.z = cvt_pk_bf16(hh[4], hh[5]); w.w = cvt_pk_bf16(hh[6], hh[7]);
                            st16_sc1(H + (size_t)en[k] * DEXP + col0, w); } }
                asm volatile("s_waitcnt vmcnt(0)" ::: "memory");
                if (lane == 0) __hip_atomic_fetch_add(done + 16 * cur.mt, 1u, __ATOMIC_RELAXED, __HIP_MEMORY_SCOPE_AGENT);
            } else {
                const int col0 = cur.n0 + wc * 32 + 8 * fq;
#pragma unroll
                for (int ai = 0; ai < 2; ++ai)
#pragma unroll
                    for (int m = 0; m < 4; ++m) { const int k = ai * 4 + m;
                        if (en[k] >= 0) { bf16* rowp = O2 + (size_t)en[k] * DM + col0;
#pragma unroll
                            for (int bj = 0; bj < 2; ++bj) { const f32x4 v0 = acc[ai][bj][m][0], v1 = acc[ai][bj][m][1];
                                u32x4 w; w.x = cvt_pk_bf16(v0[0], v0[1]); w.y = cvt_pk_bf16(v0[2], v0[3]); w.z = cvt_pk_bf16(v1[0], v1[1]); w.w = cvt_pk_bf16(v1[2], v1[3]);
                                *(u32x4*)(rowp + bj * HALF) = w; } } }
            }
        }
        if (!has_next) break;
#pragma unroll
        for (int a = 0; a < 2; ++a)
#pragma unroll
            for (int b = 0; b < 2; ++b)
#pragma unroll
                for (int m = 0; m < 4; ++m)
#pragma unroll
                    for (int n = 0; n < 2; ++n) acc[a][b][m][n] = (f32x4){0.f, 0.f, 0.f, 0.f};
        cur = nxt; cB = nB; cA = nA; hsB = hsBn; slc = sln; ++ui;
        if (wr == 1) G8_BAR;
#pragma unroll
        for (int h = 0; h < 2; ++h)
#pragma unroll
            for (int i = 0; i < 2; ++i) vAc[h][i] = vAn[h][i];
#pragma unroll
        for (int i = 0; i < 2; ++i) vBc[i] = vBn[i];
    }
    G8_WAIT_V(0);
    G8_BAR;
#undef MOE_A_READY
#undef MOE_OFFS
#undef MOE_FETCH
#undef G8_SA
#undef G8_SB
#undef G8_STAGE
#undef G8_LDA
#undef G8_LDB
#undef G8_MMA
#undef G8_WAIT_V
#undef G8_WAIT_L
#undef G8_BAR
#undef G8_SCHED
}
}

constexpr int NWAVES = 8, NTHREADS = 512;
constexpr int RING_BYTES = 131072;
constexpr int LN_STRIDE = 2052;
constexpr int LN_TILE_BYTES = 16 * LN_STRIDE * 4;
constexpr int LN_PART_OFF = LN_TILE_BYTES, LN_LOGIT_OFF = LN_PART_OFF + 8192, LN_ROUTE_OFF = LN_LOGIT_OFF + 1024;
constexpr int LN_GB_OFF = 143360;
constexpr int LDS_BYTES = 163840;
constexpr int MOETAB_OFF = LDS_BYTES - 1024;
constexpr int MISC_OFF = LDS_BYTES - 512;
static_assert(LN_ROUTE_OFF + 2048 <= MOETAB_OFF && MISC_OFF + 16 <= LDS_BYTES, "LDS map");

struct Frame {
    LAS unsigned char* lds;
    int tid, lane, wave, G, bid;
    GAS unsigned char* ws;
    const float* const* in;
    GAS float* out;
};
#define FIN(k) ((const float*)(const GAS float*)F.in[k])
enum { I_X = 0, I_POS, I_WIN, I_SINK, I_CONVW, I_ALOG, I_DTB, I_DNW, I_WOUT, I_LN1G, I_LN1B, I_RW, I_RB, I_WG, I_WU, I_WDN, I_LN2G, I_LN2B };

DI void transpose_item(const float* W, int ldw, bf16* WT, int ldt, int k0, int n0, int drow0, LAS float* scr, int lane) {
    float tv[32];
    const GAS float* wp = (const GAS float*)W + (size_t)(k0 + (lane >> 5)) * ldw + n0 + (lane & 31);
#pragma unroll
    for (int i = 0; i < 32; ++i) tv[i] = __builtin_nontemporal_load(wp + (size_t)(2 * i) * ldw);
    __builtin_amdgcn_sched_barrier(0);
#pragma unroll
    for (int i = 0; i < 32; ++i) { const int kk = 2 * i + (lane >> 5); scr[kk * 33 + (lane & 31)] = tv[i]; }
    LDS_WAIT(); asm volatile("" ::: "memory");
    const int c = lane & 7;
#pragma unroll
    for (int j = 0; j < 4; ++j) { const int n = (lane >> 3) + 8 * j; const LAS float* s = scr + (8 * c) * 33 + n;
        u32x4 o; o.x = pk2(s[0 * 33], s[1 * 33]); o.y = pk2(s[2 * 33], s[3 * 33]); o.z = pk2(s[4 * 33], s[5 * 33]); o.w = pk2(s[6 * 33], s[7 * 33]);
        __builtin_nontemporal_store(o, (GAS u32x4*)(WT + (size_t)(drow0 + n) * ldt + k0 + 8 * c)); }
    LDS_WAIT(); asm volatile("" ::: "memory");
}
constexpr int IP_ATT_UNITS = (NTOK / 256) * (C_DQ / 256);
constexpr int CONV_HELPERS = 224, CONV_SPLIT = 32000;
constexpr int CONV_ITEMS = 32 * 168 + 32 * 64 + NEXP * (2 * 32 * 16 + 8 * 64), CONV_I_IN = 32 * 168;
DI void convw_phase(Frame& F, int l, int slot, int wg_lo, int wg_n, int it_lo, int it_hi) {
    LAS float* scr = (LAS float*)(F.lds + F.wave * 16384);
    const int gw = (F.bid - wg_lo) * NWAVES + F.wave, NGW = wg_n * NWAVES;
    bf16* win_t = (bf16*)(F.ws + WS_WIN) + (size_t)slot * PN * DM;
    bf16* wout_t = (bf16*)(F.ws + WS_WOUT) + (size_t)slot * DM * DM;
    bf16* wgu_t = (bf16*)(F.ws + WS_WGU) + (size_t)slot * NEXP * 1024 * DM;
    bf16* wd_t = (bf16*)(F.ws + WS_WD) + (size_t)slot * NEXP * DM * DEXP;
    const float* w_in = FIN(I_WIN) + (size_t)l * DM * PROJ;
    const float* w_out = FIN(I_WOUT) + (size_t)l * DM * DM;
    const float* w_g = FIN(I_WG) + (size_t)l * NEXP * DM * DEXP;
    const float* w_u = FIN(I_WU) + (size_t)l * NEXP * DM * DEXP;
    const float* w_d = FIN(I_WDN) + (size_t)l * NEXP * DEXP * DM;
    constexpr int I_IN = 32 * 168, I_OUT = 32 * 64, I_GU = 32 * 16, I_D = 8 * 64, I_E = 2 * I_GU + I_D;
    static_assert(CONV_ITEMS == I_IN + I_OUT + NEXP * I_E, "item count");
    for (int it = it_lo + gw; it < it_hi; it += NGW) {
        int r = it;
        if (r < I_IN) { const int kb = r / 168, nb = r % 168; transpose_item(w_in, PROJ, win_t, DM, kb * 64, nb * 32, nb * 32, scr, F.lane); continue; } r -= I_IN;
        if (r < I_OUT) { const int kb = r / 64, nb = r % 64; transpose_item(w_out, DM, wout_t, DM, kb * 64, nb * 32, nb * 32, scr, F.lane); continue; } r -= I_OUT;
        const int e = r / I_E; r -= e * I_E;
        if (r < 2 * I_GU) { const int up = r / I_GU; r -= up * I_GU; const int kb = r / 16, nb = r % 16, n0 = nb * 32;
            const int drow0 = (n0 >> 7) * 256 + up * 128 + (n0 & 127);
            transpose_item((up ? w_u : w_g) + (size_t)e * DM * DEXP, DEXP, wgu_t + (size_t)e * 1024 * DM, DM, kb * 64, n0, drow0, scr, F.lane); continue; }
        r -= 2 * I_GU;
        { const int kb = r / 64, nb = r % 64; transpose_item(w_d + (size_t)e * DEXP * DM, DM, wd_t + (size_t)e * DM * DEXP, DEXP, kb * 64, nb * 32, nb * 32, scr, F.lane); }
    }
}

DI void rope_phase(Frame& F) {
    float* cs = (float*)(F.ws + WS_COS); float* sn = (float*)(F.ws + WS_SIN);
    const int* pos = (const int*)FIN(I_POS);
    for (int i = F.bid * NTHREADS + F.tid; i < NTOK * 32; i += F.G * NTHREADS) {
        const int t = i >> 5, d = i & 31;
        const float inv = exp2f(-(float)d * (13.287712379549449f / 32.0f));
        const float ang = (float)pos[t] * inv;
        cs[i] = cosf(ang); sn[i] = sinf(ang);
    }
}

template <int MODE, bool SRCBF>
DI void ln_phase(Frame& F, const void* src, const bf16* o2, const float* gam, const float* bet, float* of32, bf16* obf, const float* W16, int ldw, bool do_logits,
                 float* ab, const float* rbias, unsigned* cnt, int* list, float* wsel) {
    LAS float* tile = (LAS float*)F.lds;
    LAS float* part = (LAS float*)(F.lds + LN_PART_OFF);
    LAS float* logit = (LAS float*)(F.lds + LN_LOGIT_OFF);
    LAS int* rt_e = (LAS int*)(F.lds + LN_ROUTE_OFF); LAS int* rt_tok = rt_e + 64; LAS float* rt_w = (LAS float*)(rt_e + 128); LAS unsigned* rt_h = (LAS unsigned*)(rt_e + 256); LAS unsigned* rt_b = rt_h + 16;
    int nrouted = 0;
    if (MODE == 1 && F.tid < 16) rt_h[F.tid] = 0u;
    const int lane = F.lane, w = F.wave;
    LAS f32x4* gbl = (LAS f32x4*)(F.lds + LN_GB_OFF);
    if (MODE != 0) { gbl[F.tid] = *((const GAS f32x4*)gam + F.tid); gbl[512 + F.tid] = *((const GAS f32x4*)bet + F.tid); }
    float wreg[64];
    if (do_logits) { const GAS float* wp = (const GAS float*)W16 + (size_t)(256 * w + 4 * (lane >> 4)) * ldw + (lane & 15);
#pragma unroll
        for (int s = 0; s < 16; ++s)
#pragma unroll
            for (int j = 0; j < 4; ++j) wreg[4 * s + j] = wp[(size_t)(16 * s + j) * ldw]; }
    else {
#pragma unroll
        for (int i = 0; i < 64; ++i) wreg[i] = 0.f; }
    f32x4 vn[8]; u32x2 rawn[8], avn[8], bvn[8];
#define LN_ISSUE(rowx) do { if (!SRCBF) { const GAS f32x4* sp_ = (const GAS f32x4*)((const float*)src + (size_t)(rowx) * DM) + lane; \
            _Pragma("unroll") for (int j = 0; j < 8; ++j) vn[j] = sp_[64 * j]; } \
        else { const GAS u32x2* sp_ = (const GAS u32x2*)((const bf16*)src + (size_t)(rowx) * DM) + lane; \
            _Pragma("unroll") for (int j = 0; j < 8; ++j) rawn[j] = sp_[64 * j]; } \
        if (MODE == 2) { const GAS u32x2* pa_ = (const GAS u32x2*)(o2 + (size_t)(rowx) * DM) + lane; const GAS u32x2* pb_ = (const GAS u32x2*)(o2 + (size_t)(NTOK + (rowx)) * DM) + lane; \
            _Pragma("unroll") for (int j = 0; j < 8; ++j) { avn[j] = pa_[64 * j]; bvn[j] = pb_[64 * j]; } } } while (0)
    if (F.bid < NTOK / 16) LN_ISSUE(F.bid * 16 + 2 * w);
    if (MODE != 0) __syncthreads();
    for (int unit = F.bid; unit < NTOK / 16; unit += F.G) {
        const int row0 = unit * 16;
#pragma unroll 1
        for (int rr = 0; rr < 2; ++rr) {
            const int rl = 2 * w + rr, row = row0 + rl;
            f32x4 v[8]; u32x2 av[8], bv[8];
#pragma unroll
            for (int j = 0; j < 8; ++j) {
                if (SRCBF) { u32x2 r = rawn[j]; asm volatile("" : "+v"(r)); v[j] = (f32x4){bflo(r.x), bfhi(r.x), bflo(r.y), bfhi(r.y)}; }
                else { v[j] = vn[j]; asm volatile("" : "+v"(v[j])); }
                if (MODE == 2) { av[j] = avn[j]; bv[j] = bvn[j]; asm volatile("" : "+v"(av[j]), "+v"(bv[j])); } }
            { const int nrow = (rr == 0) ? row + 1 : ((unit + F.G < NTOK / 16) ? (unit + F.G) * 16 + 2 * w : row);
              LN_ISSUE(nrow); }
            __builtin_amdgcn_sched_barrier(0);
            if (MODE == 2) {
#pragma unroll
                for (int j = 0; j < 8; ++j) { const u32x2 a = av[j], b = bv[j];
                    v[j].x = v[j].x * ALPHA + (bflo(a.x) + bflo(b.x)); v[j].y = v[j].y * ALPHA + (bfhi(a.x) + bfhi(b.x));
                    v[j].z = v[j].z * ALPHA + (bflo(a.y) + bflo(b.y)); v[j].w = v[j].w * ALPHA + (bfhi(a.y) + bfhi(b.y)); }
            }
            if (MODE != 0) {
                float s = 0.f;
#pragma unroll
                for (int j = 0; j < 8; ++j) s += (v[j].x + v[j].y) + (v[j].z + v[j].w);
                const float mean = wave_sum(s) * (1.0f / DM); float s2 = 0.f;
#pragma unroll
                for (int j = 0; j < 8; ++j) { v[j] = v[j] - mean; s2 += (v[j].x * v[j].x + v[j].y * v[j].y) + (v[j].z * v[j].z + v[j].w * v[j].w); }
                const float rstd = 1.0f / sqrtf(wave_sum(s2) * (1.0f / DM) + LN_EPS);
#pragma unroll
                for (int jh = 0; jh < 2; ++jh) { f32x4 g4[4], b4[4];
#pragma unroll
                    for (int j = 0; j < 4; ++j) { g4[j] = gbl[lane + 64 * (4 * jh + j)]; b4[j] = gbl[512 + lane + 64 * (4 * jh + j)]; }
                    __builtin_amdgcn_sched_barrier(0);
#pragma unroll
                    for (int j = 0; j < 4; ++j) v[4 * jh + j] = v[4 * jh + j] * rstd * g4[j] + b4[j]; }
            }
            else __builtin_amdgcn_sched_barrier(0);
            if (of32) { GAS f32x4* op = (GAS f32x4*)(of32 + (size_t)row * DM) + lane;
#pragma unroll
                for (int j = 0; j < 8; ++j) op[64 * j] = v[j]; }
            if (obf) { GAS u32x2* op = (GAS u32x2*)(obf + (size_t)row * DM) + lane;
#pragma unroll
                for (int j = 0; j < 8; ++j) { u32x2 o; o.x = pk2(v[j].x, v[j].y); o.y = pk2(v[j].z, v[j].w); op[64 * j] = o; } }
            if (do_logits) {
#pragma unroll
                for (int j = 0; j < 8; ++j) *(LAS f32x4*)(tile + rl * LN_STRIDE + 4 * lane + 256 * j) = v[j];
            }
        }
        if (do_logits) {
            __syncthreads();
            const int m = lane & 15, kq = lane >> 4;
            f32x4 acc = (f32x4){0.f, 0.f, 0.f, 0.f};
            const int kb = 256 * w;
#pragma unroll
            for (int s = 0; s < 16; ++s) {
                const int k = kb + 16 * s + 4 * kq;
                const f32x4 a4 = *(const LAS f32x4*)(tile + m * LN_STRIDE + k);
                acc = __builtin_amdgcn_mfma_f32_16x16x4f32(a4.x, wreg[4 * s + 0], acc, 0, 0, 0);
                acc = __builtin_amdgcn_mfma_f32_16x16x4f32(a4.y, wreg[4 * s + 1], acc, 0, 0, 0);
                acc = __builtin_amdgcn_mfma_f32_16x16x4f32(a4.z, wreg[4 * s + 2], acc, 0, 0, 0);
                acc = __builtin_amdgcn_mfma_f32_16x16x4f32(a4.w, wreg[4 * s + 3], acc, 0, 0, 0);
            }
#pragma unroll
            for (int r = 0; r < 4; ++r) part[(w * 16 + 4 * kq + r) * 16 + m] = acc[r];
            __syncthreads();
            if (F.tid < 256) {
                const int r = F.tid >> 4, n = F.tid & 15; float s = 0.f;
#pragma unroll
                for (int ww = 0; ww < 8; ++ww) s += part[(ww * 16 + r) * 16 + n];
                if (MODE == 1) logit[r * 16 + n] = s; else ab[(size_t)(row0 + r) * 16 + n] = s;
            }
            if (MODE == 1) {
                __syncthreads();
                if (F.tid < 16) {
                    const int tok = row0 + F.tid;
                    float sc[16], sel[16];
#pragma unroll
                    for (int e = 0; e < 16; ++e) { sc[e] = sigmoidf_(logit[F.tid * 16 + e]); sel[e] = sc[e] + rbias[e]; }
                    int bg = 0; float bgv = -1e30f; int be0[4], be1[4];
#pragma unroll
                    for (int g = 0; g < 4; ++g) {
                        int i0 = 0; float v0 = sel[4 * g];
#pragma unroll
                        for (int j = 1; j < 4; ++j) if (sel[4 * g + j] > v0) { v0 = sel[4 * g + j]; i0 = j; }
                        int i1 = -1; float v1 = -1e30f;
#pragma unroll
                        for (int j = 0; j < 4; ++j) if (j != i0 && sel[4 * g + j] > v1) { v1 = sel[4 * g + j]; i1 = j; }
                        be0[g] = 4 * g + i0; be1[g] = 4 * g + i1;
                        const float sum = v0 + v1; if (sum > bgv) { bgv = sum; bg = g; }
                    }
                    int e0 = be0[0], e1 = be1[0];
#pragma unroll
                    for (int g = 1; g < 4; ++g) if (bg == g) { e0 = be0[g]; e1 = be1[g]; }
                    float w0 = 0.f, w1 = 0.f;
#pragma unroll
                    for (int e = 0; e < 16; ++e) { if (e == e0) w0 = sc[e]; if (e == e1) w1 = sc[e]; }
                    const float inv = 1.0f / (w0 + w1);
                    const int slot = nrouted * 16 + F.tid;
                    rt_e[slot] = e0 | (e1 << 8); rt_w[2 * slot] = w0 * inv; rt_w[2 * slot + 1] = w1 * inv; rt_tok[slot] = tok;
                }
                ++nrouted;
            }
            __syncthreads();
        }
    }
    if (MODE == 1) {
        __syncthreads();
        const int nr = nrouted * 16; unsigned p0 = 0u, p1 = 0u; int e0 = 0, e1 = 0;
        if (F.tid < nr) { const int ee = rt_e[F.tid]; e0 = ee & 255; e1 = ee >> 8; p0 = __hip_atomic_fetch_add(rt_h + e0, 1u, __ATOMIC_RELAXED, __HIP_MEMORY_SCOPE_WORKGROUP); p1 = __hip_atomic_fetch_add(rt_h + e1, 1u, __ATOMIC_RELAXED, __HIP_MEMORY_SCOPE_WORKGROUP); }
        __syncthreads();
        if (F.tid < 16) { const unsigned hc = rt_h[F.tid]; rt_b[F.tid] = hc ? atomicAdd(cnt + 64 * F.tid, hc) : 0u; }
        __syncthreads();
        if (F.tid < nr) { const int tok = rt_tok[F.tid];
            list[e0 * NTOK + rt_b[e0] + p0] = tok; wsel[tok] = rt_w[2 * F.tid];
            list[e1 * NTOK + rt_b[e1] + p1] = NTOK + tok; wsel[NTOK + tok] = rt_w[2 * F.tid + 1]; }
        __syncthreads();
    }
}

constexpr int KT_PITCH = 72, VT_PITCH = 264;
constexpr int ATT_KT_OFF = 0, ATT_VT_OFF = 256 * KT_PITCH * 2;
DI void attn_unit(Frame& F, int unit, int l) {
    const int b = unit >> 6, kvh = (unit >> 5) & 1, qb = unit & 31;
    const bf16* proj = (const bf16*)(F.ws + WS_PROJ);
    const float* cs = (const float*)(F.ws + WS_COS); const float* sn = (const float*)(F.ws + WS_SIN);
    bf16* cat = (bf16*)(F.ws + WS_CAT);
    LAS unsigned char* kt = F.lds + ATT_KT_OFF; LAS unsigned char* vt = F.lds + ATT_VT_OFF;
    const int tq0 = b * SEQ + qb * 128, tk0 = tq0 - 128;
    {
        u32x4 klo[2], khi[2], vx[4]; f32x4 kc0[2], kc1[2], ks0[2], ks1[2];
#pragma unroll
        for (int it = 0; it < 2; ++it) {
            const int idx = F.tid + it * NTHREADS, kj = idx >> 2, c = idx & 3;
            int tk = tk0 + kj; if (tk < b * SEQ) tk = b * SEQ;
            const bf16* kp = proj + (size_t)tk * PN + C_SK + kvh * 64;
            klo[it] = *(const GAS u32x4*)(kp + 8 * c); khi[it] = *(const GAS u32x4*)(kp + 32 + 8 * c);
            kc0[it] = *(const GAS f32x4*)(cs + tk * 32 + 8 * c); kc1[it] = *(const GAS f32x4*)(cs + tk * 32 + 8 * c + 4);
            ks0[it] = *(const GAS f32x4*)(sn + tk * 32 + 8 * c); ks1[it] = *(const GAS f32x4*)(sn + tk * 32 + 8 * c + 4);
        }
        const int vkj = F.tid & 255, vdh = F.tid >> 8;
        { int tk = tk0 + vkj; if (tk < b * SEQ) tk = b * SEQ;
          const bf16* vp = proj + (size_t)tk * PN + C_SV + kvh * 64 + vdh * 32;
#pragma unroll
          for (int q = 0; q < 4; ++q) vx[q] = *(const GAS u32x4*)(vp + 8 * q); }
        __builtin_amdgcn_sched_barrier(0);
#pragma unroll
        for (int it = 0; it < 2; ++it) {
            const int idx = F.tid + it * NTHREADS, kj = idx >> 2, c = idx & 3;
            const u32x4 lo = klo[it], hi = khi[it]; const f32x4 c0 = kc0[it], c1 = kc1[it], s0 = ks0[it], s1 = ks1[it];
            float x1[8], x2[8], cc[8], ss[8];
#pragma unroll
            for (int j = 0; j < 4; ++j) { x1[2 * j] = bflo(lo[j]); x1[2 * j + 1] = bfhi(lo[j]); x2[2 * j] = bflo(hi[j]); x2[2 * j + 1] = bfhi(hi[j]); cc[j] = c0[j]; cc[4 + j] = c1[j]; ss[j] = s0[j]; ss[4 + j] = s1[j]; }
            u32x4 o1, o2;
#pragma unroll
            for (int j = 0; j < 4; ++j) {
                o1[j] = pk2(x1[2 * j] * cc[2 * j] - x2[2 * j] * ss[2 * j], x1[2 * j + 1] * cc[2 * j + 1] - x2[2 * j + 1] * ss[2 * j + 1]);
                o2[j] = pk2(x2[2 * j] * cc[2 * j] + x1[2 * j] * ss[2 * j], x2[2 * j + 1] * cc[2 * j + 1] + x1[2 * j + 1] * ss[2 * j + 1]);
            }
            *(LAS u32x4*)(kt + kj * (KT_PITCH * 2) + 16 * c) = o1;
            *(LAS u32x4*)(kt + kj * (KT_PITCH * 2) + 64 + 16 * c) = o2;
        }
#pragma unroll
        for (int q = 0; q < 4; ++q) { const u32x4 x = vx[q];
#pragma unroll
            for (int j = 0; j < 4; ++j) { const int d = vdh * 32 + 8 * q + 2 * j;
                *(LAS unsigned short*)(vt + (d * VT_PITCH + vkj) * 2) = (unsigned short)(x[j] & 0xffffu);
                *(LAS unsigned short*)(vt + ((d + 1) * VT_PITCH + vkj) * 2) = (unsigned short)(x[j] >> 16); } }
    }
    __syncthreads();
    const int lane = F.lane, n = lane & 15, q4 = lane >> 4, head = kvh * 8 + F.wave;
    const float sink = FIN(I_SINK)[l * 16 + head];
    u32x4 qlo, qhi; f32x4 qc0, qc1, qs0, qs1;
    { const int tq = tq0 + n; const bf16* qp = proj + (size_t)tq * PN + C_SQ + head * 64;
      qlo = *(const GAS u32x4*)(qp + 8 * q4); qhi = *(const GAS u32x4*)(qp + 32 + 8 * q4);
      qc0 = *(const GAS f32x4*)(cs + tq * 32 + 8 * q4); qc1 = *(const GAS f32x4*)(cs + tq * 32 + 8 * q4 + 4);
      qs0 = *(const GAS f32x4*)(sn + tq * 32 + 8 * q4); qs1 = *(const GAS f32x4*)(sn + tq * 32 + 8 * q4 + 4); }
#pragma unroll 1
    for (int qt = 0; qt < 8; ++qt) {
        const int qi = 16 * qt + n, tq = tq0 + qi;
        bf16x8 qf[2];
        {
            const u32x4 lo = qlo, hi = qhi; const f32x4 c0 = qc0, c1 = qc1, s0 = qs0, s1 = qs1;
            float x1[8], x2[8], cc[8], ss[8];
#pragma unroll
            for (int j = 0; j < 4; ++j) { x1[2 * j] = bflo(lo[j]); x1[2 * j + 1] = bfhi(lo[j]); x2[2 * j] = bflo(hi[j]); x2[2 * j + 1] = bfhi(hi[j]); cc[j] = c0[j]; cc[4 + j] = c1[j]; ss[j] = s0[j]; ss[4 + j] = s1[j]; }
            u32x4 o1, o2;
#pragma unroll
            for (int j = 0; j < 4; ++j) {
                o1[j] = pk2(0.125f * (x1[2 * j] * cc[2 * j] - x2[2 * j] * ss[2 * j]), 0.125f * (x1[2 * j + 1] * cc[2 * j + 1] - x2[2 * j + 1] * ss[2 * j + 1]));
                o2[j] = pk2(0.125f * (x2[2 * j] * cc[2 * j] + x1[2 * j] * ss[2 * j]), 0.125f * (x2[2 * j + 1] * cc[2 * j + 1] + x1[2 * j + 1] * ss[2 * j + 1]));
            }
            qf[0] = __builtin_bit_cast(bf16x8, o1); qf[1] = __builtin_bit_cast(bf16x8, o2);
        }
        {   const int tqn = tq0 + 16 * ((qt + 1) & 7) + n; const bf16* qp = proj + (size_t)tqn * PN + C_SQ + head * 64;
            qlo = *(const GAS u32x4*)(qp + 8 * q4); qhi = *(const GAS u32x4*)(qp + 32 + 8 * q4);
            qc0 = *(const GAS f32x4*)(cs + tqn * 32 + 8 * q4); qc1 = *(const GAS f32x4*)(cs + tqn * 32 + 8 * q4 + 4);
            qs0 = *(const GAS f32x4*)(sn + tqn * 32 + 8 * q4); qs1 = *(const GAS f32x4*)(sn + tqn * 32 + 8 * q4 + 4); }
        __builtin_amdgcn_sched_barrier(0);
        const int t0 = 2 * (qt >> 1);
        f32x4 s[10];
#pragma unroll
        for (int tt = 0; tt < 10; ++tt) {
            f32x4 a = (f32x4){0.f, 0.f, 0.f, 0.f};
#pragma unroll
            for (int kk = 0; kk < 2; ++kk) {
                const bf16x8 kf = *(const LAS bf16x8*)(kt + (16 * (t0 + tt) + n) * (KT_PITCH * 2) + 64 * kk + 16 * q4);
                a = __builtin_amdgcn_mfma_f32_16x16x32_bf16(kf, qf[kk], a, 0, 0, 0);
            }
            s[tt] = a;
        }
        float mx = sink;
#pragma unroll
        for (int tt = 0; tt < 10; ++tt)
#pragma unroll
            for (int r = 0; r < 4; ++r) { const int kj = 16 * (t0 + tt) + 4 * q4 + r;
                const bool valid = (kj >= qi + 1) && (kj <= qi + 128) && (qb > 0 || kj >= 128);
                s[tt][r] = valid ? s[tt][r] : -INFINITY; mx = fmaxf(mx, s[tt][r]); }
        mx = fmaxf(mx, swz_xor(mx, SWZ_X16)); mx = xor32_max(mx);
        float sum = 0.f;
#pragma unroll
        for (int tt = 0; tt < 10; ++tt)
#pragma unroll
            for (int r = 0; r < 4; ++r) { const float p = __expf(s[tt][r] - mx); s[tt][r] = p; sum += p; }
        sum += swz_xor(sum, SWZ_X16); sum = xor32_sum(sum);
        const float inv = 1.0f / (sum + __expf(sink - mx));
        f32x4 o[4];
#pragma unroll
        for (int dt = 0; dt < 4; ++dt) o[dt] = (f32x4){0.f, 0.f, 0.f, 0.f};
#pragma unroll
        for (int kk = 0; kk < 5; ++kk) {
            u32x4 pw; pw.x = pk2(s[2 * kk][0], s[2 * kk][1]); pw.y = pk2(s[2 * kk][2], s[2 * kk][3]); pw.z = pk2(s[2 * kk + 1][0], s[2 * kk + 1][1]); pw.w = pk2(s[2 * kk + 1][2], s[2 * kk + 1][3]);
            const bf16x8 pf = __builtin_bit_cast(bf16x8, pw);
            const int key0 = 16 * t0 + 32 * kk + 4 * q4;
#pragma unroll
            for (int dt = 0; dt < 4; ++dt) {
                const LAS unsigned char* vp = vt + ((16 * dt + n) * VT_PITCH + key0) * 2;
                const u32x2 va = *(const LAS u32x2*)vp, vb = *(const LAS u32x2*)(vp + 32);
                u32x4 vw; vw.x = va.x; vw.y = va.y; vw.z = vb.x; vw.w = vb.y;
                o[dt] = __builtin_amdgcn_mfma_f32_16x16x32_bf16(__builtin_bit_cast(bf16x8, vw), pf, o[dt], 0, 0, 0);
            }
        }
#pragma unroll
        for (int dt = 0; dt < 4; ++dt) { u32x2 w; w.x = pk2(o[dt][0] * inv, o[dt][1] * inv); w.y = pk2(o[dt][2] * inv, o[dt][3] * inv);
            *(GAS u32x2*)(cat + (size_t)tq * DM + head * 64 + 16 * dt + 4 * q4) = w; }
    }
    __syncthreads();
}

constexpr int OPS_BYTES = 57344, U_BYTES = 16384;
constexpr size_t WS_SCAN_U = WS_SCAN + (size_t)1024 * OPS_BYTES, WS_GLAST = 6 * MiB;
constexpr int DP_PITCH = 272, DP_Q = 0, DP_K = 17408, DP_V = 34816, DP_L = 52224, DP_GC = 69632, DP_BT = 69888, DP_EG = 70144, DP_EK = 70400, DP_RK = 70656, DP_RQ = 70912, DP_EKB = 71168, DP_GROUP = 71424;
DI void dn_prep_item(Frame& F, int item, int l) {
    int lane = F.lane; asm volatile("" : "+v"(lane));
    const int gi = F.wave >> 2, wg = F.wave & 3; int tg = wg * 64 + lane;
    const int h = item & 7, ck = (item >> 3) & 63, b = item >> 9;
    const int sitem = (b * 8 + h) * 64 + ck;
    const int tb = b * SEQ + ck * 64;
    LAS unsigned char* base = F.lds + gi * DP_GROUP;
    const bf16* proj = (const bf16*)(F.ws + WS_PROJ);
    GAS unsigned char* ops = F.ws + WS_SCAN + (size_t)sitem * OPS_BYTES;
    float* uo = (float*)(F.ws + WS_SCAN_U + (size_t)sitem * U_BYTES);
    LAS float* gc = (LAS float*)(base + DP_GC); LAS float* bt = (LAS float*)(base + DP_BT); LAS float* eg = (LAS float*)(base + DP_EG); LAS float* ek = (LAS float*)(base + DP_EK);
    LAS float* rkn = (LAS float*)(base + DP_RK); LAS float* rqn = (LAS float*)(base + DP_RQ); LAS float* ekb = (LAS float*)(base + DP_EKB);
    LAS float* Lm = (LAS float*)(base + DP_L);
    {
        const float* cw = FIN(I_CONVW) + (size_t)l * 4 * 3072;
        float w[3][4][2];
#pragma unroll
        for (int s = 0; s < 3; ++s)
#pragma unroll
            for (int j = 0; j < 4; ++j) { const f32x2 t = *(const GAS f32x2*)(cw + j * 3072 + s * 1024 + h * 128 + 2 * lane); w[s][j][0] = t.x; w[s][j][1] = t.y; }
        const int colq = C_DQ + h * 128 + 2 * lane;
        const int t0 = ck * 64 + 16 * wg - 3;
        unsigned xs[3][19];
#pragma unroll
        for (int s = 0; s < 3; ++s)
#pragma unroll
            for (int i = 0; i < 19; ++i) { const int t = t0 + i; xs[s][i] = (t >= 0) ? *(const GAS unsigned*)(proj + (size_t)(b * SEQ + t) * PN + colq + s * 1024) : 0u; }
        __builtin_amdgcn_sched_barrier(0);
#pragma unroll
        for (int s = 0; s < 3; ++s) {
#pragma unroll
            for (int i = 0; i < 16; ++i) {
                const float a0 = w[s][0][0] * bflo(xs[s][i]) + w[s][1][0] * bflo(xs[s][i + 1]) + w[s][2][0] * bflo(xs[s][i + 2]) + w[s][3][0] * bflo(xs[s][i + 3]);
                const float a1 = w[s][0][1] * bfhi(xs[s][i]) + w[s][1][1] * bfhi(xs[s][i + 1]) + w[s][2][1] * bfhi(xs[s][i + 2]) + w[s][3][1] * bfhi(xs[s][i + 3]);
                *(LAS unsigned*)(base + DP_Q + s * 17408 + (16 * wg + i) * DP_PITCH + 4 * lane) = pk2(siluf_(a0), siluf_(a1));
            }
        }
    }
    if (tg < 64) {
        const float* ab = (const float*)(F.ws + WS_AB) + (size_t)(tb + tg) * 16;
        const float a = ab[h], bb = ab[8 + h];
        const float x = a + FIN(I_DTB)[l * 8 + h];
        const float ex = __expf(x);
        const float sp = (x > 20.f) ? x : ((ex < 0.03f) ? ex * (1.0f - ex * (0.5f - ex * (0.33333333f - 0.25f * ex))) : __logf(1.0f + ex));
        eg[tg] = -__expf(FIN(I_ALOG)[l * 8 + h]) * sp; bt[tg] = sigmoidf_(bb);
    }
    __syncthreads();
    if (tg < 64) { float s = 0.f;
        for (int i = 0; i < 64; ++i) { const float gv = eg[i]; s += (i <= tg) ? gv : 0.f; }
        gc[tg] = s; }
    {
        asm volatile("" : "+v"(lane));
        const int n = lane & 15, q4 = lane >> 4;
        f32x4 kd = (f32x4){0.f, 0.f, 0.f, 0.f}, qd = (f32x4){0.f, 0.f, 0.f, 0.f};
#pragma unroll
        for (int kk = 0; kk < 4; ++kk) { const bf16x8 ak = *(const LAS bf16x8*)(base + DP_K + (16 * wg + n) * DP_PITCH + (32 * kk + 8 * q4) * 2), aq = *(const LAS bf16x8*)(base + DP_Q + (16 * wg + n) * DP_PITCH + (32 * kk + 8 * q4) * 2);
            kd = __builtin_amdgcn_mfma_f32_16x16x32_bf16(ak, ak, kd, 0, 0, 0); qd = __builtin_amdgcn_mfma_f32_16x16x32_bf16(aq, aq, qd, 0, 0, 0); }
#pragma unroll
        for (int r = 0; r < 4; ++r) if (n == 4 * q4 + r) { rkn[16 * wg + n] = 1.0f / sqrtf(kd[r] + RMS_EPS); rqn[16 * wg + n] = 0.08838834764831845f / sqrtf(qd[r] + RMS_EPS); }
    }
    __syncthreads();
    if (tg < 64) { const float g63 = gc[63], gme = gc[tg], e = __expf(gme), rk = rkn[tg];
        eg[tg] = rqn[tg] * e;
        ek[tg] = rk * __expf(g63 - gme);
        ekb[tg] = rk * bt[tg] * e;
        if (tg == 0) ((float*)(F.ws + WS_GLAST))[sitem] = __expf(g63); }
    {
        asm volatile("" : "+v"(lane));
        const int n = lane & 15, q4 = lane >> 4;
        bf16x8 ak[4], aq[4];
#pragma unroll
        for (int kk = 0; kk < 4; ++kk) { ak[kk] = *(const LAS bf16x8*)(base + DP_K + (16 * wg + n) * DP_PITCH + (32 * kk + 8 * q4) * 2); aq[kk] = *(const LAS bf16x8*)(base + DP_Q + (16 * wg + n) * DP_PITCH + (32 * kk + 8 * q4) * 2); }
#pragma unroll
        for (int st = 0; st < 4; ++st) {
            f32x4 kkacc = (f32x4){0.f, 0.f, 0.f, 0.f}, qkacc = (f32x4){0.f, 0.f, 0.f, 0.f};
#pragma unroll
            for (int kk = 0; kk < 4; ++kk) { const bf16x8 bk = *(const LAS bf16x8*)(base + DP_K + (16 * st + n) * DP_PITCH + (32 * kk + 8 * q4) * 2);
                kkacc = __builtin_amdgcn_mfma_f32_16x16x32_bf16(ak[kk], bk, kkacc, 0, 0, 0); qkacc = __builtin_amdgcn_mfma_f32_16x16x32_bf16(aq[kk], bk, qkacc, 0, 0, 0); }
            const int sidx = 16 * st + n; const float gs = gc[sidx], rks = rkn[sidx];
#pragma unroll
            for (int r = 0; r < 4; ++r) { const int c = 16 * wg + 4 * q4 + r; const float dec = (c >= sidx) ? __expf(gc[c] - gs) * rks : 0.f;
                Lm[c * 68 + sidx] = (c > sidx) ? -(bt[c] * rkn[c] * kkacc[r] * dec) : 0.f;
                const int m = 4 * q4 + r, kkf = st >> 1, qq = (n >> 2) & 3, j = ((st & 1) << 2) | (n & 3);
                *(GAS unsigned short*)(ops + 49152 + (size_t)(((wg * 2 + kkf) * 64 + qq * 16 + m) * 8 + j) * 2) = (unsigned short)f2bf(qkacc[r] * rqn[c] * dec); }
        }
    }
    __syncthreads();
    f32x4 Xc[4][4];
    {
        asm volatile("" : "+v"(lane));
        const int n = lane & 15, q4 = lane >> 4;
        unsigned lmb = (unsigned)(size_t)Lm; asm volatile("" : "+v"(lmb));
        if (wg == 0) {
            float t[16];
#pragma unroll
            for (int i = 0; i < 16; ++i) t[i] = 0.f;
            const unsigned rowb = lmb + (unsigned)(((16 * q4) * 68 + 16 * q4) * 4);
#pragma unroll
            for (int i = 0; i < 16; ++i) {
                float a = (i == n) ? 1.f : 0.f;
#pragma unroll
                for (int k4 = 0; k4 < (i + 3) / 4; ++k4) { const f32x4 l4 = *(const LAS f32x4*)(size_t)(rowb + (unsigned)((i * 68 + 4 * k4) * 4));
                    a += (l4.x * t[4 * k4] + l4.y * t[4 * k4 + 1]) + (l4.z * t[4 * k4 + 2] + l4.w * t[4 * k4 + 3]); }
                t[i] = a;
            }
#pragma unroll
            for (int i = 0; i < 16; ++i) *(LAS float*)(size_t)(rowb + (unsigned)((i * 68 + n) * 4)) = t[i];
        }
        {
            const LAS unsigned char* src = base + ((wg < 2) ? DP_V : DP_K) + (((64 * wg) & 127) + n) * 2;
            const LAS float* scp = (wg < 2) ? bt : ekb;
#pragma unroll
            for (int rb = 0; rb < 4; ++rb)
#pragma unroll
                for (int r = 0; r < 4; ++r) { const int row = 16 * rb + 4 * q4 + r; const float sc = scp[row];
#pragma unroll
                    for (int ct = 0; ct < 4; ++ct) Xc[ct][rb][r] = __builtin_bit_cast(float, ((unsigned)*(const LAS unsigned short*)(src + row * DP_PITCH + 32 * ct)) << 16) * sc; }
        }
        __syncthreads();
#define DP_NBLK(rb, rbp) (*(const LAS f32x4*)(size_t)(lmb + (unsigned)((((16 * (rb) + n) * 68) + 16 * (rbp) + 4 * q4) * 4)))
#define DP_PK4(v) ({ const f32x4 v_ = (v); u32x2 p_; p_.x = pk2n(v_[0], v_[1]); p_.y = pk2n(v_[2], v_[3]); __builtin_bit_cast(s16x4, p_); })
        s16x4 xb[4][4];
#pragma unroll
        for (int rb = 0; rb < 4; ++rb) {
#pragma unroll
            for (int rbp = 0; rbp < rb; ++rbp) { const s16x4 a = DP_PK4(DP_NBLK(rb, rbp));
#pragma unroll
                for (int ct = 0; ct < 4; ++ct) Xc[ct][rb] = __builtin_amdgcn_mfma_f32_16x16x16bf16_1k(a, xb[ct][rbp], Xc[ct][rb], 0, 0, 0); }
            const s16x4 tb4 = DP_PK4(DP_NBLK(rb, rb));
#pragma unroll
            for (int ct = 0; ct < 4; ++ct) { const s16x4 rhs = DP_PK4(Xc[ct][rb]);
                Xc[ct][rb] = __builtin_amdgcn_mfma_f32_16x16x16bf16_1k(tb4, rhs, (f32x4){0.f, 0.f, 0.f, 0.f}, 0, 0, 0); xb[ct][rb] = DP_PK4(Xc[ct][rb]); }
        }
#undef DP_NBLK
#undef DP_PK4
        if (wg < 2) {
#pragma unroll
            for (int ct = 0; ct < 4; ++ct)
#pragma unroll
                for (int rb = 0; rb < 4; ++rb) { u32x2 o; o.x = pk2(Xc[ct][rb][0], Xc[ct][rb][1]); o.y = pk2(Xc[ct][rb][2], Xc[ct][rb][3]);
                    *(GAS u32x2*)((GAS unsigned char*)uo + (size_t)((((4 * wg + ct) * 4 + rb) * 64 + lane) * 8)) = o; }
        } else {
#pragma unroll
            for (int ct = 0; ct < 4; ++ct)
#pragma unroll
                for (int rb = 0; rb < 4; ++rb)
#pragma unroll
                    for (int r = 0; r < 4; ++r) *(LAS unsigned short*)(base + DP_V + (16 * rb + 4 * q4 + r) * DP_PITCH + (64 * (wg - 2) + 16 * ct + n) * 2) = (unsigned short)f2bf(Xc[ct][rb][r]);
        }
    }
    __syncthreads();
    asm volatile("" : "+v"(tg));
#pragma unroll 1
    for (int i = 0; i < 4; ++i) { const int p = tg + 256 * i, f = p >> 6, ln = p & 63, q = ln >> 4, m = ln & 15, mt = f >> 2, kk = f & 3, c = 16 * mt + m;
        const u32x2 w0 = *(const LAS u32x2*)(base + DP_V + c * DP_PITCH + (32 * kk + 4 * q) * 2), w1 = *(const LAS u32x2*)(base + DP_V + c * DP_PITCH + (32 * kk + 16 + 4 * q) * 2);
        u32x4 wv; wv.x = w0.x; wv.y = w0.y; wv.z = w1.x; wv.w = w1.y;
        *(GAS u32x4*)(ops + (size_t)(f * 64 + ln) * 16) = wv;
        const u32x2 q0 = *(const LAS u32x2*)(base + DP_Q + c * DP_PITCH + (32 * kk + 4 * q) * 2), q1 = *(const LAS u32x2*)(base + DP_Q + c * DP_PITCH + (32 * kk + 16 + 4 * q) * 2);
        const float e = eg[c]; u32x4 qv;
        qv.x = pk2(bflo(q0.x) * e, bfhi(q0.x) * e); qv.y = pk2(bflo(q0.y) * e, bfhi(q0.y) * e); qv.z = pk2(bflo(q1.x) * e, bfhi(q1.x) * e); qv.w = pk2(bflo(q1.y) * e, bfhi(q1.y) * e);
        *(GAS u32x4*)(ops + 16384 + (size_t)(f * 64 + ln) * 16) = qv;
        const int mt8 = f >> 1, kk2 = f & 1, d = 16 * mt8 + m; float kv[8];
#pragma unroll
        for (int j = 0; j < 8; ++j) { const int cc = 32 * kk2 + 16 * (j >> 2) + 4 * q + (j & 3);
            kv[j] = __builtin_bit_cast(float, ((unsigned)*(const LAS unsigned short*)(base + DP_K + cc * DP_PITCH + d * 2)) << 16) * ek[cc]; }
        u32x4 kw; kw.x = pk2(kv[0], kv[1]); kw.y = pk2(kv[2], kv[3]); kw.z = pk2(kv[4], kv[5]); kw.w = pk2(kv[6], kv[7]);
        *(GAS u32x4*)(ops + 32768 + (size_t)(f * 64 + ln) * 16) = kw; }
    __syncthreads();
}

DI void dn_scan_phase(Frame& F) {
    if (F.bid >= 32) return;
    const int bh = (F.bid & 7) + 8 * (F.bid >> 4), vg = (F.bid >> 3) & 1, b = bh >> 3, h = bh & 7, lane = F.lane;
    const GAS unsigned char* opsg = F.ws + WS_SCAN + (size_t)bh * 64 * OPS_BYTES;
    const GAS unsigned char* ugb = F.ws + WS_SCAN_U + (size_t)bh * 64 * U_BYTES + (size_t)vg * 8192;
    const float* glast = (const float*)(F.ws + WS_GLAST) + bh * 64;
    bf16* ob = (bf16*)(F.ws + WS_OBUF);
    constexpr int SBUF = OPS_BYTES + 8192;
    LAS float* glds = (LAS float*)(F.lds + 2 * SBUF);
    if (F.tid < 64) glds[F.tid] = glast[F.tid];
#define SCAN_STEP_BARRIER() do { asm volatile("s_waitcnt lgkmcnt(0)" ::: "memory"); __builtin_amdgcn_s_barrier(); asm volatile("" ::: "memory"); } while (0)
#define GLD16(dst, ptr) asm volatile("global_load_dwordx4 %0, %1, off" : "=v"(dst) : "v"(ptr) : "memory")
#define WAIT18(r) asm volatile("s_waitcnt vmcnt(16)" : "+v"(r[0]), "+v"(r[1]), "+v"(r[2]), "+v"(r[3]), "+v"(r[4]), "+v"(r[5]), "+v"(r[6]), "+v"(r[7]), "+v"(r[8]), "+v"(r[9]), "+v"(r[10]), "+v"(r[11]), "+v"(r[12]), "+v"(r[13]), "+v"(r[14]), "+v"(r[15]) :: "memory")
    if (F.wave >= 4) {
        const int lw = F.wave - 4;
        const GAS unsigned char* srco = opsg + (size_t)(lw * 14) * 1024 + lane * 16;
        const GAS unsigned char* srcu = ugb + (size_t)(lw * 2) * 1024 + lane * 16;
        LAS unsigned char* dsto = F.lds + (lw * 14) * 1024 + lane * 16;
        LAS unsigned char* dstu = F.lds + OPS_BYTES + (lw * 2) * 1024 + lane * 16;
        u32x4 ra[16], rb[16], rc[16];
#define WAIT32(r) asm volatile("s_waitcnt vmcnt(32)" : "+v"(r[0]), "+v"(r[1]), "+v"(r[2]), "+v"(r[3]), "+v"(r[4]), "+v"(r[5]), "+v"(r[6]), "+v"(r[7]), "+v"(r[8]), "+v"(r[9]), "+v"(r[10]), "+v"(r[11]), "+v"(r[12]), "+v"(r[13]), "+v"(r[14]), "+v"(r[15]) :: "memory")
#define LOAD_SET(r, ck) do { const int ck_ = (ck) < 64 ? (ck) : 63; const GAS unsigned char* so_ = srco + (size_t)ck_ * OPS_BYTES; const GAS unsigned char* su_ = srcu + (size_t)ck_ * U_BYTES; \
        _Pragma("unroll") for (int p = 0; p < 14; ++p) { const GAS unsigned char* a_ = so_ + (size_t)p * 1024; GLD16(r[p], a_); } \
        _Pragma("unroll") for (int p = 0; p < 2; ++p) { const GAS unsigned char* a_ = su_ + (size_t)p * 1024; GLD16(r[14 + p], a_); } } while (0)
#define STORE_SET(r, bufi) do { _Pragma("unroll") for (int p = 0; p < 14; ++p) *(LAS u32x4*)(dsto + (bufi) * SBUF + p * 1024) = r[p]; \
        _Pragma("unroll") for (int p = 0; p < 2; ++p) *(LAS u32x4*)(dstu + (bufi) * SBUF + p * 1024) = r[14 + p]; } while (0)
#define LSTEP(r, bufi, i_) do { WAIT32(r); __builtin_amdgcn_sched_barrier(0); STORE_SET(r, bufi); LOAD_SET(r, (i_) + 4); SCAN_STEP_BARRIER(); } while (0)
        LOAD_SET(ra, 0); LOAD_SET(rb, 1); LOAD_SET(rc, 2);
        WAIT32(ra); __builtin_amdgcn_sched_barrier(0);
        STORE_SET(ra, 0);
        LOAD_SET(ra, 3);
        SCAN_STEP_BARRIER();
#pragma unroll 1
        for (int i = 0; i < 60; i += 6) {
            LSTEP(rb, 1, i); LSTEP(rc, 0, i + 1); LSTEP(ra, 1, i + 2); LSTEP(rb, 0, i + 3); LSTEP(rc, 1, i + 4); LSTEP(ra, 0, i + 5);
        }
        LSTEP(rb, 1, 60); LSTEP(rc, 0, 61); LSTEP(ra, 1, 62); LSTEP(rb, 0, 63);
        asm volatile("s_waitcnt vmcnt(0)" : "+v"(ra[0]), "+v"(rb[0]), "+v"(rc[0]) :: "memory");
#undef LSTEP
#undef WAIT32
#undef LOAD_SET
#undef STORE_SET
    } else {
        const int vs = vg * 4 + F.wave, n = lane & 15, q4 = lane >> 4;
        f32x4 S[8];
#pragma unroll
        for (int i = 0; i < 8; ++i) S[i] = (f32x4){0.f, 0.f, 0.f, 0.f};
        f32x4 Op[4];
#pragma unroll
        for (int t = 0; t < 4; ++t) Op[t] = (f32x4){0.f, 0.f, 0.f, 0.f};
        GAS bf16* obase = (GAS bf16*)ob + (size_t)(b * SEQ + 4 * q4) * 1024 + h * 128 + vs * 16 + n;
        SCAN_STEP_BARRIER();
#pragma unroll 1
        for (int i = 0; i < 64; ++i) {
            LAS unsigned char* buf = F.lds + (i & 1) * SBUF;
            if (i > 0) { GAS bf16* op = obase + (size_t)(i - 1) * 64 * 1024;
#pragma unroll
                for (int t = 0; t < 4; ++t) { const unsigned p01 = pk2(Op[t][0], Op[t][1]), p23 = pk2(Op[t][2], Op[t][3]);
                    op[(size_t)(16 * t + 0) * 1024] = (bf16)p01; op[(size_t)(16 * t + 1) * 1024] = (bf16)(p01 >> 16); op[(size_t)(16 * t + 2) * 1024] = (bf16)p23; op[(size_t)(16 * t + 3) * 1024] = (bf16)(p23 >> 16); } }
            f32x4 u[4];
#pragma unroll
            for (int t = 0; t < 4; ++t) { const u32x2 uw = *(const LAS u32x2*)(buf + OPS_BYTES + ((F.wave * 4 + t) * 64 + lane) * 8); u[t] = (f32x4){bflo(uw.x), bfhi(uw.x), bflo(uw.y), bfhi(uw.y)}; }
            const float gl = glds[i];
            bf16x8 wf[16], qf[16];
#pragma unroll
            for (int f = 0; f < 16; ++f) { wf[f] = *(const LAS bf16x8*)(buf + (f * 64 + lane) * 16); qf[f] = *(const LAS bf16x8*)(buf + 16384 + (f * 64 + lane) * 16); }
            bf16x8 sb[4];
#pragma unroll
            for (int kk = 0; kk < 4; ++kk) { u32x4 w; w.x = pk2(S[2 * kk][0], S[2 * kk][1]); w.y = pk2(S[2 * kk][2], S[2 * kk][3]); w.z = pk2(S[2 * kk + 1][0], S[2 * kk + 1][1]); w.w = pk2(S[2 * kk + 1][2], S[2 * kk + 1][3]); sb[kk] = __builtin_bit_cast(bf16x8, w); }
            __builtin_amdgcn_sched_barrier(0);
            f32x4 P[4], O[4];
#pragma unroll
            for (int t = 0; t < 4; ++t) { P[t] = (f32x4){0.f, 0.f, 0.f, 0.f};
#pragma unroll
                for (int kk = 0; kk < 4; ++kk) P[t] = __builtin_amdgcn_mfma_f32_16x16x32_bf16(wf[t * 4 + kk], sb[kk], P[t], 0, 0, 0); }
            __builtin_amdgcn_sched_barrier(0);
            bf16x8 af[8], kf[16];
#pragma unroll
            for (int f = 0; f < 16; ++f) kf[f] = *(const LAS bf16x8*)(buf + 32768 + (f * 64 + lane) * 16);
#pragma unroll
            for (int f = 0; f < 8; ++f) af[f] = *(const LAS bf16x8*)(buf + 49152 + (f * 64 + lane) * 16);
            __builtin_amdgcn_sched_barrier(0);
#pragma unroll
            for (int t = 0; t < 4; ++t) { O[t] = (f32x4){0.f, 0.f, 0.f, 0.f};
#pragma unroll
                for (int kk = 0; kk < 4; ++kk) O[t] = __builtin_amdgcn_mfma_f32_16x16x32_bf16(qf[t * 4 + kk], sb[kk], O[t], 0, 0, 0); }
            __builtin_amdgcn_sched_barrier(0);
            bf16x8 vb[2];
#pragma unroll
            for (int k2 = 0; k2 < 2; ++k2) { const f32x4 v0 = u[2 * k2] - P[2 * k2], v1 = u[2 * k2 + 1] - P[2 * k2 + 1]; u32x4 w; w.x = pk2(v0[0], v0[1]); w.y = pk2(v0[2], v0[3]); w.z = pk2(v1[0], v1[1]); w.w = pk2(v1[2], v1[3]); vb[k2] = __builtin_bit_cast(bf16x8, w); }
#pragma unroll
            for (int mt = 0; mt < 8; ++mt) { S[mt] = S[mt] * gl;
#pragma unroll
                for (int k2 = 0; k2 < 2; ++k2) S[mt] = __builtin_amdgcn_mfma_f32_16x16x32_bf16(kf[mt * 2 + k2], vb[k2], S[mt], 0, 0, 0); }
#pragma unroll
            for (int t = 0; t < 4; ++t)
#pragma unroll
                for (int k2 = 0; k2 < 2; ++k2) O[t] = __builtin_amdgcn_mfma_f32_16x16x32_bf16(af[t * 2 + k2], vb[k2], O[t], 0, 0, 0);
#pragma unroll
            for (int t = 0; t < 4; ++t) Op[t] = O[t];
            SCAN_STEP_BARRIER();
        }
        { GAS bf16* op = obase + (size_t)63 * 64 * 1024;
#pragma unroll
            for (int t = 0; t < 4; ++t) { const unsigned p01 = pk2(Op[t][0], Op[t][1]), p23 = pk2(Op[t][2], Op[t][3]);
                op[(size_t)(16 * t + 0) * 1024] = (bf16)p01; op[(size_t)(16 * t + 1) * 1024] = (bf16)(p01 >> 16); op[(size_t)(16 * t + 2) * 1024] = (bf16)p23; op[(size_t)(16 * t + 3) * 1024] = (bf16)(p23 >> 16); } }
        asm volatile("s_waitcnt vmcnt(0)" ::: "memory");
    }
#undef SCAN_STEP_BARRIER
#undef GLD16
#undef WAIT18
}

DI void gnorm_phase(Frame& F, int l) {
    const bf16* ob = (const bf16*)(F.ws + WS_OBUF); const bf16* proj = (const bf16*)(F.ws + WS_PROJ); bf16* cat = (bf16*)(F.ws + WS_CAT);
    const int lane = F.lane; const f32x2 nw = *(const GAS f32x2*)(FIN(I_DNW) + l * 128 + 2 * lane);
    const int gw = F.bid * NWAVES + F.wave, NGW = F.G * NWAVES;
    for (int it0 = gw * 4; it0 < NTOK * 8; it0 += NGW * 4) {
        f32x2 o[4]; unsigned z[4], ow[4];
#pragma unroll
        for (int i = 0; i < 4; ++i) { const int it = it0 + i, tok = it >> 3, h = it & 7;
            ow[i] = *(const GAS unsigned*)(ob + (size_t)tok * 1024 + h * 128 + 2 * lane); z[i] = *(const GAS unsigned*)(proj + (size_t)tok * PN + C_DZ + h * 128 + 2 * lane); }
        __builtin_amdgcn_sched_barrier(0);
#pragma unroll
        for (int i = 0; i < 4; ++i) { const int it = it0 + i, tok = it >> 3, h = it & 7; o[i] = (f32x2){bflo(ow[i]), bfhi(ow[i])};
            const float ms = wave_sum(o[i].x * o[i].x + o[i].y * o[i].y) * (1.0f / 128.0f);
            const float r = 1.0f / sqrtf(ms + RMS_EPS);
            *(GAS unsigned*)(cat + (size_t)tok * DM + 1024 + h * 128 + 2 * lane) = pk2(o[i].x * r * nw.x * siluf_(bflo(z[i])), o[i].y * r * nw.y * siluf_(bfhi(z[i]))); }
    }
}

DI int moe_table(Frame& F, const unsigned* cnt) {
    LAS int* tab = (LAS int*)(F.lds + MOETAB_OFF);
    __syncthreads();
    if (F.tid < 16) tab[17 + F.tid] = (int)__hip_atomic_load(cnt + 64 * F.tid, __ATOMIC_RELAXED, __HIP_MEMORY_SCOPE_AGENT);
    __syncthreads();
    if (F.tid == 0) { int acc = 0, np = 0;
        for (int e = 0; e < 16; ++e) { const int c = tab[17 + e]; tab[e] = acc; acc += c >> 8; if (c & 255) { tab[34 + np] = e; ++np; } }
        tab[16] = acc; tab[33] = np; }
    __syncthreads();
    return tab[16] + tab[33];
}

constexpr int NS = 11, NSTEPS = 1 + DEPTH * NS;
struct Args { const float* in[18]; float* out; unsigned char* ws; int s_lo, s_hi; };

__global__ void __launch_bounds__(NTHREADS, 2) fwd_kernel(Args args) {
    extern __shared__ __attribute__((aligned(16))) unsigned char lds_raw[];
    Frame F;
    F.lds = (LAS unsigned char*)lds_raw;
    F.tid = threadIdx.x; F.lane = F.tid & 63; F.wave = __builtin_amdgcn_readfirstlane(F.tid >> 6);
    const int wave0 = F.wave;
    F.G = gridDim.x; F.bid = blockIdx.x; F.ws = (GAS unsigned char*)args.ws; F.out = (GAS float*)args.out;
    F.in = args.in;
    unsigned* ctl = (unsigned*)(F.ws + WS_CTL);
    if (F.tid < 4) ((LAS unsigned*)(F.lds + MISC_OFF))[F.tid] = 0u;
    __syncthreads();
    const int lo = args.s_lo, hi = args.s_hi;
    XcdBarrier bar; bar.bar = ctl + CW_BAR; bar.x = 0; bar.st = nullptr;
    if (hi - lo > 1) bar = xcd_barrier_post(ctl + CW_BAR, (volatile LAS unsigned*)(F.lds + MISC_OFF));
#ifndef PHASE_MASK
#define PHASE_MASK 0xfff
#endif
#define PHM(k) (((PHASE_MASK) >> (k)) & 1)
#define REFRESH() do { int z_ = 0; asm volatile("" : "+v"(z_)); const int ln_ = __builtin_amdgcn_mbcnt_hi(-1, __builtin_amdgcn_mbcnt_lo(-1, z_)); int wv_ = wave0; asm volatile("" : "+s"(wv_)); F.lane = ln_; F.wave = wv_; F.tid = wv_ * 64 + ln_; asm volatile("" : "+s"(F.ws)); } while (0)
#ifndef PROBE_A
#define PROBE_A -1
#define PROBE_B -1
#endif
#ifndef PROBE_SHIFT
#define PROBE_SHIFT 0.5f
#endif
#define TSTAMP(k) do { if (PROBE_A >= 0 && F.bid == 0 && F.tid == 0) ((unsigned long long*)(F.ws + WS_CTL + 65536))[k] = __builtin_amdgcn_s_memrealtime(); } while (0)
#define RUN(s) (lo <= (s) && (s) < hi)
#define SEAM(s) do { if ((s) + 1 < hi || PROBE_A >= 0) { XcdBarrier b2_ = bar; unsigned* bp_ = (unsigned*)(F.ws + WS_CTL) + CW_BAR; asm volatile("" : "+s"(bp_)); b2_.bar = bp_; xcd_barrier(b2_); } TSTAMP((s) + 1); } while (0)
#define P_CNT ((unsigned*)(F.ws + WS_CTL) + CW_CNT)
#define P_LIST ((int*)(F.ws + WS_LIST))
#define P_WSEL ((float*)(F.ws + WS_WSEL))
#define P_XB ((bf16*)(F.ws + WS_XB))
#define P_PROJB ((bf16*)(F.ws + WS_PROJ))
#define P_CATB ((bf16*)(F.ws + WS_CAT))
#define P_YB ((bf16*)(F.ws + WS_Y))
#define P_X1 ((float*)(F.ws + WS_X1))
#define P_X1B ((bf16*)(F.ws + WS_X1B))
#define P_HID ((bf16*)(F.ws + WS_HID))
#define P_O2 ((bf16*)(F.ws + WS_O2))
#define P_XW ((float*)(F.ws + WS_X))
#define P_ABP ((float*)(F.ws + WS_AB))
    TSTAMP(0);
    if (PHM(11) && RUN(0)) { REFRESH();
        rope_phase(F);
        ln_phase<0, false>(F, FIN(I_X), nullptr, nullptr, nullptr, nullptr, P_XB, FIN(I_WIN) + C_AB, PROJ, true, P_ABP, nullptr, nullptr, nullptr, nullptr);
        __syncthreads();
        convw_phase(F, 0, 0, 0, F.G, 0, CONV_I_IN);
        __syncthreads();
        SEAM(0);
    }
    for (int l = 0; l < DEPTH; ++l) {
        const int sb = 1 + l * NS;
        const int slot = l & 1;
#define P_WIN_T ((const bf16*)(F.ws + WS_WIN) + (size_t)slot * PN * DM)
#define P_WOUT_T ((const bf16*)(F.ws + WS_WOUT) + (size_t)slot * DM * DM)
#define P_WGU_T ((const bf16*)(F.ws + WS_WGU) + (size_t)slot * NEXP * 1024 * DM)
#define P_WD_T ((const bf16*)(F.ws + WS_WD) + (size_t)slot * NEXP * DM * DEXP)
#define P_XRES P_XB
        if (PHM(0) && RUN(sb + 0)) { REFRESH(); TSTAMP(sb + 1); }
        if (PHM(1) && RUN(sb + 1)) { REFRESH();
            if (F.bid == 0 && F.tid < 16) __hip_atomic_store(P_CNT + 64 * F.tid, 0u, __ATOMIC_RELAXED, __HIP_MEMORY_SCOPE_AGENT);
            g8::DenseSched<NTOK, PN - C_DQ, DM> S; S.init(P_WIN_T + (size_t)C_DQ * DM, F.G, F.bid);
            g8::EpiBf16 E{P_PROJB + C_DQ, PN};
            g8::gemm_phase<g8::EpiBf16, g8::DenseSched<NTOK, PN - C_DQ, DM>>(F.lds, F.wave, (const char*)P_XB, DM, S, E);
            SEAM(sb + 1);
        }
        if (PHM(2) && RUN(sb + 2)) { REFRESH();
            if (F.bid < IP_ATT_UNITS) {
                g8::DenseSched<NTOK, C_DQ, DM> S; S.init(P_WIN_T, F.G, F.bid);
                g8::EpiBf16 E{P_PROJB, PN};
                g8::gemm_phase<g8::EpiBf16, g8::DenseSched<NTOK, C_DQ, DM>>(F.lds, F.wave, (const char*)P_XB, DM, S, E);
                __syncthreads(); dn_prep_item(F, F.bid * 2 + (F.wave >> 2), l);
            } else {
                for (int it = IP_ATT_UNITS + (F.bid - IP_ATT_UNITS); it < 512; it += F.G - IP_ATT_UNITS) { __syncthreads(); dn_prep_item(F, it * 2 + (F.wave >> 2), l); }
            }
            SEAM(sb + 2);
        }
        if (PHM(3) && RUN(sb + 3)) { REFRESH(); TSTAMP(sb + 4); }
        if (PHM(4) && RUN(sb + 4)) { REFRESH();
            if (F.bid < 32) dn_scan_phase(F);
            else { for (int u = F.bid - 32; u < 128; u += F.G - 32) attn_unit(F, u, l); }
            if (F.bid >= 32 && F.bid < 32 + CONV_HELPERS) {
                convw_phase(F, l, l & 1, 32, CONV_HELPERS, CONV_I_IN, CONV_ITEMS);
                if (l + 1 < DEPTH) convw_phase(F, l + 1, (l + 1) & 1, 32, CONV_HELPERS, 0, CONV_I_IN);
                __syncthreads(); }
            SEAM(sb + 4); }
        if (PHM(5) && RUN(sb + 5)) { REFRESH(); gnorm_phase(F, l);
            SEAM(sb + 5); }
        if (PHM(6) && RUN(sb + 6)) { REFRESH();
            g8::DenseSched<NTOK, DM, DM> S; S.init(P_WOUT_T, F.G, F.bid);
            g8::EpiResid E{P_XRES, P_YB};
            g8::gemm_phase<g8::EpiResid, g8::DenseSched<NTOK, DM, DM>>(F.lds, F.wave, (const char*)P_CATB, DM, S, E);
            SEAM(sb + 6);
        }
        if (PHM(7) && RUN(sb + 7)) { REFRESH();
            ln_phase<1, true>(F, P_YB, nullptr, FIN(I_LN1G) + l * DM, FIN(I_LN1B) + l * DM, nullptr, P_X1B, FIN(I_RW), 16, true, nullptr, FIN(I_RB), P_CNT, P_LIST, P_WSEL);
            SEAM(sb + 7);
        }
        if (PHM(8) && RUN(sb + 8)) { REFRESH();
            const int mt = moe_table(F, P_CNT);
            g8::MoeUni S; S.tab = (const LAS int*)(F.lds + MOETAB_OFF); S.list = P_LIST; S.Wgu = (const char*)P_WGU_T; S.Wd = (const char*)P_WD_T; S.G = F.G; S.c = F.bid; S.MT = mt;
            g8::gemm_moe_phase(F.lds, F.wave, (const char*)P_X1B, (const char*)P_HID, S, P_HID, P_WSEL, P_O2, (unsigned*)(F.ws + WS_CTL) + CW_DONE + l * 128 * 16, (unsigned*)(F.ws + WS_CTL) + CW_BAR + XB_TMO);
            SEAM(sb + 8);
        }
        if (PHM(9) && RUN(sb + 9)) { REFRESH(); TSTAMP(sb + 10); }
        if (PHM(10) && RUN(sb + 10)) { REFRESH();
            const bool lastl = (l == DEPTH - 1);
            ln_phase<2, true>(F, P_X1B, P_O2, FIN(I_LN2G) + l * DM, FIN(I_LN2B) + l * DM, lastl ? (float*)F.out : nullptr, lastl ? (bf16*)nullptr : P_XB, FIN(I_WIN) + (size_t)(lastl ? l : l + 1) * DM * PROJ + C_AB, PROJ, !lastl, P_ABP, nullptr, nullptr, nullptr, nullptr);
            SEAM(sb + 10);
        }
    }
#if PROBE_A >= 0
    {
        REFRESH();
        { XcdBarrier b2_ = bar; unsigned* bp_ = (unsigned*)(F.ws + WS_CTL) + CW_BAR; asm volatile("" : "+s"(bp_)); b2_.bar = bp_; xcd_barrier(b2_); }
        const unsigned long long* ts = (const unsigned long long*)(F.ws + WS_CTL + 65536);
        float ta = 0.f, tb2 = 0.f;
        for (int l = 0; l < DEPTH; ++l) {
            if (PROBE_A < 11) ta += (float)(__hip_atomic_load(ts + 1 + l * NS + PROBE_A + 1, __ATOMIC_RELAXED, __HIP_MEMORY_SCOPE_AGENT) - __hip_atomic_load(ts + 1 + l * NS + PROBE_A, __ATOMIC_RELAXED, __HIP_MEMORY_SCOPE_AGENT)) * 0.01f;
            if (PROBE_B < 11) tb2 += (float)(__hip_atomic_load(ts + 1 + l * NS + PROBE_B + 1, __ATOMIC_RELAXED, __HIP_MEMORY_SCOPE_AGENT) - __hip_atomic_load(ts + 1 + l * NS + PROBE_B, __ATOMIC_RELAXED, __HIP_MEMORY_SCOPE_AGENT)) * 0.01f;
        }
        if (PROBE_A == 11) ta = (float)(__hip_atomic_load(ts + 1, __ATOMIC_RELAXED, __HIP_MEMORY_SCOPE_AGENT) - __hip_atomic_load(ts + 0, __ATOMIC_RELAXED, __HIP_MEMORY_SCOPE_AGENT)) * 0.01f;
        if (PROBE_B == 11) tb2 = (float)(__hip_atomic_load(ts + 1, __ATOMIC_RELAXED, __HIP_MEMORY_SCOPE_AGENT) - __hip_atomic_load(ts + 0, __ATOMIC_RELAXED, __HIP_MEMORY_SCOPE_AGENT)) * 0.01f;
        if (PROBE_A == 12) ta = (float)(__hip_atomic_load(ts + NSTEPS, __ATOMIC_RELAXED, __HIP_MEMORY_SCOPE_AGENT) - __hip_atomic_load(ts + 0, __ATOMIC_RELAXED, __HIP_MEMORY_SCOPE_AGENT)) * 0.01f;
        ta = __expf((rintf(__logf(fmaxf(ta, 1.f)) * 7.15495f + PROBE_SHIFT) - PROBE_SHIFT) * 0.13976194f);
        tb2 = __expf((rintf(__logf(fmaxf(tb2, 1.f)) * 7.15495f + PROBE_SHIFT) - PROBE_SHIFT) * 0.13976194f);
        const float cv = sqrtf(ta * 0.1f);
        for (size_t i = (size_t)F.bid * NTHREADS + F.tid; i < (size_t)NTOK * DM; i += (size_t)F.G * NTHREADS) F.out[i] = (i == 0) ? tb2 : cv;
    }
#endif
#undef RUN
#undef SEAM
}

extern "C" void kernel_launch(void* const* d_in, const int* in_sizes, int n_in, void* d_out, int out_size, void* d_ws, size_t ws_size, hipStream_t stream) {
    static int grid = 0;
    if (grid == 0) {
        if (n_in != 18 || out_size != NTOK * DM || ws_size < WS_END) { fprintf(stderr, "kernel_launch: unexpected shapes (n_in %d, out %d, ws %zu < %zu)\n", n_in, out_size, ws_size, (size_t)WS_END); grid = -1; return; }
        int dev = 0, cus = 0, per_cu = 0;
        if (hipGetDevice(&dev) != hipSuccess || hipDeviceGetAttribute(&cus, hipDeviceAttributeMultiprocessorCount, dev) != hipSuccess) { grid = -1; return; }
        if (hipFuncSetAttribute((const void*)fwd_kernel, hipFuncAttributeMaxDynamicSharedMemorySize, LDS_BYTES) != hipSuccess) { fprintf(stderr, "kernel_launch: hipFuncSetAttribute failed\n"); grid = -1; return; }
        if (hipOccupancyMaxActiveBlocksPerMultiprocessor(&per_cu, (const void*)fwd_kernel, NTHREADS, LDS_BYTES) != hipSuccess || per_cu < 1) { fprintf(stderr, "kernel_launch: occupancy query says %d\n", per_cu); }
        (void)hipGetLastError();
        grid = cus;
    }
    if (grid < 0) return;
    (void)hipMemsetAsync((char*)d_ws + WS_CTL, 0, CTL_BYTES, stream);
    Args a{};
    for (int i = 0; i < 18; ++i) a.in[i] = (const float*)d_in[i];
    a.out = (float*)d_out; a.ws = (unsigned char*)d_ws;
#if MK_ONE_LAUNCH
    a.s_lo = 0; a.s_hi = NSTEPS;
    hipLaunchKernelGGL(fwd_kernel, dim3(grid), dim3(NTHREADS), LDS_BYTES, stream, a);
#else
    for (int s = 0; s < NSTEPS; ++s) {
        a.s_lo = s; a.s_hi = s + 1;
        hipLaunchKernelGGL(fwd_kernel, dim3(grid), dim3(NTHREADS), LDS_BYTES, stream, a);
    }
#endif
}
```

```cpp
#include <hip/hip_runtime.h>
#include <cstdio>
#include <cstdint>

#ifndef MK_ONE_LAUNCH
#define MK_ONE_LAUNCH 1
#endif

#define DI __device__ __forceinline__
#define LAS __attribute__((address_space(3)))
#define GAS __attribute__((address_space(1)))
typedef unsigned short bf16;
typedef short bf16x8 __attribute__((ext_vector_type(8)));
typedef short s16x4 __attribute__((ext_vector_type(4)));
typedef float f32x4 __attribute__((ext_vector_type(4)));
typedef float f32x2 __attribute__((ext_vector_type(2)));
typedef unsigned u32x4 __attribute__((ext_vector_type(4)));
typedef unsigned u32x2 __attribute__((ext_vector_type(2)));

constexpr int NTOK = 8192, SEQ = 4096, DM = 2048, PROJ = 5392, PN = 5376, DEPTH = 4;
constexpr int C_SQ = 0, C_SK = 1024, C_SV = 1152, C_DQ = 1280, C_DK = 2304, C_DV = 3328, C_DZ = 4352, C_AB = 5376;
constexpr int NEXP = 16, DEXP = 512;
constexpr float ALPHA = 1.681792830507429f;
constexpr float LN_EPS = 1e-5f, RMS_EPS = 1e-6f;

constexpr size_t MiB = 1u << 20;
constexpr size_t WS_CTL = 0, CTL_BYTES = 1 * MiB;
constexpr size_t WS_COS = 1 * MiB, WS_SIN = 2 * MiB;
constexpr size_t WS_AB = 4 * MiB;
constexpr size_t WS_G = 4 * MiB + 512 * 1024, WS_BETA = WS_G + 256 * 1024;
constexpr size_t WS_WSEL = 5 * MiB, WS_LIST = 5 * MiB + 64 * 1024;
constexpr size_t WS_WIN = 8 * MiB, WS_WOUT = 50 * MiB, WS_WGU = 66 * MiB, WS_WD = 194 * MiB;
constexpr size_t WS_X = 258 * MiB, WS_XB = 322 * MiB, WS_PROJ = 354 * MiB, WS_Y = 438 * MiB, WS_X1 = 502 * MiB, WS_X1B = 566 * MiB;
constexpr size_t WS_CAT = 598 * MiB, WS_OBUF = 630 * MiB, WS_QKV = 662 * MiB, WS_SCAN = 710 * MiB, WS_HID = 798 * MiB, WS_O2 = 814 * MiB, WS_END = 878 * MiB;
constexpr int CW_BAR = 4096;
constexpr int CW_CNT = 64;
constexpr int CW_DONE = 32768;

DI unsigned f2bf(float f) { unsigned u = __builtin_bit_cast(unsigned, f); return (u + 0x7fffu + ((u >> 16) & 1u)) >> 16; }
typedef __bf16 bf16n2 __attribute__((ext_vector_type(2)));
DI unsigned pk2(float lo, float hi) { return __builtin_bit_cast(unsigned, __builtin_convertvector((f32x2){lo, hi}, bf16n2)); }
DI unsigned pk2n(float lo, float hi) { return __builtin_bit_cast(unsigned, __builtin_convertvector((f32x2){lo, hi}, bf16n2)); }
DI float bflo(unsigned w) { return __builtin_bit_cast(float, w << 16); }
DI float bfhi(unsigned w) { return __builtin_bit_cast(float, w & 0xffff0000u); }
#define swz_xor(v, pat) __builtin_bit_cast(float, __builtin_amdgcn_ds_swizzle(__builtin_bit_cast(int, (float)(v)), (pat)))
#define SWZ_X1 0x041F
#define SWZ_X2 0x081F
#define SWZ_X4 0x101F
#define SWZ_X8 0x201F
#define SWZ_X16 0x401F
DI float xor32_sum(float v) { const unsigned u = __builtin_bit_cast(unsigned, v); const auto r = __builtin_amdgcn_permlane32_swap(u, u, false, false); return __builtin_bit_cast(float, (unsigned)r[0]) + __builtin_bit_cast(float, (unsigned)r[1]); }
DI float xor32_max(float v) { const unsigned u = __builtin_bit_cast(unsigned, v); const auto r = __builtin_amdgcn_permlane32_swap(u, u, false, false); return fmaxf(__builtin_bit_cast(float, (unsigned)r[0]), __builtin_bit_cast(float, (unsigned)r[1])); }
DI float wave_sum(float v) {
    v += swz_xor(v, SWZ_X1); v += swz_xor(v, SWZ_X2); v += swz_xor(v, SWZ_X4); v += swz_xor(v, SWZ_X8); v += swz_xor(v, SWZ_X16);
    return xor32_sum(v);
}
DI float sigmoidf_(float x) { return __builtin_amdgcn_rcpf(1.0f + __expf(-x)); }
DI float siluf_(float x) { return x * __builtin_amdgcn_rcpf(1.0f + __expf(-x)); }
#define LDS_WAIT() asm volatile("s_waitcnt lgkmcnt(0)" ::: "memory")

typedef short s16x4 __attribute__((ext_vector_type(4)));
#define XB_TMO      128
#define XB_XCNT(j)  (256  + 64 * (j))
#define XB_XSUB(j)  (1280 + 64 * (j))
#define XB_XGEN(j)  (2304 + 64 * (j))
#define XB_TOP      3328
#define XB_TOPGEN   3392
#define XCD_BAR_WORDS 3456
#define XB_SPIN_CAP (1u << 18)
__device__ __forceinline__ unsigned xb_ld(unsigned* p)              { return __hip_atomic_load(p, __ATOMIC_RELAXED, __HIP_MEMORY_SCOPE_AGENT); }
__device__ __forceinline__ unsigned xb_add(unsigned* p, unsigned v) { return __hip_atomic_fetch_add(p, v, __ATOMIC_RELAXED, __HIP_MEMORY_SCOPE_AGENT); }
__device__ __forceinline__ unsigned xb_xcc_id() { return (unsigned)__builtin_amdgcn_s_getreg((3 << 11) | 20) & 0xFu; }
#define XB_SPIN(cond, bar) do { unsigned _sp = 0; while (cond) { __builtin_amdgcn_s_sleep(1); \
    if ((++_sp & 255u) == 0u) { if (xb_ld(&(bar)[XB_TMO])) break; if (_sp > XB_SPIN_CAP) { atomicAdd(&(bar)[XB_TMO], 1u); break; } } } } while (0)
struct XcdBarrier { unsigned* bar; unsigned x; volatile LAS unsigned* st; };
__device__ __forceinline__ XcdBarrier xcd_barrier_post(unsigned* bar, volatile LAS unsigned* st) {
    XcdBarrier b; b.bar = bar; b.x = xb_xcc_id(); b.st = st;
    if (threadIdx.x == 0) (void)xb_add(&bar[XB_XCNT(b.x)], 1u);
    return b;
}
__device__ __forceinline__ void xcd_barrier_complete(unsigned* bar, unsigned x, unsigned& nloc, unsigned& nx) {
    const unsigned G = gridDim.x * gridDim.y * gridDim.z;
    unsigned sum, cnt, mine, sp = 0u;
    for (;;) {
        sum = 0u; cnt = 0u; mine = 0u;
#pragma unroll
        for (unsigned j = 0; j < 16; ++j) { const unsigned c = xb_ld(&bar[XB_XCNT(j)]); sum += c; cnt += (c > 0u) ? 1u : 0u; mine = (j == x) ? c : mine; }
        if (sum == G) break;
        __builtin_amdgcn_s_sleep(1);
        if ((++sp & 255u) == 0u) { if (xb_ld(&bar[XB_TMO])) break; if (sp > XB_SPIN_CAP) { atomicAdd(&bar[XB_TMO], 1u); break; } }
    }
    nloc = mine > 0u ? mine : 1u; nx = cnt > 0u ? cnt : 1u;
}
__device__ __forceinline__ void xcd_barrier(const XcdBarrier& b) {
    asm volatile("s_waitcnt vmcnt(0)" ::: "memory");
    __syncthreads();
    if (threadIdx.x == 0) {
        unsigned* bar = b.bar;
        __builtin_amdgcn_s_waitcnt(0);
        asm volatile("buffer_inv sc1" ::: "memory");
        unsigned nloc = b.st[0], nx = b.st[1];
        if (nloc == 0u) { xcd_barrier_complete(bar, b.x, nloc, nx); b.st[0] = nloc; b.st[1] = nx; }
        const unsigned old = xb_add(&bar[XB_XSUB(b.x)], 1u);
        const unsigned gen = old / nloc;
        if (old + 1u == (gen + 1u) * nloc) {
            __builtin_amdgcn_fence(__ATOMIC_RELEASE, "agent");
            asm volatile("s_waitcnt vmcnt(0)" ::: "memory");
            const unsigned og = xb_add(&bar[XB_TOP], 1u);
            const unsigned tg = og / nx;
            if (og + 1u == (tg + 1u) * nx) xb_add(&bar[XB_TOPGEN], 1u);
            else XB_SPIN(xb_ld(&bar[XB_TOPGEN]) == tg, bar);
            xb_add(&bar[XB_XGEN(b.x)], 1u);
            asm volatile("s_waitcnt vmcnt(0)" ::: "memory");
        } else {
            XB_SPIN(xb_ld(&bar[XB_XGEN(b.x)]) == gen, bar);
            asm volatile("s_waitcnt vmcnt(0)" ::: "memory");
        }
    }
    __syncthreads();
}

namespace g8 {
constexpr int BM = 256, BK = 64, HALF = 128, HTB = HALF * BK * 2, STAGE_BYTES = 8 * HTB, NXCD = 8, WGM = 8;
DI int lds_byte(int r, int c) { const int st = (r >> 4) * 2 + (c >> 5), rr = r & 15, cc = c & 31, ob = rr * 64 + cc * 2; return st * 1024 + (ob ^ (((ob >> 9) & 1) << 5)); }
DI void stage_rc(int b, int& R, int& C) { const int st = b / 1024, sb = b % 1024, swz = sb ^ (((sb >> 9) & 1) << 5); R = (st >> 1) * 16 + swz / 64; C = (st & 1) * 32 + (swz % 64) / 2; }
DI int perm32(int rho) { const int n = rho >> 4, i = rho & 15; return 8 * (i >> 2) + 4 * n + (i & 3); }

struct Unit { const char* B; int m0, n0, rows, e; };

template <int M_, int N_, int K_> struct DenseSched {
    static constexpr bool GATHER = false;
    static constexpr int nM = M_ / BM, nN = N_ / BM, nwg = nM * nN, K = K_;
    int G, c; const char* Bt;
    DI void init(const void* Bt_, int G_, int c_) { G = G_; c = c_; Bt = (const char*)Bt_; }
    DI bool next(int i, Unit& u) const {
        const int L = i * G + c; if (L >= nwg) return false;
        int wgid = L; { constexpr int q = nwg / NXCD, r = nwg % NXCD; const int xcd = wgid % NXCD, off = wgid / NXCD; wgid = (xcd < r ? xcd * (q + 1) : r * (q + 1) + (xcd - r) * q) + off; }
        constexpr int nig = WGM * nN; const int gid = wgid / nig, fm = gid * WGM, gsz = (nM - fm) < WGM ? (nM - fm) : WGM;
        const int pm = fm + ((wgid % nig) % gsz), pn = (wgid % nig) / gsz;
        u.m0 = pm * BM; u.n0 = pn * BM; u.rows = BM; u.e = 0; u.B = Bt + (size_t)pn * BM * K * 2; return true;
    }
    DI unsigned arow(const Unit& u, int r) const { return (unsigned)(u.m0 + r); }
};
DI unsigned cvt_pk_bf16(float lo, float hi) { unsigned r; asm volatile("v_cvt_pk_bf16_f32 %0, %1, %2" : "=v"(r) : "v"(lo), "v"(hi)); return r; }

struct EpiBf16 {
    static constexpr bool PERM = true;
    bf16* O; int ldc;
    DI void operator()(const f32x4 (&acc)[2][2][4][2], const Unit& u, int wr, int wc, int fr, int fq) const {
        const int row0 = u.m0 + wr * 64 + fr, col0 = u.n0 + wc * 32 + 8 * fq;
#pragma unroll
        for (int ai = 0; ai < 2; ++ai)
#pragma unroll
            for (int m = 0; m < 4; ++m) { bf16* rowp = O + (size_t)(row0 + ai * HALF + m * 16) * ldc + col0;
#pragma unroll
                for (int bj = 0; bj < 2; ++bj) { const f32x4 v0 = acc[ai][bj][m][0], v1 = acc[ai][bj][m][1];
                    u32x4 w; w.x = cvt_pk_bf16(v0[0], v0[1]); w.y = cvt_pk_bf16(v0[2], v0[3]); w.z = cvt_pk_bf16(v1[0], v1[1]); w.w = cvt_pk_bf16(v1[2], v1[3]);
                    *(u32x4*)(rowp + bj * HALF) = w; } }
    }
};
struct EpiResid {
    static constexpr bool PERM = true;
    const bf16* X; bf16* Y;
    DI void operator()(const f32x4 (&acc)[2][2][4][2], const Unit& u, int wr, int wc, int fr, int fq) const {
        const int row0 = u.m0 + wr * 64 + fr, col0 = u.n0 + wc * 32 + 8 * fq;
#pragma unroll
        for (int ai = 0; ai < 2; ++ai) {
            u32x4 xr[4][2];
#pragma unroll
            for (int m = 0; m < 4; ++m) { const size_t off = (size_t)(row0 + ai * HALF + m * 16) * DM + col0;
#pragma unroll
                for (int bj = 0; bj < 2; ++bj) xr[m][bj] = *(const GAS u32x4*)(X + off + bj * HALF); }
            __builtin_amdgcn_sched_barrier(0);
#pragma unroll
            for (int m = 0; m < 4; ++m) { const size_t off = (size_t)(row0 + ai * HALF + m * 16) * DM + col0;
#pragma unroll
                for (int bj = 0; bj < 2; ++bj) { const u32x4 x = xr[m][bj]; const f32x4 v0 = acc[ai][bj][m][0], v1 = acc[ai][bj][m][1];
                    u32x4 o; o.x = cvt_pk_bf16(bflo(x.x) * ALPHA + v0[0], bfhi(x.x) * ALPHA + v0[1]); o.y = cvt_pk_bf16(bflo(x.y) * ALPHA + v0[2], bfhi(x.y) * ALPHA + v0[3]);
                    o.z = cvt_pk_bf16(bflo(x.z) * ALPHA + v1[0], bfhi(x.z) * ALPHA + v1[1]); o.w = cvt_pk_bf16(bflo(x.w) * ALPHA + v1[2], bfhi(x.w) * ALPHA + v1[3]);
                    *(GAS u32x4*)(Y + off + bj * HALF) = o; } }
        }
    }
};
template <class Epi, class Sched>
DI void gemm_phase(LAS unsigned char* lds, const int wave_id, const char* Abase, const int K, const Sched& S, const Epi& E) {
    int z_ = 0; asm volatile("" : "+v"(z_));
    const int lane = __builtin_amdgcn_mbcnt_hi(-1, __builtin_amdgcn_mbcnt_lo(-1, z_)), wid = wave_id, tid = wid * 64 + lane, wr = wid >> 2, wc = wid & 3, fr = lane & 15, fq = lane >> 4;
    const int nt = K / BK;
    constexpr bool GATHER = Sched::GATHER;
    int Rr[2]; unsigned C2[2], voffB[2], voffA[2];
#pragma unroll
    for (int i = 0; i < 2; ++i) { int R, C; stage_rc(tid * 16 + i * 8192, R, C); const int Rb = Epi::PERM ? ((R & ~31) + perm32(R & 31)) : R;
        Rr[i] = R; C2[i] = (unsigned)C * 2u; voffB[i] = (unsigned)(Rb * K + C) * 2u; voffA[i] = (unsigned)(R * K + C) * 2u; }
    const size_t kstep = (size_t)(BK * 2);
    const size_t hstepB = (size_t)HALF * K * 2;
    const size_t tstepA = (size_t)K * 2;
    const unsigned ldsw = (unsigned)wid * 1024u;
    const int aoff = lds_byte(wr * 64 + fr, fq * 8), boff = lds_byte(wc * 32 + fr, fq * 8);
#define G8_SA(b, h) (((b) * 2 + (h)) * HTB)
#define G8_SB(b, h) ((4 + (b) * 2 + (h)) * HTB)
#define G8_STAGE(bufoff, gbase, voff) do { _Pragma("unroll") for (int _i = 0; _i < 2; ++_i) \
        __builtin_amdgcn_global_load_lds((const unsigned*)((const char*)(gbase) + (voff)[_i]), (LAS unsigned*)(lds + (bufoff) + ldsw + _i * 8192), 16, 0, 0); } while (0)
#define G8_LDA(dst, b, h) do { _Pragma("unroll") for (int m = 0; m < 4; ++m) _Pragma("unroll") for (int k = 0; k < 2; ++k) dst[m][k] = *(const LAS bf16x8*)(lds + G8_SA(b, h) + aoff + m * 2048 + k * 1024); } while (0)
#define G8_LDB(dst, b, h) do { _Pragma("unroll") for (int n = 0; n < 2; ++n) _Pragma("unroll") for (int k = 0; k < 2; ++k) dst[n][k] = *(const LAS bf16x8*)(lds + G8_SB(b, h) + boff + n * 2048 + k * 1024); } while (0)
#define G8_MMA(ai, bj, At, Bt) do { __builtin_amdgcn_s_setprio(1); _Pragma("unroll") for (int m = 0; m < 4; ++m) _Pragma("unroll") for (int n = 0; n < 2; ++n) _Pragma("unroll") for (int k = 0; k < 2; ++k) \
        acc[ai][bj][m][n] = __builtin_amdgcn_mfma_f32_16x16x32_bf16(Bt[n][k], At[m][k], acc[ai][bj][m][n], 0, 0, 0); __builtin_amdgcn_s_setprio(0); } while (0)
#define G8_WAIT_V(n) asm volatile("s_waitcnt vmcnt(" #n ")" ::: "memory")
#define G8_WAIT_L(n) asm volatile("s_waitcnt lgkmcnt(" #n ")" ::: "memory")
#define G8_BAR __builtin_amdgcn_s_barrier()
#define G8_SCHED __builtin_amdgcn_sched_barrier(0)
    Unit cur, nxt; int ui = 0;
    if (!S.next(0, cur)) return;
    f32x4 acc[2][2][4][2];
#pragma unroll
    for (int a = 0; a < 2; ++a)
#pragma unroll
        for (int b = 0; b < 2; ++b)
#pragma unroll
            for (int m = 0; m < 4; ++m)
#pragma unroll
                for (int n = 0; n < 2; ++n) acc[a][b][m][n] = (f32x4){0.f, 0.f, 0.f, 0.f};
    bf16x8 At[4][2], B0[2][2], B1[2][2];
    unsigned vAc[2][2], vAn[2][2];
    const char* cA0 = Abase; const char* cA1 = Abase;
    if constexpr (GATHER) {
#pragma unroll
        for (int h = 0; h < 2; ++h)
#pragma unroll
            for (int i = 0; i < 2; ++i) vAc[h][i] = S.arow(cur, h * HALF + Rr[i]) * (unsigned)(K * 2) + C2[i];
    } else {
        cA0 = Abase + (size_t)cur.m0 * tstepA; cA1 = cA0 + (size_t)HALF * tstepA;
#pragma unroll
        for (int h = 0; h < 2; ++h)
#pragma unroll
            for (int i = 0; i < 2; ++i) vAc[h][i] = voffA[i];
    }
    const char* cB = cur.B;
    G8_STAGE(G8_SB(0, 0), cB, voffB); G8_STAGE(G8_SB(0, 1), cB + hstepB, voffB); G8_STAGE(G8_SA(0, 0), cA0, vAc[0]); G8_STAGE(G8_SA(0, 1), cA1, vAc[1]);
    if (wr == 1) G8_BAR;
    G8_WAIT_V(2); G8_BAR;
    G8_STAGE(G8_SB(1, 0), cB + kstep, voffB); G8_STAGE(G8_SA(1, 0), cA0 + kstep, vAc[0]); G8_STAGE(G8_SB(1, 1), cB + hstepB + kstep, voffB);
    G8_WAIT_V(6); G8_BAR;
    for (;;) {
        const bool has_next = S.next(ui + 1, nxt);
        const char* nB = has_next ? nxt.B : cB;
        const char* nA0 = cA0; const char* nA1 = cA1;
        if constexpr (GATHER) {
#pragma unroll
            for (int h = 0; h < 2; ++h)
#pragma unroll
                for (int i = 0; i < 2; ++i) vAn[h][i] = has_next ? (S.arow(nxt, h * HALF + Rr[i]) * (unsigned)(K * 2) + C2[i]) : vAc[h][i];
        } else {
            if (has_next) { nA0 = Abase + (size_t)nxt.m0 * tstepA; nA1 = nA0 + (size_t)HALF * tstepA; }
        }
        for (int t = 0; t < nt; t += 2) {
            const bool last = (t == nt - 2);
            const char* a1h1 = cA1 + (size_t)(t + 1) * kstep;
            const char* a2h0 = last ? nA0 : cA0 + (size_t)(t + 2) * kstep; const char* a2h1 = last ? nA1 : cA1 + (size_t)(t + 2) * kstep;
            const char* b2 = last ? nB : cB + (size_t)(t + 2) * kstep;
            const char* a3h0 = a2h0 + kstep; const char* b3 = b2 + kstep;
            unsigned va2[2][2];
#pragma unroll
            for (int h = 0; h < 2; ++h)
#pragma unroll
                for (int i = 0; i < 2; ++i) va2[h][i] = (GATHER && last) ? vAn[h][i] : vAc[h][i];
            G8_LDB(B0, 0, 0); G8_LDB(B1, 0, 1); G8_SCHED; G8_LDA(At, 0, 0); G8_STAGE(G8_SA(1, 1), a1h1, vAc[1]);
            G8_WAIT_V(8); G8_WAIT_L(0); G8_BAR; G8_MMA(0, 0, At, B0); G8_MMA(0, 1, At, B1); G8_BAR; G8_SCHED;
            G8_LDA(At, 0, 1); G8_STAGE(G8_SB(0, 0), b2, voffB); G8_STAGE(G8_SB(0, 1), b2 + hstepB, voffB); G8_STAGE(G8_SA(0, 0), a2h0, va2[0]);
            G8_WAIT_V(8); G8_WAIT_L(0); G8_BAR; G8_MMA(1, 0, At, B0); G8_MMA(1, 1, At, B1); G8_BAR; G8_SCHED;
            G8_LDB(B0, 1, 0); G8_LDB(B1, 1, 1); G8_SCHED; G8_LDA(At, 1, 0); G8_STAGE(G8_SA(0, 1), a2h1, va2[1]);
            G8_WAIT_V(8); G8_WAIT_L(0); G8_BAR; G8_MMA(0, 0, At, B0); G8_MMA(0, 1, At, B1); G8_BAR; G8_SCHED;
            G8_LDA(At, 1, 1); G8_STAGE(G8_SB(1, 0), b3, voffB); G8_STAGE(G8_SB(1, 1), b3 + hstepB, voffB); G8_STAGE(G8_SA(1, 0), a3h0, va2[0]);
            G8_WAIT_V(8); G8_WAIT_L(0); G8_BAR; G8_MMA(1, 0, At, B0); G8_MMA(1, 1, At, B1); G8_BAR; G8_SCHED;
        }
        if (wr == 0) G8_BAR;
        E(acc, cur, wr, wc, fr, fq);
        if (!has_next) break;
#pragma unroll
        for (int a = 0; a < 2; ++a)
#pragma unroll
            for (int b = 0; b < 2; ++b)
#pragma unroll
                for (int m = 0; m < 4; ++m)
#pragma unroll
                    for (int n = 0; n < 2; ++n) acc[a][b][m][n] = (f32x4){0.f, 0.f, 0.f, 0.f};
        cur = nxt; cB = nB; cA0 = nA0; cA1 = nA1; ++ui;
        if (wr == 1) G8_BAR;
        if constexpr (GATHER) {
#pragma unroll
            for (int h = 0; h < 2; ++h)
#pragma unroll
                for (int i = 0; i < 2; ++i) vAc[h][i] = vAn[h][i];
        }
    }
    G8_WAIT_V(0);
    G8_BAR;
#undef G8_SA
#undef G8_SB
#undef G8_STAGE
#undef G8_LDA
#undef G8_LDB
#undef G8_MMA
#undef G8_WAIT_V
#undef G8_WAIT_L
#undef G8_BAR
#undef G8_SCHED
}

struct MUnit { const char* B; int m0, n0, rows, e, kind, mt; };
struct MoeUni {
    const LAS int* tab; const int* list; const char* Wgu; const char* Wd; int G, c, MT;
    DI bool next(int i, MUnit& u) const {
        const int nA = 4 * MT, nB = 8 * MT, x = nA > G ? nA - G : 0;
        const int mineA = (c < nA ? 1 : 0) + (c + G < nA ? 1 : 0);
        int kind, L;
        if (i < mineA) { kind = 0; L = c + i * G; }
        else { const int k = i - mineA;
            if (x > 0) { if (c < x) return false; L = (c - x) + k * (G - x); } else L = c + k * G;
            if (L >= nB) return false; kind = 1; }
        const int NB = kind ? 8 : 4, mt = L / NB, nb = L - mt * NB, nfull = tab[16];
        int e, ti;
        if (mt < nfull) { e = 0;
#pragma unroll
            for (int j = 1; j < 16; ++j) e += (tab[j] <= mt) ? 1 : 0;
            ti = mt - tab[e]; }
        else { e = tab[34 + (mt - nfull)]; ti = tab[17 + e] >> 8; }
        const int cnt = tab[17 + e];
        u.e = e; u.m0 = e * NTOK + ti * BM; u.rows = (cnt - ti * BM) < BM ? (cnt - ti * BM) : BM; u.n0 = nb * BM; u.kind = kind; u.mt = mt;
        u.B = kind ? (Wd + (size_t)e * ((size_t)DM * DEXP * 2) + (size_t)nb * BM * DEXP * 2) : (Wgu + (size_t)e * ((size_t)1024 * DM * 2) + (size_t)nb * BM * DM * 2);
        return true;
    }
    DI unsigned arow(const MUnit& u, int r) const { const int rr = r < u.rows ? r : 0; const unsigned en = (unsigned)list[u.m0 + rr]; return u.kind ? en : (en & (NTOK - 1)); }
};
DI void st16_sc1(void* p, u32x4 v) { asm volatile("global_store_dwordx4 %0, %1, off sc1\n\ts_nop 1" :: "v"((GAS void*)p), "v"(v) : "memory"); }

DI void gemm_moe_phase(LAS unsigned char* lds, const int wave_id, const char* A0  , const char* A1  , const MoeUni& S,
                       bf16* H, const float* wsel, bf16* O2, unsigned* done  , unsigned* tmo) {
    int z_ = 0; asm volatile("" : "+v"(z_));
    const int lane = __builtin_amdgcn_mbcnt_hi(-1, __builtin_amdgcn_mbcnt_lo(-1, z_)), wid = wave_id, tid = wid * 64 + lane, wr = wid >> 2, wc = wid & 3, fr = lane & 15, fq = lane >> 4;
    LAS int* ent = (LAS int*)(lds + STAGE_BYTES); LAS float* wsl = (LAS float*)(lds + STAGE_BYTES + 3 * 1024);
#define MOE_FETCH(u, slot) do { if (tid < 256) { const int e_ = S.list[(u).m0 + (tid < (u).rows ? tid : 0)]; float w_ = 0.f; if ((u).kind == 0) w_ = wsel[e_]; \
            ent[(slot) * 256 + tid] = e_; wsl[(slot) * 256 + tid] = w_; } } while (0)
#define MOE_OFFS(u, slot, vA, vB) do { int tz_ = tid; asm volatile("" : "+v"(tz_)); const int Kk_ = (u).kind ? DEXP : DM; \
        _Pragma("unroll") for (int i = 0; i < 2; ++i) { int R_, C_; stage_rc(tz_ * 16 + i * 8192, R_, C_); const int Rb_ = (R_ & ~31) + perm32(R_ & 31); \
            vB[i] = (unsigned)(Rb_ * Kk_ + C_) * 2u; \
            _Pragma("unroll") for (int h = 0; h < 2; ++h) { const unsigned en_ = (unsigned)ent[(slot) * 256 + h * HALF + R_]; \
                vA[h][i] = ((u).kind ? en_ : (en_ & (NTOK - 1))) * (unsigned)(Kk_ * 2) + (unsigned)C_ * 2u; } } } while (0)
    const size_t kstep = (size_t)(BK * 2);
    const unsigned ldsw = (unsigned)wid * 1024u;
    const int aoff = lds_byte(wr * 64 + fr, fq * 8), boff = lds_byte(wc * 32 + fr, fq * 8);
#define G8_SA(b, h) (((b) * 2 + (h)) * HTB)
#define G8_SB(b, h) ((4 + (b) * 2 + (h)) * HTB)
#define G8_STAGE(bufoff, gbase, voff) do { _Pragma("unroll") for (int _i = 0; _i < 2; ++_i) \
        __builtin_amdgcn_global_load_lds((const unsigned*)((const char*)(gbase) + (voff)[_i]), (LAS unsigned*)(lds + (bufoff) + ldsw + _i * 8192), 16, 0, 0); } while (0)
#define G8_LDA(dst, b, h) do { _Pragma("unroll") for (int m = 0; m < 4; ++m) _Pragma("unroll") for (int k = 0; k < 2; ++k) dst[m][k] = *(const LAS bf16x8*)(lds + G8_SA(b, h) + aoff + m * 2048 + k * 1024); } while (0)
#define G8_LDB(dst, b, h) do { _Pragma("unroll") for (int n = 0; n < 2; ++n) _Pragma("unroll") for (int k = 0; k < 2; ++k) dst[n][k] = *(const LAS bf16x8*)(lds + G8_SB(b, h) + boff + n * 2048 + k * 1024); } while (0)
#define G8_MMA(ai, bj, At, Bt) do { __builtin_amdgcn_s_setprio(1); _Pragma("unroll") for (int m = 0; m < 4; ++m) _Pragma("unroll") for (int n = 0; n < 2; ++n) _Pragma("unroll") for (int k = 0; k < 2; ++k) \
        acc[ai][bj][m][n] = __builtin_amdgcn_mfma_f32_16x16x32_bf16(Bt[n][k], At[m][k], acc[ai][bj][m][n], 0, 0, 0); __builtin_amdgcn_s_setprio(0); } while (0)
#define G8_WAIT_V(n) asm volatile("s_waitcnt vmcnt(" #n ")" ::: "memory")
#define G8_WAIT_L(n) asm volatile("s_waitcnt lgkmcnt(" #n ")" ::: "memory")
#define G8_BAR __builtin_amdgcn_s_barrier()
#define G8_SCHED __builtin_amdgcn_sched_barrier(0)
#define MOE_A_READY(u) do { if ((u).kind) { \
        if (wid == 0 && !ackd) { unsigned sp_ = 0u; \
            while ((unsigned)__builtin_amdgcn_readfirstlane(__hip_atomic_load(done + 16 * (u).mt, __ATOMIC_RELAXED, __HIP_MEMORY_SCOPE_AGENT)) < 32u) { \
                __builtin_amdgcn_s_sleep(2); if (++sp_ > (1u << 20)) { if (lane == 0) __hip_atomic_store(tmo, 1u, __ATOMIC_RELAXED, __HIP_MEMORY_SCOPE_AGENT); break; } } \
            __builtin_amdgcn_fence(__ATOMIC_ACQUIRE, "agent"); asm volatile("s_waitcnt vmcnt(0)" ::: "memory"); } \
        asm volatile("" ::: "memory"); G8_BAR; asm volatile("" ::: "memory"); } } while (0)
    MUnit cur, nxt; int ui = 0; int ackd = 0;
    LAS unsigned* pollw = (LAS unsigned*)(lds + 143360);
    if (!S.next(0, cur)) return;
    f32x4 acc[2][2][4][2];
#pragma unroll
    for (int a = 0; a < 2; ++a)
#pragma unroll
        for (int b = 0; b < 2; ++b)
#pragma unroll
            for (int m = 0; m < 4; ++m)
#pragma unroll
                for (int n = 0; n < 2; ++n) acc[a][b][m][n] = (f32x4){0.f, 0.f, 0.f, 0.f};
    bf16x8 At[4][2], B0[2][2], B1[2][2];
    unsigned vAc[2][2], vAn[2][2], vBc[2], vBn[2];
    int slc = 0, sln = 0;
    MOE_FETCH(cur, 0);
    asm volatile("s_waitcnt lgkmcnt(0)" ::: "memory"); G8_BAR; asm volatile("" ::: "memory");
    MOE_A_READY(cur);
    MOE_OFFS(cur, 0, vAc, vBc);
    const char* cA = cur.kind ? A1 : A0; const char* cB = cur.B;
    size_t hsB = (size_t)HALF * (cur.kind ? DEXP : DM) * 2;
    G8_STAGE(G8_SB(0, 0), cB, vBc); G8_STAGE(G8_SB(0, 1), cB + hsB, vBc); G8_STAGE(G8_SA(0, 0), cA, vAc[0]); G8_STAGE(G8_SA(0, 1), cA, vAc[1]);
    if (wr == 1) G8_BAR;
    G8_WAIT_V(2); G8_BAR;
    G8_STAGE(G8_SB(1, 0), cB + kstep, vBc); G8_STAGE(G8_SA(1, 0), cA + kstep, vAc[0]); G8_STAGE(G8_SB(1, 1), cB + hsB + kstep, vBc);
    G8_WAIT_V(6); G8_BAR;
    for (;;) {
        const bool has_next = S.next(ui + 1, nxt);
        const char* nB = has_next ? nxt.B : cB; const char* nA = has_next ? (nxt.kind ? A1 : A0) : cA;
        const size_t hsBn = has_next ? (size_t)HALF * (nxt.kind ? DEXP : DM) * 2 : hsB;
        const bool fresh = has_next && !(nxt.kind == cur.kind && nxt.mt == cur.mt);
        sln = fresh ? (slc == 2 ? 0 : slc + 1) : slc;
        if (fresh && tid < 256)
            __builtin_amdgcn_global_load_lds((const unsigned*)(S.list + (nxt.m0 + (tid < nxt.rows ? tid : 0))), (LAS unsigned*)(ent + sln * 256 + wid * 64), 4, 0, 0);
#pragma unroll
        for (int i = 0; i < 2; ++i) { vBn[i] = vBc[i]; vAn[0][i] = vAc[0][i]; vAn[1][i] = vAc[1][i]; }
        const int nt = cur.kind ? (DEXP / BK) : (DM / BK);
        for (int t = 0; t < nt; t += 2) {
            const bool last = (t == nt - 2);
            if (t == 2 && fresh && nxt.kind == 0 && tid < 256)
                __builtin_amdgcn_global_load_lds((const unsigned*)(wsel + ent[sln * 256 + tid]), (LAS unsigned*)(wsl + sln * 256 + wid * 64), 4, 0, 0);
            if (fresh && nxt.kind && wid == 0) {
                if (t == nt - 6) __builtin_amdgcn_global_load_lds((const unsigned*)(done + 16 * nxt.mt), pollw, 4, 0, 16  );
                if (t == nt - 4) { if ((unsigned)__builtin_amdgcn_readfirstlane((int)pollw[0]) >= 32u) { asm volatile("buffer_inv sc1" ::: "memory"); ackd = 1; } }
            }
            if (last && fresh) { MOE_A_READY(nxt); MOE_OFFS(nxt, sln, vAn, vBn); ackd = 0; }
            const char* a1 = cA + (size_t)(t + 1) * kstep;
            const char* a2 = last ? nA : cA + (size_t)(t + 2) * kstep;
            const char* b2 = last ? nB : cB + (size_t)(t + 2) * kstep;
            const char* a3 = a2 + kstep; const char* b3 = b2 + kstep;
            const size_t hs2 = last ? hsBn : hsB;
            unsigned va2[2][2], vb2[2];
#pragma unroll
            for (int h = 0; h < 2; ++h)
#pragma unroll
                for (int i = 0; i < 2; ++i) va2[h][i] = last ? vAn[h][i] : vAc[h][i];
#pragma unroll
            for (int i = 0; i < 2; ++i) vb2[i] = last ? vBn[i] : vBc[i];
            G8_LDB(B0, 0, 0); G8_LDB(B1, 0, 1); G8_SCHED; G8_LDA(At, 0, 0); G8_STAGE(G8_SA(1, 1), a1, vAc[1]);
            G8_WAIT_V(8); G8_WAIT_L(0); G8_BAR; G8_MMA(0, 0, At, B0); G8_MMA(0, 1, At, B1); G8_BAR; G8_SCHED;
            G8_LDA(At, 0, 1); G8_STAGE(G8_SB(0, 0), b2, vb2); G8_STAGE(G8_SB(0, 1), b2 + hs2, vb2); G8_STAGE(G8_SA(0, 0), a2, va2[0]);
            G8_WAIT_V(8); G8_WAIT_L(0); G8_BAR; G8_MMA(1, 0, At, B0); G8_MMA(1, 1, At, B1); G8_BAR; G8_SCHED;
            G8_LDB(B0, 1, 0); G8_LDB(B1, 1, 1); G8_SCHED; G8_LDA(At, 1, 0); G8_STAGE(G8_SA(0, 1), a2, va2[1]);
            G8_WAIT_V(8); G8_WAIT_L(0); G8_BAR; G8_MMA(0, 0, At, B0); G8_MMA(0, 1, At, B1); G8_BAR; G8_SCHED;
            G8_LDA(At, 1, 1); G8_STAGE(G8_SB(1, 0), b3, vb2); G8_STAGE(G8_SB(1, 1), b3 + hs2, vb2); G8_STAGE(G8_SA(1, 0), a3, va2[0]);
            G8_WAIT_V(8); G8_WAIT_L(0); G8_BAR; G8_MMA(1, 0, At, B0); G8_MMA(1, 1, At, B1); G8_BAR; G8_SCHED;
        }
        if (wr == 0) G8_BAR;
        {
            int en[8];
#pragma unroll
            for (int ai = 0; ai < 2; ++ai)
#pragma unroll
                for (int m = 0; m < 4; ++m) { const int r = ai * HALF + wr * 64 + m * 16 + fr; en[ai * 4 + m] = (r < cur.rows) ? ent[slc * 256 + r] : -1; }
            if (cur.kind == 0) {
                float ws[8];
#pragma unroll
                for (int ai = 0; ai < 2; ++ai)
#pragma unroll
                    for (int m = 0; m < 4; ++m) ws[ai * 4 + m] = wsl[slc * 256 + ai * HALF + wr * 64 + m * 16 + fr];
                const int col0 = (cur.n0 >> 1) + wc * 32 + 8 * fq;
#pragma unroll
                for (int ai = 0; ai < 2; ++ai)
#pragma unroll
                    for (int m = 0; m < 4; ++m) { const int k = ai * 4 + m;
                        if (en[k] >= 0) { const float wv = ws[k];
                            const f32x4 g0 = acc[ai][0][m][0], g1 = acc[ai][0][m][1], u0 = acc[ai][1][m][0], u1 = acc[ai][1][m][1];
                            float hh[8];
#pragma unroll
                            for (int j = 0; j < 4; ++j) { hh[j] = siluf_(g0[j]) * u0[j] * wv; hh[4 + j] = siluf_(g1[j]) * u1[j] * wv; }
                            u32x4 w; w.x = cvt_pk_bf16(hh[0], hh[1]); w.y = cvt_pk_bf16(hh[2], hh[3]); w.z = cvt_pk_bf16(hh[4], hh[5]); w.w = cvt_pk_bf16(hh[6], hh[7]);
                            st16_sc1(H + (size_t)en[k] * DEXP + col0, w); } }
                asm volatile("s_waitcnt vmcnt(0)" ::: "memory");
                if (lane == 0) __hip_atomic_fetch_add(done + 16 * cur.mt, 1u, __ATOMIC_RELAXED, __HIP_MEMORY_SCOPE_AGENT);
            } else {
                const int col0 = cur.n0 + wc * 32 + 8 * fq;
#pragma unroll
                for (int ai = 0; ai < 2; ++ai)
#pragma unroll
                    for (int m = 0; m < 4; ++m) { const int k = ai * 4 + m;
                        if (en[k] >= 0) { bf16* rowp = O2 + (size_t)en[k] * DM + col0;
#pragma unroll
                            for (int bj = 0; bj < 2; ++bj) { const f32x4 v0 = acc[ai][bj][m][0], v1 = acc[ai][bj][m][1];
                                u32x4 w; w.x = cvt_pk_bf16(v0[0], v0[1]); w.y = cvt_pk_bf16(v0[2], v0[3]); w.z = cvt_pk_bf16(v1[0], v1[1]); w.w = cvt_pk_bf16(v1[2], v1[3]);
                                *(u32x4*)(rowp + bj * HALF) = w; } } }
            }
        }
        if (!has_next) break;
#pragma unroll
        for (int a = 0; a < 2; ++a)
#pragma unroll
            for (int b = 0; b < 2; ++b)
#pragma unroll
                for (int m = 0; m < 4; ++m)
#pragma unroll
                    for (int n = 0; n < 2; ++n) acc[a][b][m][n] = (f32x4){0.f, 0.f, 0.f, 0.f};
        cur = nxt; cB = nB; cA = nA; hsB = hsBn; slc = sln; ++ui;
        if (wr == 1) G8_BAR;
#pragma unroll
        for (int h = 0; h < 2; ++h)
#pragma unroll
            for (int i = 0; i < 2; ++i) vAc[h][i] = vAn[h][i];
#pragma unroll
        for (int i = 0; i < 2; ++i) vBc[i] = vBn[i];
    }
    G8_WAIT_V(0);
    G8_BAR;
#undef MOE_A_READY
#undef MOE_OFFS
#undef MOE_FETCH
#undef G8_SA
#undef G8_SB
#undef G8_STAGE
#undef G8_LDA
#undef G8_LDB
#undef G8_MMA
#undef G8_WAIT_V
#undef G8_WAIT_L
#undef G8_BAR
#undef G8_SCHED
}
}

constexpr int NWAVES = 8, NTHREADS = 512;
constexpr int RING_BYTES = 131072;
constexpr int LN_STRIDE = 2052;
constexpr int LN_TILE_BYTES = 16 * LN_STRIDE * 4;
constexpr int LN_PART_OFF = LN_TILE_BYTES, LN_LOGIT_OFF = LN_PART_OFF + 8192, LN_ROUTE_OFF = LN_LOGIT_OFF + 1024;
constexpr int LN_GB_OFF = 143360;
constexpr int LDS_BYTES = 163840;
constexpr int MOETAB_OFF = LDS_BYTES - 1024;
constexpr int MISC_OFF = LDS_BYTES - 512;
static_assert(LN_ROUTE_OFF + 2048 <= MOETAB_OFF && MISC_OFF + 16 <= LDS_BYTES, "LDS map");

struct Frame {
    LAS unsigned char* lds;
    int tid, lane, wave, G, bid;
    GAS unsigned char* ws;
    const float* const* in;
    GAS float* out;
};
#define FIN(k) ((const float*)(const GAS float*)F.in[k])
enum { I_X = 0, I_POS, I_WIN, I_SINK, I_CONVW, I_ALOG, I_DTB, I_DNW, I_WOUT, I_LN1G, I_LN1B, I_RW, I_RB, I_WG, I_WU, I_WDN, I_LN2G, I_LN2B };

DI void transpose_item(const float* W, int ldw, bf16* WT, int ldt, int k0, int n0, int drow0, LAS float* scr, int lane) {
    float tv[32];
    const GAS float* wp = (const GAS float*)W + (size_t)(k0 + (lane >> 5)) * ldw + n0 + (lane & 31);
#pragma unroll
    for (int i = 0; i < 32; ++i) tv[i] = __builtin_nontemporal_load(wp + (size_t)(2 * i) * ldw);
    __builtin_amdgcn_sched_barrier(0);
#pragma unroll
    for (int i = 0; i < 32; ++i) { const int kk = 2 * i + (lane >> 5); scr[kk * 33 + (lane & 31)] = tv[i]; }
    LDS_WAIT(); asm volatile("" ::: "memory");
    const int c = lane & 7;
#pragma unroll
    for (int j = 0; j < 4; ++j) { const int n = (lane >> 3) + 8 * j; const LAS float* s = scr + (8 * c) * 33 + n;
        u32x4 o; o.x = pk2(s[0 * 33], s[1 * 33]); o.y = pk2(s[2 * 33], s[3 * 33]); o.z = pk2(s[4 * 33], s[5 * 33]); o.w = pk2(s[6 * 33], s[7 * 33]);
        __builtin_nontemporal_store(o, (GAS u32x4*)(WT + (size_t)(drow0 + n) * ldt + k0 + 8 * c)); }
    LDS_WAIT(); asm volatile("" ::: "memory");
}
constexpr int IP_ATT_UNITS = (NTOK / 256) * (C_DQ / 256);
constexpr int CONV_HELPERS = 224, CONV_SPLIT = 32000;
constexpr int CONV_ITEMS = 32 * 168 + 32 * 64 + NEXP * (2 * 32 * 16 + 8 * 64), CONV_I_IN = 32 * 168;
DI void convw_phase(Frame& F, int l, int slot, int wg_lo, int wg_n, int it_lo, int it_hi) {
    LAS float* scr = (LAS float*)(F.lds + F.wave * 16384);
    const int gw = (F.bid - wg_lo) * NWAVES + F.wave, NGW = wg_n * NWAVES;
    bf16* win_t = (bf16*)(F.ws + WS_WIN) + (size_t)slot * PN * DM;
    bf16* wout_t = (bf16*)(F.ws + WS_WOUT) + (size_t)slot * DM * DM;
    bf16* wgu_t = (bf16*)(F.ws + WS_WGU) + (size_t)slot * NEXP * 1024 * DM;
    bf16* wd_t = (bf16*)(F.ws + WS_WD) + (size_t)slot * NEXP * DM * DEXP;
    const float* w_in = FIN(I_WIN) + (size_t)l * DM * PROJ;
    const float* w_out = FIN(I_WOUT) + (size_t)l * DM * DM;
    const float* w_g = FIN(I_WG) + (size_t)l * NEXP * DM * DEXP;
    const float* w_u = FIN(I_WU) + (size_t)l * NEXP * DM * DEXP;
    const float* w_d = FIN(I_WDN) + (size_t)l * NEXP * DEXP * DM;
    constexpr int I_IN = 32 * 168, I_OUT = 32 * 64, I_GU = 32 * 16, I_D = 8 * 64, I_E = 2 * I_GU + I_D;
    static_assert(CONV_ITEMS == I_IN + I_OUT + NEXP * I_E, "item count");
    for (int it = it_lo + gw; it < it_hi; it += NGW) {
        int r = it;
        if (r < I_IN) { const int kb = r / 168, nb = r % 168; transpose_item(w_in, PROJ, win_t, DM, kb * 64, nb * 32, nb * 32, scr, F.lane); continue; } r -= I_IN;
        if (r < I_OUT) { const int kb = r / 64, nb = r % 64; transpose_item(w_out, DM, wout_t, DM, kb * 64, nb * 32, nb * 32, scr, F.lane); continue; } r -= I_OUT;
        const int e = r / I_E; r -= e * I_E;
        if (r < 2 * I_GU) { const int up = r / I_GU; r -= up * I_GU; const int kb = r / 16, nb = r % 16, n0 = nb * 32;
            const int drow0 = (n0 >> 7) * 256 + up * 128 + (n0 & 127);
            transpose_item((up ? w_u : w_g) + (size_t)e * DM * DEXP, DEXP, wgu_t + (size_t)e * 1024 * DM, DM, kb * 64, n0, drow0, scr, F.lane); continue; }
        r -= 2 * I_GU;
        { const int kb = r / 64, nb = r % 64; transpose_item(w_d + (size_t)e * DEXP * DM, DM, wd_t + (size_t)e * DM * DEXP, DEXP, kb * 64, nb * 32, nb * 32, scr, F.lane); }
    }
}

DI void rope_phase(Frame& F) {
    float* cs = (float*)(F.ws + WS_COS); float* sn = (float*)(F.ws + WS_SIN);
    const int* pos = (const int*)FIN(I_POS);
    for (int i = F.bid * NTHREADS + F.tid; i < NTOK * 32; i += F.G * NTHREADS) {
        const int t = i >> 5, d = i & 31;
        const float inv = exp2f(-(float)d * (13.287712379549449f / 32.0f));
        const float ang = (float)pos[t] * inv;
        cs[i] = cosf(ang); sn[i] = sinf(ang);
    }
}

template <int MODE, bool SRCBF>
DI void ln_phase(Frame& F, const void* src, const bf16* o2, const float* gam, const float* bet, float* of32, bf16* obf, const float* W16, int ldw, bool do_logits,
                 float* ab, const float* rbias, unsigned* cnt, int* list, float* wsel) {
    LAS float* tile = (LAS float*)F.lds;
    LAS float* part = (LAS float*)(F.lds + LN_PART_OFF);
    LAS float* logit = (LAS float*)(F.lds + LN_LOGIT_OFF);
    LAS int* rt_e = (LAS int*)(F.lds + LN_ROUTE_OFF); LAS int* rt_tok = rt_e + 64; LAS float* rt_w = (LAS float*)(rt_e + 128); LAS unsigned* rt_h = (LAS unsigned*)(rt_e + 256); LAS unsigned* rt_b = rt_h + 16;
    int nrouted = 0;
    if (MODE == 1 && F.tid < 16) rt_h[F.tid] = 0u;
    const int lane = F.lane, w = F.wave;
    LAS f32x4* gbl = (LAS f32x4*)(F.lds + LN_GB_OFF);
    if (MODE != 0) { gbl[F.tid] = *((const GAS f32x4*)gam + F.tid); gbl[512 + F.tid] = *((const GAS f32x4*)bet + F.tid); }
    float wreg[64];
    if (do_logits) { const GAS float* wp = (const GAS float*)W16 + (size_t)(256 * w + 4 * (lane >> 4)) * ldw + (lane & 15);
#pragma unroll
        for (int s = 0; s < 16; ++s)
#pragma unroll
            for (int j = 0; j < 4; ++j) wreg[4 * s + j] = wp[(size_t)(16 * s + j) * ldw]; }
    else {
#pragma unroll
        for (int i = 0; i < 64; ++i) wreg[i] = 0.f; }
    f32x4 vn[8]; u32x2 rawn[8], avn[8], bvn[8];
#define LN_ISSUE(rowx) do { if (!SRCBF) { const GAS f32x4* sp_ = (const GAS f32x4*)((const float*)src + (size_t)(rowx) * DM) + lane; \
            _Pragma("unroll") for (int j = 0; j < 8; ++j) vn[j] = sp_[64 * j]; } \
        else { const GAS u32x2* sp_ = (const GAS u32x2*)((const bf16*)src + (size_t)(rowx) * DM) + lane; \
            _Pragma("unroll") for (int j = 0; j < 8; ++j) rawn[j] = sp_[64 * j]; } \
        if (MODE == 2) { const GAS u32x2* pa_ = (const GAS u32x2*)(o2 + (size_t)(rowx) * DM) + lane; const GAS u32x2* pb_ = (const GAS u32x2*)(o2 + (size_t)(NTOK + (rowx)) * DM) + lane; \
            _Pragma("unroll") for (int j = 0; j < 8; ++j) { avn[j] = pa_[64 * j]; bvn[j] = pb_[64 * j]; } } } while (0)
    if (F.bid < NTOK / 16) LN_ISSUE(F.bid * 16 + 2 * w);
    if (MODE != 0) __syncthreads();
    for (int unit = F.bid; unit < NTOK / 16; unit += F.G) {
        const int row0 = unit * 16;
#pragma unroll 1
        for (int rr = 0; rr < 2; ++rr) {
            const int rl = 2 * w + rr, row = row0 + rl;
            f32x4 v[8]; u32x2 av[8], bv[8];
#pragma unroll
            for (int j = 0; j < 8; ++j) {
                if (SRCBF) { u32x2 r = rawn[j]; asm volatile("" : "+v"(r)); v[j] = (f32x4){bflo(r.x), bfhi(r.x), bflo(r.y), bfhi(r.y)}; }
                else { v[j] = vn[j]; asm volatile("" : "+v"(v[j])); }
                if (MODE == 2) { av[j] = avn[j]; bv[j] = bvn[j]; asm volatile("" : "+v"(av[j]), "+v"(bv[j])); } }
            { const int nrow = (rr == 0) ? row + 1 : ((unit + F.G < NTOK / 16) ? (unit + F.G) * 16 + 2 * w : row);
              LN_ISSUE(nrow); }
            __builtin_amdgcn_sched_barrier(0);
            if (MODE == 2) {
#pragma unroll
                for (int j = 0; j < 8; ++j) { const u32x2 a = av[j], b = bv[j];
                    v[j].x = v[j].x * ALPHA + (bflo(a.x) + bflo(b.x)); v[j].y = v[j].y * ALPHA + (bfhi(a.x) + bfhi(b.x));
                    v[j].z = v[j].z * ALPHA + (bflo(a.y) + bflo(b.y)); v[j].w = v[j].w * ALPHA + (bfhi(a.y) + bfhi(b.y)); }
            }
            if (MODE != 0) {
                float s = 0.f;
#pragma unroll
                for (int j = 0; j < 8; ++j) s += (v[j].x + v[j].y) + (v[j].z + v[j].w);
                const float mean = wave_sum(s) * (1.0f / DM); float s2 = 0.f;
#pragma unroll
                for (int j = 0; j < 8; ++j) { v[j] = v[j] - mean; s2 += (v[j].x * v[j].x + v[j].y * v[j].y) + (v[j].z * v[j].z + v[j].w * v[j].w); }
                const float rstd = 1.0f / sqrtf(wave_sum(s2) * (1.0f / DM) + LN_EPS);
#pragma unroll
                for (int jh = 0; jh < 2; ++jh) { f32x4 g4[4], b4[4];
#pragma unroll
                    for (int j = 0; j < 4; ++j) { g4[j] = gbl[lane + 64 * (4 * jh + j)]; b4[j] = gbl[512 + lane + 64 * (4 * jh + j)]; }
                    __builtin_amdgcn_sched_barrier(0);
#pragma unroll
                    for (int j = 0; j < 4; ++j) v[4 * jh + j] = v[4 * jh + j] * rstd * g4[j] + b4[j]; }
            }
            else __builtin_amdgcn_sched_barrier(0);
            if (of32) { GAS f32x4* op = (GAS f32x4*)(of32 + (size_t)row * DM) + lane;
#pragma unroll
                for (int j = 0; j < 8; ++j) op[64 * j] = v[j]; }
            if (obf) { GAS u32x2* op = (GAS u32x2*)(obf + (size_t)row * DM) + lane;
#pragma unroll
                for (int j = 0; j < 8; ++j) { u32x2 o; o.x = pk2(v[j].x, v[j].y); o.y = pk2(v[j].z, v[j].w); op[64 * j] = o; } }
            if (do_logits) {
#pragma unroll
                for (int j = 0; j < 8; ++j) *(LAS f32x4*)(tile + rl * LN_STRIDE + 4 * lane + 256 * j) = v[j];
            }
        }
        if (do_logits) {
            __syncthreads();
            const int m = lane & 15, kq = lane >> 4;
            f32x4 acc = (f32x4){0.f, 0.f, 0.f, 0.f};
            const int kb = 256 * w;
#pragma unroll
            for (int s = 0; s < 16; ++s) {
                const int k = kb + 16 * s + 4 * kq;
                const f32x4 a4 = *(const LAS f32x4*)(tile + m * LN_STRIDE + k);
                acc = __builtin_amdgcn_mfma_f32_16x16x4f32(a4.x, wreg[4 * s + 0], acc, 0, 0, 0);
                acc = __builtin_amdgcn_mfma_f32_16x16x4f32(a4.y, wreg[4 * s + 1], acc, 0, 0, 0);
                acc = __builtin_amdgcn_mfma_f32_16x16x4f32(a4.z, wreg[4 * s + 2], acc, 0, 0, 0);
                acc = __builtin_amdgcn_mfma_f32_16x16x4f32(a4.w, wreg[4 * s + 3], acc, 0, 0, 0);
            }
#pragma unroll
            for (int r = 0; r < 4; ++r) part[(w * 16 + 4 * kq + r) * 16 + m] = acc[r];
            __syncthreads();
            if (F.tid < 256) {
                const int r = F.tid >> 4, n = F.tid & 15; float s = 0.f;
#pragma unroll
                for (int ww = 0; ww < 8; ++ww) s += part[(ww * 16 + r) * 16 + n];
                if (MODE == 1) logit[r * 16 + n] = s; else ab[(size_t)(row0 + r) * 16 + n] = s;
            }
            if (MODE == 1) {
                __syncthreads();
                if (F.tid < 16) {
                    const int tok = row0 + F.tid;
                    float sc[16], sel[16];
#pragma unroll
                    for (int e = 0; e < 16; ++e) { sc[e] = sigmoidf_(logit[F.tid * 16 + e]); sel[e] = sc[e] + rbias[e]; }
                    int bg = 0; float bgv = -1e30f; int be0[4], be1[4];
#pragma unroll
                    for (int g = 0; g < 4; ++g) {
                        int i0 = 0; float v0 = sel[4 * g];
#pragma unroll
                        for (int j = 1; j < 4; ++j) if (sel[4 * g + j] > v0) { v0 = sel[4 * g + j]; i0 = j; }
                        int i1 = -1; float v1 = -1e30f;
#pragma unroll
                        for (int j = 0; j < 4; ++j) if (j != i0 && sel[4 * g + j] > v1) { v1 = sel[4 * g + j]; i1 = j; }
                        be0[g] = 4 * g + i0; be1[g] = 4 * g + i1;
                        const float sum = v0 + v1; if (sum > bgv) { bgv = sum; bg = g; }
                    }
                    int e0 = be0[0], e1 = be1[0];
#pragma unroll
                    for (int g = 1; g < 4; ++g) if (bg == g) { e0 = be0[g]; e1 = be1[g]; }
                    float w0 = 0.f, w1 = 0.f;
#pragma unroll
                    for (int e = 0; e < 16; ++e) { if (e == e0) w0 = sc[e]; if (e == e1) w1 = sc[e]; }
                    const float inv = 1.0f / (w0 + w1);
                    const int slot = nrouted * 16 + F.tid;
                    rt_e[slot] = e0 | (e1 << 8); rt_w[2 * slot] = w0 * inv; rt_w[2 * slot + 1] = w1 * inv; rt_tok[slot] = tok;
                }
                ++nrouted;
            }
            __syncthreads();
        }
    }
    if (MODE == 1) {
        __syncthreads();
        const int nr = nrouted * 16; unsigned p0 = 0u, p1 = 0u; int e0 = 0, e1 = 0;
        if (F.tid < nr) { const int ee = rt_e[F.tid]; e0 = ee & 255; e1 = ee >> 8; p0 = __hip_atomic_fetch_add(rt_h + e0, 1u, __ATOMIC_RELAXED, __HIP_MEMORY_SCOPE_WORKGROUP); p1 = __hip_atomic_fetch_add(rt_h + e1, 1u, __ATOMIC_RELAXED, __HIP_MEMORY_SCOPE_WORKGROUP); }
        __syncthreads();
        if (F.tid < 16) { const unsigned hc = rt_h[F.tid]; rt_b[F.tid] = hc ? atomicAdd(cnt + 64 * F.tid, hc) : 0u; }
        __syncthreads();
        if (F.tid < nr) { const int tok = rt_tok[F.tid];
            list[e0 * NTOK + rt_b[e0] + p0] = tok; wsel[tok] = rt_w[2 * F.tid];
            list[e1 * NTOK + rt_b[e1] + p1] = NTOK + tok; wsel[NTOK + tok] = rt_w[2 * F.tid + 1]; }
        __syncthreads();
    }
}

constexpr int KT_PITCH = 72, VT_PITCH = 264;
constexpr int ATT_KT_OFF = 0, ATT_VT_OFF = 256 * KT_PITCH * 2;
DI void attn_unit(Frame& F, int unit, int l) {
    const int b = unit >> 6, kvh = (unit >> 5) & 1, qb = unit & 31;
    const bf16* proj = (const bf16*)(F.ws + WS_PROJ);
    const float* cs = (const float*)(F.ws + WS_COS); const float* sn = (const float*)(F.ws + WS_SIN);
    bf16* cat = (bf16*)(F.ws + WS_CAT);
    LAS unsigned char* kt = F.lds + ATT_KT_OFF; LAS unsigned char* vt = F.lds + ATT_VT_OFF;
    const int tq0 = b * SEQ + qb * 128, tk0 = tq0 - 128;
    {
        u32x4 klo[2], khi[2], vx[4]; f32x4 kc0[2], kc1[2], ks0[2], ks1[2];
#pragma unroll
        for (int it = 0; it < 2; ++it) {
            const int idx = F.tid + it * NTHREADS, kj = idx >> 2, c = idx & 3;
            int tk = tk0 + kj; if (tk < b * SEQ) tk = b * SEQ;
            const bf16* kp = proj + (size_t)tk * PN + C_SK + kvh * 64;
            klo[it] = *(const GAS u32x4*)(kp + 8 * c); khi[it] = *(const GAS u32x4*)(kp + 32 + 8 * c);
            kc0[it] = *(const GAS f32x4*)(cs + tk * 32 + 8 * c); kc1[it] = *(const GAS f32x4*)(cs + tk * 32 + 8 * c + 4);
            ks0[it] = *(const GAS f32x4*)(sn + tk * 32 + 8 * c); ks1[it] = *(const GAS f32x4*)(sn + tk * 32 + 8 * c + 4);
        }
        const int vkj = F.tid & 255, vdh = F.tid >> 8;
        { int tk = tk0 + vkj; if (tk < b * SEQ) tk = b * SEQ;
          const bf16* vp = proj + (size_t)tk * PN + C_SV + kvh * 64 + vdh * 32;
#pragma unroll
          for (int q = 0; q < 4; ++q) vx[q] = *(const GAS u32x4*)(vp + 8 * q); }
        __builtin_amdgcn_sched_barrier(0);
#pragma unroll
        for (int it = 0; it < 2; ++it) {
            const int idx = F.tid + it * NTHREADS, kj = idx >> 2, c = idx & 3;
            const u32x4 lo = klo[it], hi = khi[it]; const f32x4 c0 = kc0[it], c1 = kc1[it], s0 = ks0[it], s1 = ks1[it];
            float x1[8], x2[8], cc[8], ss[8];
#pragma unroll
            for (int j = 0; j < 4; ++j) { x1[2 * j] = bflo(lo[j]); x1[2 * j + 1] = bfhi(lo[j]); x2[2 * j] = bflo(hi[j]); x2[2 * j + 1] = bfhi(hi[j]); cc[j] = c0[j]; cc[4 + j] = c1[j]; ss[j] = s0[j]; ss[4 + j] = s1[j]; }
            u32x4 o1, o2;
#pragma unroll
            for (int j = 0; j < 4; ++j) {
                o1[j] = pk2(x1[2 * j] * cc[2 * j] - x2[2 * j] * ss[2 * j], x1[2 * j + 1] * cc[2 * j + 1] - x2[2 * j + 1] * ss[2 * j + 1]);
                o2[j] = pk2(x2[2 * j] * cc[2 * j] + x1[2 * j] * ss[2 * j], x2[2 * j + 1] * cc[2 * j + 1] + x1[2 * j + 1] * ss[2 * j + 1]);
            }
            *(LAS u32x4*)(kt + kj * (KT_PITCH * 2) + 16 * c) = o1;
            *(LAS u32x4*)(kt + kj * (KT_PITCH * 2) + 64 + 16 * c) = o2;
        }
#pragma unroll
        for (int q = 0; q < 4; ++q) { const u32x4 x = vx[q];
#pragma unroll
            for (int j = 0; j < 4; ++j) { const int d = vdh * 32 + 8 * q + 2 * j;
                *(LAS unsigned short*)(vt + (d * VT_PITCH + vkj) * 2) = (unsigned short)(x[j] & 0xffffu);
                *(LAS unsigned short*)(vt + ((d + 1) * VT_PITCH + vkj) * 2) = (unsigned short)(x[j] >> 16); } }
    }
    __syncthreads();
    const int lane = F.lane, n = lane & 15, q4 = lane >> 4, head = kvh * 8 + F.wave;
    const float sink = FIN(I_SINK)[l * 16 + head];
    u32x4 qlo, qhi; f32x4 qc0, qc1, qs0, qs1;
    { const int tq = tq0 + n; const bf16* qp = proj + (size_t)tq * PN + C_SQ + head * 64;
      qlo = *(const GAS u32x4*)(qp + 8 * q4); qhi = *(const GAS u32x4*)(qp + 32 + 8 * q4);
      qc0 = *(const GAS f32x4*)(cs + tq * 32 + 8 * q4); qc1 = *(const GAS f32x4*)(cs + tq * 32 + 8 * q4 + 4);
      qs0 = *(const GAS f32x4*)(sn + tq * 32 + 8 * q4); qs1 = *(const GAS f32x4*)(sn + tq * 32 + 8 * q4 + 4); }
#pragma unroll 1
    for (int qt = 0; qt < 8; ++qt) {
        const int qi = 16 * qt + n, tq = tq0 + qi;
        bf16x8 qf[2];
        {
            const u32x4 lo = qlo, hi = qhi; const f32x4 c0 = qc0, c1 = qc1, s0 = qs0, s1 = qs1;
            float x1[8], x2[8], cc[8], ss[8];
#pragma unroll
            for (int j = 0; j < 4; ++j) { x1[2 * j] = bflo(lo[j]); x1[2 * j + 1] = bfhi(lo[j]); x2[2 * j] = bflo(hi[j]); x2[2 * j + 1] = bfhi(hi[j]); cc[j] = c0[j]; cc[4 + j] = c1[j]; ss[j] = s0[j]; ss[4 + j] = s1[j]; }
            u32x4 o1, o2;
#pragma unroll
            for (int j = 0; j < 4; ++j) {
                o1[j] = pk2(0.125f * (x1[2 * j] * cc[2 * j] - x2[2 * j] * ss[2 * j]), 0.125f * (x1[2 * j + 1] * cc[2 * j + 1] - x2[2 * j + 1] * ss[2 * j + 1]));
                o2[j] = pk2(0.125f * (x2[2 * j] * cc[2 * j] + x1[2 * j] * ss[2 * j]), 0.125f * (x2[2 * j + 1] * cc[2 * j + 1] + x1[2 * j + 1] * ss[2 * j + 1]));
            }
            qf[0] = __builtin_bit_cast(bf16x8, o1); qf[1] = __builtin_bit_cast(bf16x8, o2);
        }
        {   const int tqn = tq0 + 16 * ((qt + 1) & 7) + n; const bf16* qp = proj + (size_t)tqn * PN + C_SQ + head * 64;
            qlo = *(const GAS u32x4*)(qp + 8 * q4); qhi = *(const GAS u32x4*)(qp + 32 + 8 * q4);
            qc0 = *(const GAS f32x4*)(cs + tqn * 32 + 8 * q4); qc1 = *(const GAS f32x4*)(cs + tqn * 32 + 8 * q4 + 4);
            qs0 = *(const GAS f32x4*)(sn + tqn * 32 + 8 * q4); qs1 = *(const GAS f32x4*)(sn + tqn * 32 + 8 * q4 + 4); }
        __builtin_amdgcn_sched_barrier(0);
        const int t0 = 2 * (qt >> 1);
        f32x4 s[10];
#pragma unroll
        for (int tt = 0; tt < 10; ++tt) {
            f32x4 a = (f32x4){0.f, 0.f, 0.f, 0.f};
#pragma unroll
            for (int kk = 0; kk < 2; ++kk) {
                const bf16x8 kf = *(const LAS bf16x8*)(kt + (16 * (t0 + tt) + n) * (KT_PITCH * 2) + 64 * kk + 16 * q4);
                a = __builtin_amdgcn_mfma_f32_16x16x32_bf16(kf, qf[kk], a, 0, 0, 0);
            }
            s[tt] = a;
        }
        float mx = sink;
#pragma unroll
        for (int tt = 0; tt < 10; ++tt)
#pragma unroll
            for (int r = 0; r < 4; ++r) { const int kj = 16 * (t0 + tt) + 4 * q4 + r;
                const bool valid = (kj >= qi + 1) && (kj <= qi + 128) && (qb > 0 || kj >= 128);
                s[tt][r] = valid ? s[tt][r] : -INFINITY; mx = fmaxf(mx, s[tt][r]); }
        mx = fmaxf(mx, swz_xor(mx, SWZ_X16)); mx = xor32_max(mx);
        float sum = 0.f;
#pragma unroll
        for (int tt = 0; tt < 10; ++tt)
#pragma unroll
            for (int r = 0; r < 4; ++r) { const float p = __expf(s[tt][r] - mx); s[tt][r] = p; sum += p; }
        sum += swz_xor(sum, SWZ_X16); sum = xor32_sum(sum);
        const float inv = 1.0f / (sum + __expf(sink - mx));
        f32x4 o[4];
#pragma unroll
        for (int dt = 0; dt < 4; ++dt) o[dt] = (f32x4){0.f, 0.f, 0.f, 0.f};
#pragma unroll
        for (int kk = 0; kk < 5; ++kk) {
            u32x4 pw; pw.x = pk2(s[2 * kk][0], s[2 * kk][1]); pw.y = pk2(s[2 * kk][2], s[2 * kk][3]); pw.z = pk2(s[2 * kk + 1][0], s[2 * kk + 1][1]); pw.w = pk2(s[2 * kk + 1][2], s[2 * kk + 1][3]);
            const bf16x8 pf = __builtin_bit_cast(bf16x8, pw);
            const int key0 = 16 * t0 + 32 * kk + 4 * q4;
#pragma unroll
            for (int dt = 0; dt < 4; ++dt) {
                const LAS unsigned char* vp = vt + ((16 * dt + n) * VT_PITCH + key0) * 2;
                const u32x2 va = *(const LAS u32x2*)vp, vb = *(const LAS u32x2*)(vp + 32);
                u32x4 vw; vw.x = va.x; vw.y = va.y; vw.z = vb.x; vw.w = vb.y;
                o[dt] = __builtin_amdgcn_mfma_f32_16x16x32_bf16(__builtin_bit_cast(bf16x8, vw), pf, o[dt], 0, 0, 0);
            }
        }
#pragma unroll
        for (int dt = 0; dt < 4; ++dt) { u32x2 w; w.x = pk2(o[dt][0] * inv, o[dt][1] * inv); w.y = pk2(o[dt][2] * inv, o[dt][3] * inv);
            *(GAS u32x2*)(cat + (size_t)tq * DM + head * 64 + 16 * dt + 4 * q4) = w; }
    }
    __syncthreads();
}

constexpr int OB_CHUNK = 8 * 8 * 4 * 512;
constexpr int OPS_BYTES = 57344, U_BYTES = 16384;
constexpr size_t WS_SCAN_U = WS_SCAN + (size_t)1024 * OPS_BYTES, WS_GLAST = 6 * MiB;
constexpr int DP_PITCH = 272, DP_Q = 0, DP_K = 17408, DP_V = 34816, DP_L = 52224, DP_GC = 69632, DP_BT = 69888, DP_EG = 70144, DP_EK = 70400, DP_RK = 70656, DP_RQ = 70912, DP_EKB = 71168, DP_GROUP = 71424;
DI void dn_prep_item(Frame& F, int item, int l) {
    int lane = F.lane; asm volatile("" : "+v"(lane));
    const int gi = F.wave >> 2, wg = F.wave & 3; int tg = wg * 64 + lane;
    const int h = item & 7, ck = (item >> 3) & 63, b = item >> 9;
    const int sitem = (b * 8 + h) * 64 + ck;
    const int tb = b * SEQ + ck * 64;
    LAS unsigned char* base = F.lds + gi * DP_GROUP;
    const bf16* proj = (const bf16*)(F.ws + WS_PROJ);
    GAS unsigned char* ops = F.ws + WS_SCAN + (size_t)sitem * OPS_BYTES;
    float* uo = (float*)(F.ws + WS_SCAN_U + (size_t)sitem * U_BYTES);
    LAS float* gc = (LAS float*)(base + DP_GC); LAS float* bt = (LAS float*)(base + DP_BT); LAS float* eg = (LAS float*)(base + DP_EG); LAS float* ek = (LAS float*)(base + DP_EK);
    LAS float* rkn = (LAS float*)(base + DP_RK); LAS float* rqn = (LAS float*)(base + DP_RQ); LAS float* ekb = (LAS float*)(base + DP_EKB);
    LAS float* Lm = (LAS float*)(base + DP_L);
    {
        const float* cw = FIN(I_CONVW) + (size_t)l * 4 * 3072;
        float w[3][4][2];
#pragma unroll
        for (int s = 0; s < 3; ++s)
#pragma unroll
            for (int j = 0; j < 4; ++j) { const f32x2 t = *(const GAS f32x2*)(cw + j * 3072 + s * 1024 + h * 128 + 2 * lane); w[s][j][0] = t.x; w[s][j][1] = t.y; }
        const int colq = C_DQ + h * 128 + 2 * lane;
        const int t0 = ck * 64 + 16 * wg - 3;
        unsigned xs[3][19];
#pragma unroll
        for (int s = 0; s < 3; ++s)
#pragma unroll
            for (int i = 0; i < 19; ++i) { const int t = t0 + i; xs[s][i] = (t >= 0) ? *(const GAS unsigned*)(proj + (size_t)(b * SEQ + t) * PN + colq + s * 1024) : 0u; }
        __builtin_amdgcn_sched_barrier(0);
#pragma unroll
        for (int s = 0; s < 3; ++s) {
#pragma unroll
            for (int i = 0; i < 16; ++i) {
                const float a0 = w[s][0][0] * bflo(xs[s][i]) + w[s][1][0] * bflo(xs[s][i + 1]) + w[s][2][0] * bflo(xs[s][i + 2]) + w[s][3][0] * bflo(xs[s][i + 3]);
                const float a1 = w[s][0][1] * bfhi(xs[s][i]) + w[s][1][1] * bfhi(xs[s][i + 1]) + w[s][2][1] * bfhi(xs[s][i + 2]) + w[s][3][1] * bfhi(xs[s][i + 3]);
                *(LAS unsigned*)(base + DP_Q + s * 17408 + (16 * wg + i) * DP_PITCH + 4 * lane) = pk2(siluf_(a0), siluf_(a1));
            }
        }
    }
    if (tg < 64) {
        const float* ab = (const float*)(F.ws + WS_AB) + (size_t)(tb + tg) * 16;
        const float a = ab[h], bb = ab[8 + h];
        const float x = a + FIN(I_DTB)[l * 8 + h];
        const float ex = __expf(x);
        const float sp = (x > 20.f) ? x : ((ex < 0.03f) ? ex * (1.0f - ex * (0.5f - ex * (0.33333333f - 0.25f * ex))) : __logf(1.0f + ex));
        eg[tg] = -__expf(FIN(I_ALOG)[l * 8 + h]) * sp; bt[tg] = sigmoidf_(bb);
    }
    __syncthreads();
    if (tg < 64) { float s = 0.f;
        for (int i = 0; i < 64; ++i) { const float gv = eg[i]; s += (i <= tg) ? gv : 0.f; }
        gc[tg] = s; }
    {
        asm volatile("" : "+v"(lane));
        const int n = lane & 15, q4 = lane >> 4;
        f32x4 kd = (f32x4){0.f, 0.f, 0.f, 0.f}, qd = (f32x4){0.f, 0.f, 0.f, 0.f};
#pragma unroll
        for (int kk = 0; kk < 4; ++kk) { const bf16x8 ak = *(const LAS bf16x8*)(base + DP_K + (16 * wg + n) * DP_PITCH + (32 * kk + 8 * q4) * 2), aq = *(const LAS bf16x8*)(base + DP_Q + (16 * wg + n) * DP_PITCH + (32 * kk + 8 * q4) * 2);
            kd = __builtin_amdgcn_mfma_f32_16x16x32_bf16(ak, ak, kd, 0, 0, 0); qd = __builtin_amdgcn_mfma_f32_16x16x32_bf16(aq, aq, qd, 0, 0, 0); }
#pragma unroll
        for (int r = 0; r < 4; ++r) if (n == 4 * q4 + r) { rkn[16 * wg + n] = 1.0f / sqrtf(kd[r] + RMS_EPS); rqn[16 * wg + n] = 0.08838834764831845f / sqrtf(qd[r] + RMS_EPS); }
    }
    __syncthreads();
    if (tg < 64) { const float g63 = gc[63], gme = gc[tg], e = __expf(gme), rk = rkn[tg];
        eg[tg] = rqn[tg] * e;
        ek[tg] = rk * __expf(g63 - gme);
        ekb[tg] = rk * bt[tg] * e;
        if (tg == 0) ((float*)(F.ws + WS_GLAST))[sitem] = __expf(g63); }
    {
        asm volatile("" : "+v"(lane));
        const int n = lane & 15, q4 = lane >> 4;
        bf16x8 ak[4], aq[4];
#pragma unroll
        for (int kk = 0; kk < 4; ++kk) { ak[kk] = *(const LAS bf16x8*)(base + DP_K + (16 * wg + n) * DP_PITCH + (32 * kk + 8 * q4) * 2); aq[kk] = *(const LAS bf16x8*)(base + DP_Q + (16 * wg + n) * DP_PITCH + (32 * kk + 8 * q4) * 2); }
#pragma unroll
        for (int st = 0; st < 4; ++st) {
            f32x4 kkacc = (f32x4){0.f, 0.f, 0.f, 0.f}, qkacc = (f32x4){0.f, 0.f, 0.f, 0.f};
#pragma unroll
            for (int kk = 0; kk < 4; ++kk) { const bf16x8 bk = *(const LAS bf16x8*)(base + DP_K + (16 * st + n) * DP_PITCH + (32 * kk + 8 * q4) * 2);
                kkacc = __builtin_amdgcn_mfma_f32_16x16x32_bf16(ak[kk], bk, kkacc, 0, 0, 0); qkacc = __builtin_amdgcn_mfma_f32_16x16x32_bf16(aq[kk], bk, qkacc, 0, 0, 0); }
            const int sidx = 16 * st + n; const float gs = gc[sidx], rks = rkn[sidx];
#pragma unroll
            for (int r = 0; r < 4; ++r) { const int c = 16 * wg + 4 * q4 + r; const float dec = (c >= sidx) ? __expf(gc[c] - gs) * rks : 0.f;
                Lm[c * 68 + sidx] = (c > sidx) ? -(bt[c] * rkn[c] * kkacc[r] * dec) : 0.f;
                const int m = 4 * q4 + r, kkf = st >> 1, qq = (n >> 2) & 3, j = ((st & 1) << 2) | (n & 3);
                *(GAS unsigned short*)(ops + 49152 + (size_t)(((wg * 2 + kkf) * 64 + qq * 16 + m) * 8 + j) * 2) = (unsigned short)f2bf(qkacc[r] * rqn[c] * dec); }
        }
    }
    __syncthreads();
    f32x4 Xc[4][4];
    {
        asm volatile("" : "+v"(lane));
        const int n = lane & 15, q4 = lane >> 4;
        unsigned lmb = (unsigned)(size_t)Lm; asm volatile("" : "+v"(lmb));
        if (wg == 0) {
            float t[16];
#pragma unroll
            for (int i = 0; i < 16; ++i) t[i] = 0.f;
            const unsigned rowb = lmb + (unsigned)(((16 * q4) * 68 + 16 * q4) * 4);
#pragma unroll
            for (int i = 0; i < 16; ++i) {
                float a = (i == n) ? 1.f : 0.f;
#pragma unroll
                for (int k4 = 0; k4 < (i + 3) / 4; ++k4) { const f32x4 l4 = *(const LAS f32x4*)(size_t)(rowb + (unsigned)((i * 68 + 4 * k4) * 4));
                    a += (l4.x * t[4 * k4] + l4.y * t[4 * k4 + 1]) + (l4.z * t[4 * k4 + 2] + l4.w * t[4 * k4 + 3]); }
                t[i] = a;
            }
#pragma unroll
            for (int i = 0; i < 16; ++i) *(LAS float*)(size_t)(rowb + (unsigned)((i * 68 + n) * 4)) = t[i];
        }
        {
            const LAS unsigned char* src = base + ((wg < 2) ? DP_V : DP_K) + (((64 * wg) & 127) + n) * 2;
            const LAS float* scp = (wg < 2) ? bt : ekb;
#pragma unroll
            for (int rb = 0; rb < 4; ++rb)
#pragma unroll
                for (int r = 0; r < 4; ++r) { const int row = 16 * rb + 4 * q4 + r; const float sc = scp[row];
#pragma unroll
                    for (int ct = 0; ct < 4; ++ct) Xc[ct][rb][r] = __builtin_bit_cast(float, ((unsigned)*(const LAS unsigned short*)(src + row * DP_PITCH + 32 * ct)) << 16) * sc; }
        }
        __syncthreads();
#define DP_NBLK(rb, rbp) (*(const LAS f32x4*)(size_t)(lmb + (unsigned)((((16 * (rb) + n) * 68) + 16 * (rbp) + 4 * q4) * 4)))
#define DP_PK4(v) ({ const f32x4 v_ = (v); u32x2 p_; p_.x = pk2n(v_[0], v_[1]); p_.y = pk2n(v_[2], v_[3]); __builtin_bit_cast(s16x4, p_); })
        s16x4 xb[4][4];
#pragma unroll
        for (int rb = 0; rb < 4; ++rb) {
#pragma unroll
            for (int rbp = 0; rbp < rb; ++rbp) { const s16x4 a = DP_PK4(DP_NBLK(rb, rbp));
#pragma unroll
                for (int ct = 0; ct < 4; ++ct) Xc[ct][rb] = __builtin_amdgcn_mfma_f32_16x16x16bf16_1k(a, xb[ct][rbp], Xc[ct][rb], 0, 0, 0); }
            const s16x4 tb4 = DP_PK4(DP_NBLK(rb, rb));
#pragma unroll
            for (int ct = 0; ct < 4; ++ct) { const s16x4 rhs = DP_PK4(Xc[ct][rb]);
                Xc[ct][rb] = __builtin_amdgcn_mfma_f32_16x16x16bf16_1k(tb4, rhs, (f32x4){0.f, 0.f, 0.f, 0.f}, 0, 0, 0); xb[ct][rb] = DP_PK4(Xc[ct][rb]); }
        }
#undef DP_NBLK
#undef DP_PK4
        if (wg < 2) {
#pragma unroll
            for (int ct = 0; ct < 4; ++ct)
#pragma unroll
                for (int rb = 0; rb < 4; ++rb) { u32x2 o; o.x = pk2(Xc[ct][rb][0], Xc[ct][rb][1]); o.y = pk2(Xc[ct][rb][2], Xc[ct][rb][3]);
                    *(GAS u32x2*)((GAS unsigned char*)uo + (size_t)((((4 * wg + ct) * 4 + rb) * 64 + lane) * 8)) = o; }
        } else {
#pragma unroll
            for (int ct = 0; ct < 4; ++ct)
#pragma unroll
                for (int rb = 0; rb < 4; ++rb)
#pragma unroll
                    for (int r = 0; r < 4; ++r) *(LAS unsigned short*)(base + DP_V + (16 * rb + 4 * q4 + r) * DP_PITCH + (64 * (wg - 2) + 16 * ct + n) * 2) = (unsigned short)f2bf(Xc[ct][rb][r]);
        }
    }
    __syncthreads();
    asm volatile("" : "+v"(tg));
#pragma unroll 1
    for (int i = 0; i < 4; ++i) { const int p = tg + 256 * i, f = p >> 6, ln = p & 63, q = ln >> 4, m = ln & 15, mt = f >> 2, kk = f & 3, c = 16 * mt + m;
        const u32x2 w0 = *(const LAS u32x2*)(base + DP_V + c * DP_PITCH + (32 * kk + 4 * q) * 2), w1 = *(const LAS u32x2*)(base + DP_V + c * DP_PITCH + (32 * kk + 16 + 4 * q) * 2);
        u32x4 wv; wv.x = w0.x; wv.y = w0.y; wv.z = w1.x; wv.w = w1.y;
        *(GAS u32x4*)(ops + (size_t)(f * 64 + ln) * 16) = wv;
        const u32x2 q0 = *(const LAS u32x2*)(base + DP_Q + c * DP_PITCH + (32 * kk + 4 * q) * 2), q1 = *(const LAS u32x2*)(base + DP_Q + c * DP_PITCH + (32 * kk + 16 + 4 * q) * 2);
        const float e = eg[c]; u32x4 qv;
        qv.x = pk2(bflo(q0.x) * e, bfhi(q0.x) * e); qv.y = pk2(bflo(q0.y) * e, bfhi(q0.y) * e); qv.z = pk2(bflo(q1.x) * e, bfhi(q1.x) * e); qv.w = pk2(bflo(q1.y) * e, bfhi(q1.y) * e);
        *(GAS u32x4*)(ops + 16384 + (size_t)(f * 64 + ln) * 16) = qv;
        const int mt8 = f >> 1, kk2 = f & 1, d = 16 * mt8 + m; float kv[8];
#pragma unroll
        for (int j = 0; j < 8; ++j) { const int cc = 32 * kk2 + 16 * (j >> 2) + 4 * q + (j & 3);
            kv[j] = __builtin_bit_cast(float, ((unsigned)*(const LAS unsigned short*)(base + DP_K + cc * DP_PITCH + d * 2)) << 16) * ek[cc]; }
        u32x4 kw; kw.x = pk2(kv[0], kv[1]); kw.y = pk2(kv[2], kv[3]); kw.z = pk2(kv[4], kv[5]); kw.w = pk2(kv[6], kv[7]);
        *(GAS u32x4*)(ops + 32768 + (size_t)(f * 64 + ln) * 16) = kw; }
    __syncthreads();
}

DI void dn_scan_phase(Frame& F) {
    if (F.bid >= 32) return;
    const int bh = (F.bid & 7) + 8 * (F.bid >> 4), vg = (F.bid >> 3) & 1, b = bh >> 3, h = bh & 7, lane = F.lane;
    const GAS unsigned char* opsg = F.ws + WS_SCAN + (size_t)bh * 64 * OPS_BYTES;
    const GAS unsigned char* ugb = F.ws + WS_SCAN_U + (size_t)bh * 64 * U_BYTES + (size_t)vg * 8192;
    const float* glast = (const float*)(F.ws + WS_GLAST) + bh * 64;
    bf16* ob = (bf16*)(F.ws + WS_OBUF);
    constexpr int SBUF = OPS_BYTES + 8192;
    LAS float* glds = (LAS float*)(F.lds + 2 * SBUF);
    if (F.tid < 64) glds[F.tid] = glast[F.tid];
#define SCAN_STEP_BARRIER() do { asm volatile("s_waitcnt lgkmcnt(0)" ::: "memory"); __builtin_amdgcn_s_barrier(); asm volatile("" ::: "memory"); } while (0)
#define GLD16(dst, ptr) asm volatile("global_load_dwordx4 %0, %1, off" : "=v"(dst) : "v"(ptr) : "memory")
#define WAIT18(r) asm volatile("s_waitcnt vmcnt(16)" : "+v"(r[0]), "+v"(r[1]), "+v"(r[2]), "+v"(r[3]), "+v"(r[4]), "+v"(r[5]), "+v"(r[6]), "+v"(r[7]), "+v"(r[8]), "+v"(r[9]), "+v"(r[10]), "+v"(r[11]), "+v"(r[12]), "+v"(r[13]), "+v"(r[14]), "+v"(r[15]) :: "memory")
    if (F.wave >= 4) {
        const int lw = F.wave - 4;
        const GAS unsigned char* srco = opsg + (size_t)(lw * 14) * 1024 + lane * 16;
        const GAS unsigned char* srcu = ugb + (size_t)(lw * 2) * 1024 + lane * 16;
        LAS unsigned char* dsto = F.lds + (lw * 14) * 1024 + lane * 16;
        LAS unsigned char* dstu = F.lds + OPS_BYTES + (lw * 2) * 1024 + lane * 16;
        u32x4 ra[16], rb[16], rc[16];
#define WAIT32(r) asm volatile("s_waitcnt vmcnt(32)" : "+v"(r[0]), "+v"(r[1]), "+v"(r[2]), "+v"(r[3]), "+v"(r[4]), "+v"(r[5]), "+v"(r[6]), "+v"(r[7]), "+v"(r[8]), "+v"(r[9]), "+v"(r[10]), "+v"(r[11]), "+v"(r[12]), "+v"(r[13]), "+v"(r[14]), "+v"(r[15]) :: "memory")
#define LOAD_SET(r, ck) do { const int ck_ = (ck) < 64 ? (ck) : 63; const GAS unsigned char* so_ = srco + (size_t)ck_ * OPS_BYTES; const GAS unsigned char* su_ = srcu + (size_t)ck_ * U_BYTES; \
        _Pragma("unroll") for (int p = 0; p < 14; ++p) { const GAS unsigned char* a_ = so_ + (size_t)p * 1024; GLD16(r[p], a_); } \
        _Pragma("unroll") for (int p = 0; p < 2; ++p) { const GAS unsigned char* a_ = su_ + (size_t)p * 1024; GLD16(r[14 + p], a_); } } while (0)
#define STORE_SET(r, bufi) do { _Pragma("unroll") for (int p = 0; p < 14; ++p) *(LAS u32x4*)(dsto + (bufi) * SBUF + p * 1024) = r[p]; \
        _Pragma("unroll") for (int p = 0; p < 2; ++p) *(LAS u32x4*)(dstu + (bufi) * SBUF + p * 1024) = r[14 + p]; } while (0)
#define LSTEP(r, bufi, i_) do { WAIT32(r); __builtin_amdgcn_sched_barrier(0); STORE_SET(r, bufi); LOAD_SET(r, (i_) + 4); SCAN_STEP_BARRIER(); } while (0)
        LOAD_SET(ra, 0); LOAD_SET(rb, 1); LOAD_SET(rc, 2);
        WAIT32(ra); __builtin_amdgcn_sched_barrier(0);
        STORE_SET(ra, 0);
        LOAD_SET(ra, 3);
        SCAN_STEP_BARRIER();
#pragma unroll 1
        for (int i = 0; i < 60; i += 6) {
            LSTEP(rb, 1, i); LSTEP(rc, 0, i + 1); LSTEP(ra, 1, i + 2); LSTEP(rb, 0, i + 3); LSTEP(rc, 1, i + 4); LSTEP(ra, 0, i + 5);
        }
        LSTEP(rb, 1, 60); LSTEP(rc, 0, 61); LSTEP(ra, 1, 62); LSTEP(rb, 0, 63);
        asm volatile("s_waitcnt vmcnt(0)" : "+v"(ra[0]), "+v"(rb[0]), "+v"(rc[0]) :: "memory");
#undef LSTEP
#undef WAIT32
#undef LOAD_SET
#undef STORE_SET
    } else {
        const int vs = vg * 4 + F.wave, n = lane & 15, q4 = lane >> 4;
        f32x4 S[8];
#pragma unroll
        for (int i = 0; i < 8; ++i) S[i] = (f32x4){0.f, 0.f, 0.f, 0.f};
        f32x4 Op[4];
#pragma unroll
        for (int t = 0; t < 4; ++t) Op[t] = (f32x4){0.f, 0.f, 0.f, 0.f};
        GAS unsigned char* obase = (GAS unsigned char*)ob + (size_t)b * 64 * OB_CHUNK + h * 16384 + vs * 2048 + lane * 8;
        SCAN_STEP_BARRIER();
#pragma unroll 1
        for (int i = 0; i < 64; ++i) {
            LAS unsigned char* buf = F.lds + (i & 1) * SBUF;
            if (i > 0) { GAS unsigned char* op = obase + (size_t)(i - 1) * OB_CHUNK;
#pragma unroll
                for (int t = 0; t < 4; ++t) { u32x2 pw; pw.x = pk2(Op[t][0], Op[t][1]); pw.y = pk2(Op[t][2], Op[t][3]); *(GAS u32x2*)(op + t * 512) = pw; } }
            f32x4 u[4];
#pragma unroll
            for (int t = 0; t < 4; ++t) { const u32x2 uw = *(const LAS u32x2*)(buf + OPS_BYTES + ((F.wave * 4 + t) * 64 + lane) * 8); u[t] = (f32x4){bflo(uw.x), bfhi(uw.x), bflo(uw.y), bfhi(uw.y)}; }
            const float gl = glds[i];
            bf16x8 wf[16], qf[16];
#pragma unroll
            for (int f = 0; f < 16; ++f) { wf[f] = *(const LAS bf16x8*)(buf + (f * 64 + lane) * 16); qf[f] = *(const LAS bf16x8*)(buf + 16384 + (f * 64 + lane) * 16); }
            bf16x8 sb[4];
#pragma unroll
            for (int kk = 0; kk < 4; ++kk) { u32x4 w; w.x = pk2(S[2 * kk][0], S[2 * kk][1]); w.y = pk2(S[2 * kk][2], S[2 * kk][3]); w.z = pk2(S[2 * kk + 1][0], S[2 * kk + 1][1]); w.w = pk2(S[2 * kk + 1][2], S[2 * kk + 1][3]); sb[kk] = __builtin_bit_cast(bf16x8, w); }
            __builtin_amdgcn_sched_barrier(0);
            f32x4 P[4], O[4];
#pragma unroll
            for (int t = 0; t < 4; ++t) { P[t] = (f32x4){0.f, 0.f, 0.f, 0.f};
#pragma unroll
                for (int kk = 0; kk < 4; ++kk) P[t] = __builtin_amdgcn_mfma_f32_16x16x32_bf16(wf[t * 4 + kk], sb[kk], P[t], 0, 0, 0); }
            __builtin_amdgcn_sched_barrier(0);
            bf16x8 af[8], kf[16];
#pragma unroll
            for (int f = 0; f < 16; ++f) kf[f] = *(const LAS bf16x8*)(buf + 32768 + (f * 64 + lane) * 16);
#pragma unroll
            for (int f = 0; f < 8; ++f) af[f] = *(const LAS bf16x8*)(buf + 49152 + (f * 64 + lane) * 16);
            __builtin_amdgcn_sched_barrier(0);
#pragma unroll
            for (int t = 0; t < 4; ++t) { O[t] = (f32x4){0.f, 0.f, 0.f, 0.f};
#pragma unroll
                for (int kk = 0; kk < 4; ++kk) O[t] = __builtin_amdgcn_mfma_f32_16x16x32_bf16(qf[t * 4 + kk], sb[kk], O[t], 0, 0, 0); }
            __builtin_amdgcn_sched_barrier(0);
            bf16x8 vb[2];
#pragma unroll
            for (int k2 = 0; k2 < 2; ++k2) { const f32x4 v0 = u[2 * k2] - P[2 * k2], v1 = u[2 * k2 + 1] - P[2 * k2 + 1]; u32x4 w; w.x = pk2(v0[0], v0[1]); w.y = pk2(v0[2], v0[3]); w.z = pk2(v1[0], v1[1]); w.w = pk2(v1[2], v1[3]); vb[k2] = __builtin_bit_cast(bf16x8, w); }
#pragma unroll
            for (int mt = 0; mt < 8; ++mt) { S[mt] = S[mt] * gl;
#pragma unroll
                for (int k2 = 0; k2 < 2; ++k2) S[mt] = __builtin_amdgcn_mfma_f32_16x16x32_bf16(kf[mt * 2 + k2], vb[k2], S[mt], 0, 0, 0); }
#pragma unroll
            for (int t = 0; t < 4; ++t)
#pragma unroll
                for (int k2 = 0; k2 < 2; ++k2) O[t] = __builtin_amdgcn_mfma_f32_16x16x32_bf16(af[t * 2 + k2], vb[k2], O[t], 0, 0, 0);
#pragma unroll
            for (int t = 0; t < 4; ++t) Op[t] = O[t];
            SCAN_STEP_BARRIER();
        }
        { GAS unsigned char* op = obase + (size_t)63 * OB_CHUNK;
#pragma unroll
            for (int t = 0; t < 4; ++t) { u32x2 pw; pw.x = pk2(Op[t][0], Op[t][1]); pw.y = pk2(Op[t][2], Op[t][3]); *(GAS u32x2*)(op + t * 512) = pw; } }
        asm volatile("s_waitcnt vmcnt(0)" ::: "memory");
    }
#undef SCAN_STEP_BARRIER
#undef GLD16
#undef WAIT18
}

DI void gnorm_phase(Frame& F, int l) {
    const GAS unsigned char* ob = F.ws + WS_OBUF; const bf16* proj = (const bf16*)(F.ws + WS_PROJ); bf16* cat = (bf16*)(F.ws + WS_CAT);
    int lane = F.lane; asm volatile("" : "+v"(lane));
    const int n = lane & 15, q4 = lane >> 4;
    const f32x2 nw = *(const GAS f32x2*)(FIN(I_DNW) + l * 128 + 2 * lane);
    LAS float* tl = (LAS float*)(F.lds + F.wave * (16 * 132 * 4));
    const int gw = F.bid * NWAVES + F.wave, NGW = F.G * NWAVES;
    for (int item = gw; item < 2 * 64 * 8 * 4; item += NGW) {
        const int t = item & 3, h = (item >> 2) & 7, ck = (item >> 5) & 63, b = item >> 11;
        const GAS unsigned char* src = ob + (size_t)(b * 64 + ck) * OB_CHUNK + h * 16384 + t * 512 + lane * 8;
        const int tok0 = b * SEQ + ck * 64 + t * 16;
        u32x2 fr[8]; unsigned zz[16];
#pragma unroll
        for (int vs = 0; vs < 8; ++vs) fr[vs] = *(const GAS u32x2*)(src + vs * 2048);
#pragma unroll
        for (int k = 0; k < 16; ++k) zz[k] = *(const GAS unsigned*)(proj + (size_t)(tok0 + k) * PN + C_DZ + h * 128 + 2 * lane);
        __builtin_amdgcn_sched_barrier(0);
        float f[8][4], s4[4] = {0.f, 0.f, 0.f, 0.f};
#pragma unroll
        for (int vs = 0; vs < 8; ++vs) { f[vs][0] = bflo(fr[vs].x); f[vs][1] = bfhi(fr[vs].x); f[vs][2] = bflo(fr[vs].y); f[vs][3] = bfhi(fr[vs].y);
#pragma unroll
            for (int r = 0; r < 4; ++r) s4[r] += f[vs][r] * f[vs][r]; }
#pragma unroll
        for (int r = 0; r < 4; ++r) { float v = s4[r]; v += swz_xor(v, SWZ_X1); v += swz_xor(v, SWZ_X2); v += swz_xor(v, SWZ_X4); v += swz_xor(v, SWZ_X8);
            s4[r] = 1.0f / sqrtf(v * (1.0f / 128.0f) + RMS_EPS); }
#pragma unroll
        for (int vs = 0; vs < 8; ++vs)
#pragma unroll
            for (int r = 0; r < 4; ++r) tl[(4 * q4 + r) * 132 + vs * 16 + n] = f[vs][r] * s4[r];
        LDS_WAIT(); asm volatile("" ::: "memory");
#pragma unroll
        for (int k = 0; k < 16; ++k) { const f32x2 v = *(const LAS f32x2*)(tl + k * 132 + 2 * lane);
            *(GAS unsigned*)(cat + (size_t)(tok0 + k) * DM + 1024 + h * 128 + 2 * lane) = pk2(v.x * nw.x * siluf_(bflo(zz[k])), v.y * nw.y * siluf_(bfhi(zz[k]))); }
        LDS_WAIT(); asm volatile("" ::: "memory");
    }
}

DI int moe_table(Frame& F, const unsigned* cnt) {
    LAS int* tab = (LAS int*)(F.lds + MOETAB_OFF);
    __syncthreads();
    if (F.tid < 16) tab[17 + F.tid] = (int)__hip_atomic_load(cnt + 64 * F.tid, __ATOMIC_RELAXED, __HIP_MEMORY_SCOPE_AGENT);
    __syncthreads();
    if (F.tid == 0) { int acc = 0, np = 0;
        for (int e = 0; e < 16; ++e) { const int c = tab[17 + e]; tab[e] = acc; acc += c >> 8; if (c & 255) { tab[34 + np] = e; ++np; } }
        tab[16] = acc; tab[33] = np; }
    __syncthreads();
    return tab[16] + tab[33];
}

constexpr int NS = 11, NSTEPS = 1 + DEPTH * NS;
struct Args { const float* in[18]; float* out; unsigned char* ws; int s_lo, s_hi; };

__global__ void __launch_bounds__(NTHREADS, 2) fwd_kernel(Args args) {
    extern __shared__ __attribute__((aligned(16))) unsigned char lds_raw[];
    Frame F;
    F.lds = (LAS unsigned char*)lds_raw;
    F.tid = threadIdx.x; F.lane = F.tid & 63; F.wave = __builtin_amdgcn_readfirstlane(F.tid >> 6);
    const int wave0 = F.wave;
    F.G = gridDim.x; F.bid = blockIdx.x; F.ws = (GAS unsigned char*)args.ws; F.out = (GAS float*)args.out;
    F.in = args.in;
    unsigned* ctl = (unsigned*)(F.ws + WS_CTL);
    if (F.tid < 4) ((LAS unsigned*)(F.lds + MISC_OFF))[F.tid] = 0u;
    __syncthreads();
    const int lo = args.s_lo, hi = args.s_hi;
    XcdBarrier bar; bar.bar = ctl + CW_BAR; bar.x = 0; bar.st = nullptr;
    if (hi - lo > 1) bar = xcd_barrier_post(ctl + CW_BAR, (volatile LAS unsigned*)(F.lds + MISC_OFF));
#ifndef PHASE_MASK
#define PHASE_MASK 0xfff
#endif
#define PHM(k) (((PHASE_MASK) >> (k)) & 1)
#define REFRESH() do { int z_ = 0; asm volatile("" : "+v"(z_)); const int ln_ = __builtin_amdgcn_mbcnt_hi(-1, __builtin_amdgcn_mbcnt_lo(-1, z_)); int wv_ = wave0; asm volatile("" : "+s"(wv_)); F.lane = ln_; F.wave = wv_; F.tid = wv_ * 64 + ln_; asm volatile("" : "+s"(F.ws)); } while (0)
#ifndef PROBE_A
#define PROBE_A -1
#define PROBE_B -1
#endif
#ifndef PROBE_SHIFT
#define PROBE_SHIFT 0.5f
#endif
#define TSTAMP(k) do { if (PROBE_A >= 0 && F.bid == 0 && F.tid == 0) ((unsigned long long*)(F.ws + WS_CTL + 65536))[k] = __builtin_amdgcn_s_memrealtime(); } while (0)
#define RUN(s) (lo <= (s) && (s) < hi)
#define SEAM(s) do { if ((s) + 1 < hi || PROBE_A >= 0) { XcdBarrier b2_ = bar; unsigned* bp_ = (unsigned*)(F.ws + WS_CTL) + CW_BAR; asm volatile("" : "+s"(bp_)); b2_.bar = bp_; xcd_barrier(b2_); } TSTAMP((s) + 1); } while (0)
#define P_CNT ((unsigned*)(F.ws + WS_CTL) + CW_CNT)
#define P_LIST ((int*)(F.ws + WS_LIST))
#define P_WSEL ((float*)(F.ws + WS_WSEL))
#define P_XB ((bf16*)(F.ws + WS_XB))
#define P_PROJB ((bf16*)(F.ws + WS_PROJ))
#define P_CATB ((bf16*)(F.ws + WS_CAT))
#define P_YB ((bf16*)(F.ws + WS_Y))
#define P_X1 ((float*)(F.ws + WS_X1))
#define P_X1B ((bf16*)(F.ws + WS_X1B))
#define P_HID ((bf16*)(F.ws + WS_HID))
#define P_O2 ((bf16*)(F.ws + WS_O2))
#define P_XW ((float*)(F.ws + WS_X))
#define P_ABP ((float*)(F.ws + WS_AB))
    TSTAMP(0);
    if (PHM(11) && RUN(0)) { REFRESH();
        rope_phase(F);
        ln_phase<0, false>(F, FIN(I_X), nullptr, nullptr, nullptr, nullptr, P_XB, FIN(I_WIN) + C_AB, PROJ, true, P_ABP, nullptr, nullptr, nullptr, nullptr);
        __syncthreads();
        convw_phase(F, 0, 0, 0, F.G, 0, CONV_I_IN);
        __syncthreads();
        SEAM(0);
    }
    for (int l = 0; l < DEPTH; ++l) {
        const int sb = 1 + l * NS;
        const int slot = l & 1;
#define P_WIN_T ((const bf16*)(F.ws + WS_WIN) + (size_t)slot * PN * DM)
#define P_WOUT_T ((const bf16*)(F.ws + WS_WOUT) + (size_t)slot * DM * DM)
#define P_WGU_T ((const bf16*)(F.ws + WS_WGU) + (size_t)slot * NEXP * 1024 * DM)
#define P_WD_T ((const bf16*)(F.ws + WS_WD) + (size_t)slot * NEXP * DM * DEXP)
#define P_XRES P_XB
        if (PHM(0) && RUN(sb + 0)) { REFRESH(); TSTAMP(sb + 1); }
        if (PHM(1) && RUN(sb + 1)) { REFRESH();
            if (F.bid == 0 && F.tid < 16) __hip_atomic_store(P_CNT + 64 * F.tid, 0u, __ATOMIC_RELAXED, __HIP_MEMORY_SCOPE_AGENT);
            g8::DenseSched<NTOK, PN - C_DQ, DM> S; S.init(P_WIN_T + (size_t)C_DQ * DM, F.G, F.bid);
            g8::EpiBf16 E{P_PROJB + C_DQ, PN};
            g8::gemm_phase<g8::EpiBf16, g8::DenseSched<NTOK, PN - C_DQ, DM>>(F.lds, F.wave, (const char*)P_XB, DM, S, E);
            SEAM(sb + 1);
        }
        if (PHM(2) && RUN(sb + 2)) { REFRESH();
            if (F.bid < IP_ATT_UNITS) {
                g8::DenseSched<NTOK, C_DQ, DM> S; S.init(P_WIN_T, F.G, F.bid);
                g8::EpiBf16 E{P_PROJB, PN};
                g8::gemm_phase<g8::EpiBf16, g8::DenseSched<NTOK, C_DQ, DM>>(F.lds, F.wave, (const char*)P_XB, DM, S, E);
                __syncthreads(); dn_prep_item(F, F.bid * 2 + (F.wave >> 2), l);
            } else {
                for (int it = IP_ATT_UNITS + (F.bid - IP_ATT_UNITS); it < 512; it += F.G - IP_ATT_UNITS) { __syncthreads(); dn_prep_item(F, it * 2 + (F.wave >> 2), l); }
            }
            SEAM(sb + 2);
        }
        if (PHM(3) && RUN(sb + 3)) { REFRESH(); TSTAMP(sb + 4); }
        if (PHM(4) && RUN(sb + 4)) { REFRESH();
            if (F.bid < 32) dn_scan_phase(F);
            else { for (int u = F.bid - 32; u < 128; u += F.G - 32) attn_unit(F, u, l); }
            if (F.bid >= 32 && F.bid < 32 + CONV_HELPERS) {
                convw_phase(F, l, l & 1, 32, CONV_HELPERS, CONV_I_IN, CONV_ITEMS);
                if (l + 1 < DEPTH) convw_phase(F, l + 1, (l + 1) & 1, 32, CONV_HELPERS, 0, CONV_I_IN);
                __syncthreads(); }
            SEAM(sb + 4); }
        if (PHM(5) && RUN(sb + 5)) { REFRESH(); gnorm_phase(F, l);
            SEAM(sb + 5); }
        if (PHM(6) && RUN(sb + 6)) { REFRESH();
            g8::DenseSched<NTOK, DM, DM> S; S.init(P_WOUT_T, F.G, F.bid);
            g8::EpiResid E{P_XRES, P_YB};
            g8::gemm_phase<g8::EpiResid, g8::DenseSched<NTOK, DM, DM>>(F.lds, F.wave, (const char*)P_CATB, DM, S, E);
            SEAM(sb + 6);
        }
        if (PHM(7) && RUN(sb + 7)) { REFRESH();
            ln_phase<1, true>(F, P_YB, nullptr, FIN(I_LN1G) + l * DM, FIN(I_LN1B) + l * DM, nullptr, P_X1B, FIN(I_RW), 16, true, nullptr, FIN(I_RB), P_CNT, P_LIST, P_WSEL);
            SEAM(sb + 7);
        }
        if (PHM(8) && RUN(sb + 8)) { REFRESH();
            const int mt = moe_table(F, P_CNT);
            g8::MoeUni S; S.tab = (const LAS int*)(F.lds + MOETAB_OFF); S.list = P_LIST; S.Wgu = (const char*)P_WGU_T; S.Wd = (const char*)P_WD_T; S.G = F.G; S.c = F.bid; S.MT = mt;
            g8::gemm_moe_phase(F.lds, F.wave, (const char*)P_X1B, (const char*)P_HID, S, P_HID, P_WSEL, P_O2, (unsigned*)(F.ws + WS_CTL) + CW_DONE + l * 128 * 16, (unsigned*)(F.ws + WS_CTL) + CW_BAR + XB_TMO);
            SEAM(sb + 8);
        }
        if (PHM(9) && RUN(sb + 9)) { REFRESH(); TSTAMP(sb + 10); }
        if (PHM(10) && RUN(sb + 10)) { REFRESH();
            const bool lastl = (l == DEPTH - 1);
            ln_phase<2, true>(F, P_X1B, P_O2, FIN(I_LN2G) + l * DM, FIN(I_LN2B) + l * DM, lastl ? (float*)F.out : nullptr, lastl ? (bf16*)nullptr : P_XB, FIN(I_WIN) + (size_t)(lastl ? l : l + 1) * DM * PROJ + C_AB, PROJ, !lastl, P_ABP, nullptr, nullptr, nullptr, nullptr);
            SEAM(sb + 10);
        }
    }
#if PROBE_A >= 0
    {
        REFRESH();
        { XcdBarrier b2_ = bar; unsigned* bp_ = (unsigned*)(F.ws + WS_CTL) + CW_BAR; asm volatile("" : "+s"(bp_)); b2_.bar = bp_; xcd_barrier(b2_); }
        const unsigned long long* ts = (const unsigned long long*)(F.ws + WS_CTL + 65536);
        float ta = 0.f, tb2 = 0.f;
        for (int l = 0; l < DEPTH; ++l) {
            if (PROBE_A < 11) ta += (float)(__hip_atomic_load(ts + 1 + l * NS + PROBE_A + 1, __ATOMIC_RELAXED, __HIP_MEMORY_SCOPE_AGENT) - __hip_atomic_load(ts + 1 + l * NS + PROBE_A, __ATOMIC_RELAXED, __HIP_MEMORY_SCOPE_AGENT)) * 0.01f;
            if (PROBE_B < 11) tb2 += (float)(__hip_atomic_load(ts + 1 + l * NS + PROBE_B + 1, __ATOMIC_RELAXED, __HIP_MEMORY_SCOPE_AGENT) - __hip_atomic_load(ts + 1 + l * NS + PROBE_B, __ATOMIC_RELAXED, __HIP_MEMORY_SCOPE_AGENT)) * 0.01f;
        }
        if (PROBE_A == 11) ta = (float)(__hip_atomic_load(ts + 1, __ATOMIC_RELAXED, __HIP_MEMORY_SCOPE_AGENT) - __hip_atomic_load(ts + 0, __ATOMIC_RELAXED, __HIP_MEMORY_SCOPE_AGENT)) * 0.01f;
        if (PROBE_B == 11) tb2 = (float)(__hip_atomic_load(ts + 1, __ATOMIC_RELAXED, __HIP_MEMORY_SCOPE_AGENT) - __hip_atomic_load(ts + 0, __ATOMIC_RELAXED, __HIP_MEMORY_SCOPE_AGENT)) * 0.01f;
        if (PROBE_A == 12) ta = (float)(__hip_atomic_load(ts + NSTEPS, __ATOMIC_RELAXED, __HIP_MEMORY_SCOPE_AGENT) - __hip_atomic_load(ts + 0, __ATOMIC_RELAXED, __HIP_MEMORY_SCOPE_AGENT)) * 0.01f;
        ta = __expf((rintf(__logf(fmaxf(ta, 1.f)) * 7.15495f + PROBE_SHIFT) - PROBE_SHIFT) * 0.13976194f);
        tb2 = __expf((rintf(__logf(fmaxf(tb2, 1.f)) * 7.15495f + PROBE_SHIFT) - PROBE_SHIFT) * 0.13976194f);
        const float cv = sqrtf(ta * 0.1f);
        for (size_t i = (size_t)F.bid * NTHREADS + F.tid; i < (size_t)NTOK * DM; i += (size_t)F.G * NTHREADS) F.out[i] = (i == 0) ? tb2 : cv;
    }
#endif
#undef RUN
#undef SEAM
}

extern "C" void kernel_launch(void* const* d_in, const int* in_sizes, int n_in, void* d_out, int out_size, void* d_ws, size_t ws_size, hipStream_t stream) {
    static int grid = 0;
    if (grid == 0) {
        if (n_in != 18 || out_size != NTOK * DM || ws_size < WS_END) { fprintf(stderr, "kernel_launch: unexpected shapes (n_in %d, out %d, ws %zu < %zu)\n", n_in, out_size, ws_size, (size_t)WS_END); grid = -1; return; }
        int dev = 0, cus = 0, per_cu = 0;
        if (hipGetDevice(&dev) != hipSuccess || hipDeviceGetAttribute(&cus, hipDeviceAttributeMultiprocessorCount, dev) != hipSuccess) { grid = -1; return; }
        if (hipFuncSetAttribute((const void*)fwd_kernel, hipFuncAttributeMaxDynamicSharedMemorySize, LDS_BYTES) != hipSuccess) { fprintf(stderr, "kernel_launch: hipFuncSetAttribute failed\n"); grid = -1; return; }
        if (hipOccupancyMaxActiveBlocksPerMultiprocessor(&per_cu, (const void*)fwd_kernel, NTHREADS, LDS_BYTES) != hipSuccess || per_cu < 1) { fprintf(stderr, "kernel_launch: occupancy query says %d\n", per_cu); }
        (void)hipGetLastError();
        grid = cus;
    }
    if (grid < 0) return;
    (void)hipMemsetAsync((char*)d_ws + WS_CTL, 0, CTL_BYTES, stream);
    Args a{};
    for (int i = 0; i < 18; ++i) a.in[i] = (const float*)d_in[i];
    a.out = (float*)d_out; a.ws = (unsigned char*)d_ws;
#if MK_ONE_LAUNCH
    a.s_lo = 0; a.s_hi = NSTEPS;
    hipLaunchKernelGGL(fwd_kernel, dim3(grid), dim3(NTHREADS), LDS_BYTES, stream, a);
#else
    for (int s = 0; s < NSTEPS; ++s) {
        a.s_lo = s; a.s_hi = s + 1;
        hipLaunchKernelGGL(fwd_kernel, dim3(grid), dim3(NTHREADS), LDS_BYTES, stream, a);
    }
#endif
}
```
